# Optimizing an MI355X kernel written in HIP

```python
import jax, jax.numpy as jnp
from jax import lax
import numpy as np

D_MODEL = 2048
BATCH = 4
SEQ = 2048
DEPTH = 4
DEC_BATCH = 128
DEC_SEQ = 8
PAST_LEN = 16384
PAGE_SIZE = 128

N_MIXERS = 3
N_LAYERS_A = len(range(0, DEPTH, N_MIXERS))
N_LAYERS_B = len(range(1, DEPTH, N_MIXERS))
N_LAYERS_C = len(range(2, DEPTH, N_MIXERS))

HG_FORGET_DIM = 128
HG_HEADS = D_MODEL // HG_FORGET_DIM
HG_HEAD_V = D_MODEL // HG_HEADS

GLA_HEADS = 4
GLA_DK = D_MODEL // 2
GLA_DV = D_MODEL
GLA_HEAD_K = GLA_DK // GLA_HEADS
GLA_HEAD_V = GLA_DV // GLA_HEADS
GLA_GATE_RANK = 16
GLA_GATE_NORM = 16.0

POOL_WINDOWS = (2, 4, 8, 16)
POOL_GROUPS = len(POOL_WINDOWS)
POOL_GROUP_DIM = D_MODEL // POOL_GROUPS
POOL_BUF = max(POOL_WINDOWS) - 1

D_FF = 5632
CHUNK = 32
EPS = 1e-6

kernel_name = "hgrn2_gla_pool_macaron_decoder_step"


def rmsnorm(x, g):
    xf = x.astype(jnp.float32)
    y = xf * lax.rsqrt(jnp.mean(xf * xf, axis=-1, keepdims=True) + EPS)
    return (y * g.astype(jnp.float32)).astype(x.dtype)


def swiglu(x, w_gate, w_up, w_down):
    return (jax.nn.silu(x @ w_gate) * (x @ w_up)) @ w_down


def gla_chunked(q, k, v, log_f, s0):
    B, T, H, K = q.shape
    C = min(CHUNK, T)
    n = -(-T // C)
    pad = n * C - T

    def chunks(a):
        a = jnp.pad(a.astype(jnp.float32), ((0, 0), (0, pad), (0, 0), (0, 0)))
        return jnp.moveaxis(a.reshape(B, n, C, H, a.shape[-1]), 1, 0)

    causal = jnp.tril(jnp.ones((C, C), dtype=bool))[None, :, :, None, None]

    def step(S, blk):
        qc, kc, vc, gc = blk
        b = jnp.cumsum(gc, axis=1)
        b_last = b[:, -1]
        o_inter = jnp.einsum('bthk,bhkv->bthv', qc * jnp.exp(b), S)
        decay = jnp.exp(jnp.where(causal, b[:, :, None] - b[:, None, :], -jnp.inf))
        att = jnp.einsum('bthk,bshk,btshk->bhts', qc, kc, decay)
        o = o_inter + jnp.einsum('bhts,bshv->bthv', att, vc)
        S = jnp.exp(b_last)[..., None] * S + jnp.einsum(
            'bshk,bshv->bhkv', kc * jnp.exp(b_last[:, None] - b), vc)
        return S, o

    s_fin, o = lax.scan(step, s0.astype(jnp.float32),
                        (chunks(q), chunks(k), chunks(v), chunks(log_f)))
    o = jnp.moveaxis(o, 0, 1).reshape(B, n * C, H, -1)[:, :T]
    return o, s_fin


def hgrn_lower_bounds(logits):
    p = jax.nn.softmax(logits.astype(jnp.float32), axis=0)
    gamma = jnp.cumsum(p, axis=0)
    return gamma - gamma[0]


def hgrn2_mixer(xn, s0, lb, w_in, o_gain, w_out):
    B, T, _ = xn.shape
    q, f, i, g = jnp.split(xn @ w_in, 4, axis=-1)
    ff = f.astype(jnp.float32)
    log_f = jnp.logaddexp(jnp.log(lb), jnp.log1p(-lb) + jax.nn.log_sigmoid(ff))
    k = (1.0 - lb) * jax.nn.sigmoid(-ff)
    heads = lambda a: a.reshape(B, T, HG_HEADS, -1)
    qh = heads(jax.nn.silu(q).astype(jnp.float32)) * (HG_FORGET_DIM ** -0.5)
    o, s = gla_chunked(qh, heads(k), heads(i), heads(log_f), s0)
    o = rmsnorm(o.reshape(B, T, D_MODEL).astype(xn.dtype), o_gain) * jax.nn.silu(g)
    return o @ w_out, s.astype(s0.dtype)


def gla_mixer(xn, s0, w_in, w_gate_up, b_gate, o_gain, w_out):
    B, T, _ = xn.shape
    q, k, v, r, glow = jnp.split(
        xn @ w_in, [GLA_DK, 2 * GLA_DK, 2 * GLA_DK + GLA_DV, 2 * GLA_DK + 2 * GLA_DV], axis=-1)
    log_f = jax.nn.log_sigmoid((glow @ w_gate_up + b_gate).astype(jnp.float32)) / GLA_GATE_NORM
    heads = lambda a: a.reshape(B, T, GLA_HEADS, -1)
    qh = heads(q.astype(jnp.float32)) * (GLA_HEAD_K ** -0.5)
    o, s = gla_chunked(qh, heads(k), heads(v), heads(log_f), s0)
    o = rmsnorm(o.astype(xn.dtype), o_gain.reshape(GLA_HEADS, GLA_HEAD_V))
    o = o.reshape(B, T, GLA_DV) * jax.nn.silu(r)
    return o @ w_out, s.astype(s0.dtype)


def pool_mixer(xn, buf, n_prev, w_group, scale):
    B, T, D = xn.shape
    xe = jnp.concatenate([buf.astype(xn.dtype), xn], axis=1)
    cs = jnp.pad(jnp.cumsum(xe.astype(jnp.float32), axis=1), ((0, 0), (1, 0), (0, 0)))
    t = jnp.arange(T)
    outs = []
    for gi, w in enumerate(POOL_WINDOWS):
        sl = slice(gi * POOL_GROUP_DIM, (gi + 1) * POOL_GROUP_DIM)
        win = cs[:, POOL_BUF + 1:POOL_BUF + 1 + T, sl] - cs[:, POOL_BUF + 1 - w:POOL_BUF + 1 - w + T, sl]
        cnt = jnp.minimum(w, t + 1 + n_prev).astype(jnp.float32)
        outs.append(win / cnt[None, :, None] - xn[:, :, sl].astype(jnp.float32))
    y = jnp.stack(outs, axis=2).astype(xn.dtype)
    y = jnp.einsum('btgc,gcd->btgd', y, w_group).reshape(B, T, D) * scale
    return y, xe[:, -POOL_BUF:]


def trunk(x, st_a, st_b, st_c, n_prev, lb, p):
    new_a, new_b, new_c = [], [], []
    for li in range(DEPTH):
        j = li // N_MIXERS
        x = x + 0.5 * swiglu(rmsnorm(x, p['norm_ffn1'][li]), p['ffn1_w_gate'][li],
                             p['ffn1_w_up'][li], p['ffn1_w_down'][li])
        xn = rmsnorm(x, p['norm_mix'][li])
        kind = li % N_MIXERS
        if kind == 0:
            h, s = hgrn2_mixer(xn, st_a[j], lb[li], p['hgrn_w_in'][j], p['hgrn_o_norm'][j], p['hgrn_w_out'][j])
            new_a.append(s)
        elif kind == 1:
            h, s = gla_mixer(xn, st_b[j], p['gla_w_in'][j], p['gla_w_gate_up'][j], p['gla_b_gate'][j],
                             p['gla_o_norm'][j], p['gla_w_out'][j])
            new_b.append(s)
        else:
            h, s = pool_mixer(xn, st_c[j], n_prev, p['pool_w_group'][j], p['pool_scale'][j])
            new_c.append(s)
        x = x + h
        x = x + 0.5 * swiglu(rmsnorm(x, p['norm_ffn2'][li]), p['ffn2_w_gate'][li],
                             p['ffn2_w_up'][li], p['ffn2_w_down'][li])
    return rmsnorm(x, p['final_norm']), jnp.stack(new_a), jnp.stack(new_b), jnp.stack(new_c)


def setup_inputs(seed: int = 0) -> dict:
    key = jax.random.key(seed)
    keys = iter(jax.random.split(key, 64))

    def nrm(shape, scale):
        return scale * jax.random.normal(next(keys), shape, jnp.float32)

    def gain(shape):
        return 1.0 + nrm(shape, 0.02)

    D = D_MODEL
    return {
        "x_prompt": nrm((BATCH, SEQ, D), 1.0),
        "x_sample": nrm((DEC_BATCH, DEC_SEQ, D), 1.0),
        "state_hgrn": nrm((N_LAYERS_A, DEC_BATCH, HG_HEADS, HG_FORGET_DIM, HG_HEAD_V), 0.5),
        "state_gla": nrm((N_LAYERS_B, DEC_BATCH, GLA_HEADS, GLA_HEAD_K, GLA_HEAD_V), 1.0),
        "state_pool": nrm((N_LAYERS_C, DEC_BATCH, POOL_BUF, D), 1.0),
        "norm_ffn1": gain((DEPTH, D)),
        "ffn1_w_gate": nrm((DEPTH, D, D_FF), D ** -0.5),
        "ffn1_w_up": nrm((DEPTH, D, D_FF), D ** -0.5),
        "ffn1_w_down": nrm((DEPTH, D_FF, D), D_FF ** -0.5),
        "norm_mix": gain((DEPTH, D)),
        "norm_ffn2": gain((DEPTH, D)),
        "ffn2_w_gate": nrm((DEPTH, D, D_FF), D ** -0.5),
        "ffn2_w_up": nrm((DEPTH, D, D_FF), D ** -0.5),
        "ffn2_w_down": nrm((DEPTH, D_FF, D), D_FF ** -0.5),
        "hgrn_lb_logits": nrm((DEPTH, HG_HEADS * HG_FORGET_DIM), 0.1),
        "hgrn_w_in": nrm((N_LAYERS_A, D, 4 * D), D ** -0.5),
        "hgrn_o_norm": gain((N_LAYERS_A, D)),
        "hgrn_w_out": nrm((N_LAYERS_A, D, D), D ** -0.5),
        "gla_w_in": nrm((N_LAYERS_B, D, 2 * GLA_DK + 2 * GLA_DV + GLA_GATE_RANK), D ** -0.5),
        "gla_w_gate_up": nrm((N_LAYERS_B, GLA_GATE_RANK, GLA_DK), GLA_GATE_RANK ** -0.5),
        "gla_b_gate": nrm((N_LAYERS_B, GLA_DK), 0.1),
        "gla_o_norm": gain((N_LAYERS_B, GLA_DV)),
        "gla_w_out": nrm((N_LAYERS_B, GLA_DV, D), GLA_DV ** -0.5),
        "pool_w_group": nrm((N_LAYERS_C, POOL_GROUPS, POOL_GROUP_DIM, POOL_GROUP_DIM), POOL_GROUP_DIM ** -0.5),
        "pool_scale": gain((N_LAYERS_C, D)),
        "final_norm": gain((D,)),
    }


def reference(x_prompt, x_sample, state_hgrn, state_gla, state_pool,
              norm_ffn1, ffn1_w_gate, ffn1_w_up, ffn1_w_down, norm_mix,
              norm_ffn2, ffn2_w_gate, ffn2_w_up, ffn2_w_down,
              hgrn_lb_logits, hgrn_w_in, hgrn_o_norm, hgrn_w_out,
              gla_w_in, gla_w_gate_up, gla_b_gate, gla_o_norm, gla_w_out,
              pool_w_group, pool_scale, final_norm):
    p = {
        'norm_ffn1': norm_ffn1, 'ffn1_w_gate': ffn1_w_gate, 'ffn1_w_up': ffn1_w_up, 'ffn1_w_down': ffn1_w_down,
        'norm_mix': norm_mix,
        'norm_ffn2': norm_ffn2, 'ffn2_w_gate': ffn2_w_gate, 'ffn2_w_up': ffn2_w_up, 'ffn2_w_down': ffn2_w_down,
        'hgrn_w_in': hgrn_w_in, 'hgrn_o_norm': hgrn_o_norm, 'hgrn_w_out': hgrn_w_out,
        'gla_w_in': gla_w_in, 'gla_w_gate_up': gla_w_gate_up, 'gla_b_gate': gla_b_gate,
        'gla_o_norm': gla_o_norm, 'gla_w_out': gla_w_out,
        'pool_w_group': pool_w_group, 'pool_scale': pool_scale, 'final_norm': final_norm,
    }
    lb = hgrn_lower_bounds(hgrn_lb_logits)
    dt = x_prompt.dtype
    z_a = jnp.zeros((N_LAYERS_A, BATCH, HG_HEADS, HG_FORGET_DIM, HG_HEAD_V), dt)
    z_b = jnp.zeros((N_LAYERS_B, BATCH, GLA_HEADS, GLA_HEAD_K, GLA_HEAD_V), dt)
    z_c = jnp.zeros((N_LAYERS_C, BATCH, POOL_BUF, D_MODEL), dt)
    y_prompt, hgrn_p, gla_p, pool_p = trunk(x_prompt, z_a, z_b, z_c, 0, lb, p)
    y_sample, hgrn_s, gla_s, pool_s = trunk(x_sample, state_hgrn, state_gla, state_pool,
                                            min(POOL_BUF, PAST_LEN), lb, p)
    return (y_prompt, y_sample, hgrn_p, gla_p, pool_p, hgrn_s, gla_s, pool_s)
```

```cpp
#include <hip/hip_runtime.h>
#include <cstdio>
#include <cstdint>

#ifndef MK_PER_PHASE_LAUNCH
#define MK_PER_PHASE_LAUNCH 0
#endif

#define LAS __attribute__((address_space(3)))
#define GAS __attribute__((address_space(1)))
typedef unsigned short bf16_t;
typedef short bf16x8 __attribute__((ext_vector_type(8)));
typedef float f32x4 __attribute__((ext_vector_type(4)));
typedef float f32x2 __attribute__((ext_vector_type(2)));
typedef unsigned u32x4 __attribute__((ext_vector_type(4)));
typedef unsigned u32x2 __attribute__((ext_vector_type(2)));

constexpr int D = 2048, FF = 5632, NLAYER = 4;
constexpr int PB = 4, PT = 2048, SB = 128, ST = 8;
constexpr int MP = PB * PT, MS = SB * ST, M = MP + MS;
constexpr int HG_H = 16, HG_K = 128, HG_V = 128;
constexpr int GL_H = 4, GL_K = 256, GL_V = 512, GL_DK = 1024, GL_NIN = 7168, GL_WIN_LD = 6160;
constexpr int POOLBUF = 15;
constexpr float EPS = 1e-6f;
constexpr int NWAVES = 8, NTHREADS = 512;

constexpr size_t OUT_Y = 0;
constexpr size_t OUT_HG_P = (size_t)M * D;
constexpr size_t OUT_GLA_P = OUT_HG_P + (size_t)2 * PB * HG_H * HG_K * HG_V;
constexpr size_t OUT_POOL_P = OUT_GLA_P + (size_t)PB * GL_H * GL_K * GL_V;
constexpr size_t OUT_HG_S = OUT_POOL_P + (size_t)PB * POOLBUF * D;
constexpr size_t OUT_GLA_S = OUT_HG_S + (size_t)2 * SB * HG_H * HG_K * HG_V;
constexpr size_t OUT_POOL_S = OUT_GLA_S + (size_t)SB * GL_H * GL_K * GL_V;
constexpr size_t OUT_TOTAL = OUT_POOL_S + (size_t)SB * POOLBUF * D;
static_assert(OUT_TOTAL == 161341440ull, "output size");

constexpr size_t MiB = 1u << 20;
constexpr size_t al(size_t x) { return (x + MiB - 1) / MiB * MiB; }
constexpr size_t WS_CTL = 0, CTL_ZERO_BYTES = 1 * MiB;
constexpr size_t WS_TAB = 1 * MiB;
constexpr size_t SZ_WGU1 = (size_t)2 * FF * D * 2, SZ_WDN1 = (size_t)D * FF * 2;
constexpr size_t WS_WGU = 2 * MiB;
constexpr size_t WS_WDN = WS_WGU + al(8 * SZ_WGU1);
constexpr size_t WS_WHIN = WS_WDN + al(8 * SZ_WDN1);
constexpr size_t WS_WHOUT = WS_WHIN + al((size_t)2 * 8192 * D * 2);
constexpr size_t WS_WGIN = WS_WHOUT + al((size_t)2 * D * D * 2);
constexpr size_t WS_WGOUT = WS_WGIN + al((size_t)GL_NIN * D * 2);
constexpr size_t WS_WPOOL = WS_WGOUT + al((size_t)D * D * 2);
constexpr size_t WS_X = WS_WPOOL + al((size_t)D * 512 * 2);
constexpr size_t WS_XN = WS_X + al((size_t)M * D * 4);
constexpr size_t WS_H = WS_XN + al((size_t)M * D * 2);
constexpr size_t WS_Q = WS_H + al((size_t)M * FF * 2);
constexpr size_t WS_KK = WS_Q + al((size_t)M * D * 2);
constexpr size_t WS_V = WS_KK + al((size_t)M * D * 2);
constexpr size_t WS_G = WS_V + al((size_t)M * D * 2);
constexpr size_t WS_LF = WS_G + al((size_t)M * D * 2);
constexpr size_t WS_O = WS_LF + al((size_t)M * D * 4);
constexpr size_t WS_END = WS_O + al((size_t)M * D * 4);

constexpr int CW_BAR = 4096;

constexpr int RING_BYTES = 131072, LDSCTL_OFF = RING_BYTES, MISC_OFF = LDSCTL_OFF + 320, LDS_BYTES = 147456;

__device__ __forceinline__ unsigned f2bf(float f) { unsigned u = __builtin_bit_cast(unsigned, f); return (u + 0x7fffu + ((u >> 16) & 1u)) >> 16; }
__device__ __forceinline__ unsigned pk2(float lo, float hi) { return f2bf(lo) | (f2bf(hi) << 16); }
__device__ __forceinline__ float bf2f(unsigned short b) { return __builtin_bit_cast(float, ((unsigned)b) << 16); }
__device__ __forceinline__ float bflo(unsigned w) { return __builtin_bit_cast(float, w << 16); }
__device__ __forceinline__ float bfhi(unsigned w) { return __builtin_bit_cast(float, w & 0xffff0000u); }
__device__ __forceinline__ float wave_sum(float v) {
#pragma unroll
    for (int o = 1; o < 64; o <<= 1) v += __shfl_xor(v, o);
    return v;
}
__device__ __forceinline__ float fsigmoid(float x) { return __builtin_amdgcn_rcpf(1.f + __expf(-x)); }
__device__ __forceinline__ float fsilu(float x) { return x * fsigmoid(x); }
#define LDS_WAIT() asm volatile("s_waitcnt lgkmcnt(0)" ::: "memory")

#define XB_TMO      128
#define XB_XCNT(j)  (256  + 64 * (j))
#define XB_XSUB(j)  (1280 + 64 * (j))
#define XB_XGEN(j)  (2304 + 64 * (j))
#define XB_TOP      3328
#define XB_TOPGEN   3392
#define XCD_BAR_WORDS 3456
#define XB_SPIN_CAP (1u << 22)

__device__ __forceinline__ unsigned xb_ld(unsigned* p)              { return __hip_atomic_load(p, __ATOMIC_RELAXED, __HIP_MEMORY_SCOPE_AGENT); }
__device__ __forceinline__ unsigned xb_add(unsigned* p, unsigned v) { return __hip_atomic_fetch_add(p, v, __ATOMIC_RELAXED, __HIP_MEMORY_SCOPE_AGENT); }
__device__ __forceinline__ unsigned xb_xcc_id() { return (unsigned)__builtin_amdgcn_s_getreg((3 << 11) | 20) & 0xFu; }
#define XB_SPIN(cond, bar) do { unsigned _sp = 0; while (cond) { __builtin_amdgcn_s_sleep(1); \
    if ((++_sp & 255u) == 0u) { if (xb_ld(&(bar)[XB_TMO])) break; if (_sp > XB_SPIN_CAP) { atomicAdd(&(bar)[XB_TMO], 1u); break; } } } } while (0)

struct XcdBarrier { unsigned* bar; unsigned x; volatile LAS unsigned* st; };

__device__ __forceinline__ XcdBarrier xcd_barrier_post(unsigned* bar, volatile LAS unsigned* st) {
    XcdBarrier b; b.bar = bar; b.x = xb_xcc_id(); b.st = st;
    if (threadIdx.x == 0) (void)xb_add(&bar[XB_XCNT(b.x)], 1u);
    return b;
}
__device__ __forceinline__ void xcd_barrier_complete(unsigned* bar, unsigned x, unsigned& nloc, unsigned& nx) {
    const unsigned G = gridDim.x * gridDim.y * gridDim.z;
    unsigned sum, cnt, mine, sp = 0u;
    for (;;) {
        sum = 0u; cnt = 0u; mine = 0u;
#pragma unroll
        for (unsigned j = 0; j < 16; ++j) { const unsigned c = xb_ld(&bar[XB_XCNT(j)]); sum += c; cnt += (c > 0u) ? 1u : 0u; mine = (j == x) ? c : mine; }
        if (sum == G) break;
        __builtin_amdgcn_s_sleep(1);
        if ((++sp & 255u) == 0u) { if (xb_ld(&bar[XB_TMO])) break; if (sp > XB_SPIN_CAP) { atomicAdd(&bar[XB_TMO], 1u); break; } }
    }
    nloc = mine > 0u ? mine : 1u; nx = cnt > 0u ? cnt : 1u;
}
__device__ __forceinline__ void xcd_barrier(const XcdBarrier& b) {
    asm volatile("s_waitcnt vmcnt(0)" ::: "memory");
    __syncthreads();
    if (threadIdx.x == 0) {
        unsigned* bar = b.bar;
        __builtin_amdgcn_s_waitcnt(0);
        unsigned nloc = b.st[0], nx = b.st[1];
        if (nloc == 0u) { xcd_barrier_complete(bar, b.x, nloc, nx); b.st[0] = nloc; b.st[1] = nx; }
        const unsigned old = xb_add(&bar[XB_XSUB(b.x)], 1u);
        const unsigned gen = old / nloc;
        if (old + 1u == (gen + 1u) * nloc) {
            __builtin_amdgcn_fence(__ATOMIC_RELEASE, "agent");
            asm volatile("s_waitcnt vmcnt(0)" ::: "memory");
            const unsigned og = xb_add(&bar[XB_TOP], 1u);
            const unsigned tg = og / nx;
            if (og + 1u == (tg + 1u) * nx) xb_add(&bar[XB_TOPGEN], 1u);
            else XB_SPIN(xb_ld(&bar[XB_TOPGEN]) == tg, bar);
            __builtin_amdgcn_fence(__ATOMIC_ACQUIRE, "agent");
            xb_add(&bar[XB_XGEN(b.x)], 1u);
            asm volatile("s_waitcnt vmcnt(0)" ::: "memory");
        } else {
            XB_SPIN(xb_ld(&bar[XB_XGEN(b.x)]) == gen, bar);
            __builtin_amdgcn_fence(__ATOMIC_ACQUIRE, "agent");
            asm volatile("s_waitcnt vmcnt(0)" ::: "memory");
        }
    }
    __syncthreads();
}

namespace pg8 {
constexpr int BM = 256, BK = 64, HALF = 128, HTB = HALF * BK * 2, STAGE_BYTES = 8 * HTB, NXCD = 8, WGM = 8;
__host__ __device__ __forceinline__ int lds_byte(int r, int c) { const int st = (r >> 4) * 2 + (c >> 5), rr = r & 15, cc = c & 31, ob = rr * 64 + cc * 2; return st * 1024 + (ob ^ (((ob >> 9) & 1) << 5)); }
__host__ __device__ __forceinline__ void stage_rc(int b, int& R, int& C) { const int st = b / 1024, sb = b % 1024, swz = sb ^ (((sb >> 9) & 1) << 5); R = (st >> 1) * 16 + swz / 64; C = (st & 1) * 32 + (swz % 64) / 2; }
__host__ __device__ __forceinline__ int perm32(int rho) { const int n = rho >> 4, i = rho & 15; return 8 * (i >> 2) + 4 * n + (i & 3); }

struct Unit { int pm, pn; };
struct Gemm { const bf16_t* A; const bf16_t* Bt; int lda, ldb, K, nM, nN, grp; };

struct StaticOrder {
    int nM, nN, nwg, G, c;
    __device__ void init(int nM_, int nN_, int G_, int c_) { nM = nM_; nN = nN_; nwg = nM * nN; G = G_; c = c_; }
    __device__ bool next(int i, Unit& u) const {
        const long L = (long)i * G + c; if (L >= nwg) return false;
        int wgid = (int)L; { const int q = nwg / NXCD, r = nwg % NXCD, xcd = wgid % NXCD, off = wgid / NXCD; wgid = (xcd < r ? xcd * (q + 1) : r * (q + 1) + (xcd - r) * q) + off; }
        const int nig = WGM * nN, gid = wgid / nig, fm = gid * WGM, gsz = (nM - fm) < WGM ? (nM - fm) : WGM;
        u.pm = fm + ((wgid % nig) % gsz); u.pn = (wgid % nig) / gsz; return true;
    }
};

template <class Epi>
__device__ __forceinline__ void gemm_phase(LAS unsigned char* lds, const Gemm g, const StaticOrder& S, const Epi& E, const int tid) {
    const int wid = __builtin_amdgcn_readfirstlane(tid >> 6), lane = tid & 63, wr = wid >> 2, wc = wid & 3, fr = lane & 15, fq = lane >> 4;
    const int K = g.K, nt = K / BK;
    unsigned voffA[2], voffB[2];
#pragma unroll
    for (int i = 0; i < 2; ++i) { int R, C; stage_rc(tid * 16 + i * 8192, R, C); const int Rb = (R & ~31) + perm32(R & 31);
        voffA[i] = (unsigned)(R * g.lda + C) * 2u; voffB[i] = (unsigned)(Rb * g.ldb + C) * 2u; }
    const size_t kstep = (size_t)(BK * 2);
    const size_t hstepA = (size_t)HALF * g.lda * 2, hstepB = (size_t)HALF * g.ldb * 2;
    const size_t tstepA = 2 * hstepA, tstepB = 2 * hstepB;
    const unsigned ldsw = (unsigned)wid * 1024u;
    const int aoff = lds_byte(wr * 64 + fr, fq * 8), boff = lds_byte(wc * 32 + fr, fq * 8);
#define PG8_SA(b, h) (((b) * 2 + (h)) * HTB)
#define PG8_SB(b, h) ((4 + (b) * 2 + (h)) * HTB)
#define PG8_STAGE(bufoff, gbase, voff) do { _Pragma("unroll") for (int _i = 0; _i < 2; ++_i) \
        __builtin_amdgcn_global_load_lds((const unsigned*)((const char*)(gbase) + (voff)[_i]), (LAS unsigned*)(lds + (bufoff) + ldsw + _i * 8192), 16, 0, 0); } while (0)
#define PG8_LDA(dst, b, h) do { _Pragma("unroll") for (int m = 0; m < 4; ++m) _Pragma("unroll") for (int k = 0; k < 2; ++k) dst[m][k] = *(const LAS bf16x8*)(lds + PG8_SA(b, h) + aoff + m * 2048 + k * 1024); } while (0)
#define PG8_LDB(dst, b, h) do { _Pragma("unroll") for (int n = 0; n < 2; ++n) _Pragma("unroll") for (int k = 0; k < 2; ++k) dst[n][k] = *(const LAS bf16x8*)(lds + PG8_SB(b, h) + boff + n * 2048 + k * 1024); } while (0)
#define PG8_MMA(ai, bj, At, Bt) do { __builtin_amdgcn_s_setprio(1); _Pragma("unroll") for (int m = 0; m < 4; ++m) _Pragma("unroll") for (int n = 0; n < 2; ++n) _Pragma("unroll") for (int k = 0; k < 2; ++k) \
        acc[ai][bj][m][n] = __builtin_amdgcn_mfma_f32_16x16x32_bf16(Bt[n][k], At[m][k], acc[ai][bj][m][n], 0, 0, 0); __builtin_amdgcn_s_setprio(0); } while (0)
#define PG8_WAIT_V(n) asm volatile("s_waitcnt vmcnt(" #n ")" ::: "memory")
#define PG8_WAIT_L(n) asm volatile("s_waitcnt lgkmcnt(" #n ")" ::: "memory")
#define PG8_BAR __builtin_amdgcn_s_barrier()
#define PG8_SCHED __builtin_amdgcn_sched_barrier(0)
#define PG8_ABASE(u) ((const char*)g.A + (size_t)(u).pm * tstepA + (g.grp ? (size_t)((u).pn >> 1) * (size_t)K * 2 : (size_t)0))
#define PG8_BBASE(u) ((const char*)g.Bt + (size_t)(u).pn * tstepB)
    Unit cur, nxt; int ui = 0;
    if (!S.next(0, cur)) return;
    f32x4 acc[2][2][4][2];
#pragma unroll
    for (int a = 0; a < 2; ++a)
#pragma unroll
        for (int b = 0; b < 2; ++b)
#pragma unroll
            for (int m = 0; m < 4; ++m)
#pragma unroll
                for (int n = 0; n < 2; ++n) acc[a][b][m][n] = (f32x4){0.f, 0.f, 0.f, 0.f};
    bf16x8 At[4][2], B0[2][2], B1[2][2];
    const char* cA = PG8_ABASE(cur); const char* cB = PG8_BBASE(cur);
    PG8_STAGE(PG8_SB(0, 0), cB, voffB); PG8_STAGE(PG8_SB(0, 1), cB + hstepB, voffB); PG8_STAGE(PG8_SA(0, 0), cA, voffA); PG8_STAGE(PG8_SA(0, 1), cA + hstepA, voffA);
    if (wr == 1) PG8_BAR;
    PG8_WAIT_V(2); PG8_BAR;
    PG8_STAGE(PG8_SB(1, 0), cB + kstep, voffB); PG8_STAGE(PG8_SA(1, 0), cA + kstep, voffA); PG8_STAGE(PG8_SB(1, 1), cB + hstepB + kstep, voffB);
    PG8_WAIT_V(6); PG8_BAR;
    for (;;) {
        const bool has_next = S.next(ui + 1, nxt);
        const char* nA = has_next ? PG8_ABASE(nxt) : cA; const char* nB = has_next ? PG8_BBASE(nxt) : cB;
        for (int t = 0; t < nt; t += 2) {
            const bool last = (t == nt - 2);
            const char* a1 = cA + (size_t)(t + 1) * kstep;
            const char* a2 = last ? nA : cA + (size_t)(t + 2) * kstep; const char* b2 = last ? nB : cB + (size_t)(t + 2) * kstep;
            const char* a3 = a2 + kstep; const char* b3 = b2 + kstep;
            PG8_LDB(B0, 0, 0); PG8_LDB(B1, 0, 1); PG8_SCHED; PG8_LDA(At, 0, 0); PG8_STAGE(PG8_SA(1, 1), a1 + hstepA, voffA);
            PG8_WAIT_V(8); PG8_WAIT_L(0); PG8_BAR; PG8_MMA(0, 0, At, B0); PG8_MMA(0, 1, At, B1); PG8_BAR; PG8_SCHED;
            PG8_LDA(At, 0, 1); PG8_STAGE(PG8_SB(0, 0), b2, voffB); PG8_STAGE(PG8_SB(0, 1), b2 + hstepB, voffB); PG8_STAGE(PG8_SA(0, 0), a2, voffA);
            PG8_WAIT_V(8); PG8_WAIT_L(0); PG8_BAR; PG8_MMA(1, 0, At, B0); PG8_MMA(1, 1, At, B1); PG8_BAR; PG8_SCHED;
            PG8_LDB(B0, 1, 0); PG8_LDB(B1, 1, 1); PG8_SCHED; PG8_LDA(At, 1, 0); PG8_STAGE(PG8_SA(0, 1), a2 + hstepA, voffA);
            PG8_WAIT_V(8); PG8_WAIT_L(0); PG8_BAR; PG8_MMA(0, 0, At, B0); PG8_MMA(0, 1, At, B1); PG8_BAR; PG8_SCHED;
            PG8_LDA(At, 1, 1); PG8_STAGE(PG8_SB(1, 0), b3, voffB); PG8_STAGE(PG8_SB(1, 1), b3 + hstepB, voffB); PG8_STAGE(PG8_SA(1, 0), a3, voffA);
            PG8_WAIT_V(8); PG8_WAIT_L(0); PG8_BAR; PG8_MMA(1, 0, At, B0); PG8_MMA(1, 1, At, B1); PG8_BAR; PG8_SCHED;
        }
        if (wr == 0) PG8_BAR;
        E(acc, cur, wr, wc, fr, fq);
        if (!has_next) break;
#pragma unroll
        for (int a = 0; a < 2; ++a)
#pragma unroll
            for (int b = 0; b < 2; ++b)
#pragma unroll
                for (int m = 0; m < 4; ++m)
#pragma unroll
                    for (int n = 0; n < 2; ++n) acc[a][b][m][n] = (f32x4){0.f, 0.f, 0.f, 0.f};
        cur = nxt; cA = nA; cB = nB; ++ui;
        if (wr == 1) PG8_BAR;
    }
    PG8_WAIT_V(0);
    PG8_BAR;
#undef PG8_SA
#undef PG8_SB
#undef PG8_STAGE
#undef PG8_LDA
#undef PG8_LDB
#undef PG8_MMA
#undef PG8_WAIT_V
#undef PG8_WAIT_L
#undef PG8_BAR
#undef PG8_SCHED
#undef PG8_ABASE
#undef PG8_BBASE
}
}

__device__ __forceinline__ unsigned cvt_pk_bf16(float lo, float hi) { unsigned r; asm volatile("v_cvt_pk_bf16_f32 %0, %1, %2" : "=v"(r) : "v"(lo), "v"(hi)); return r; }
typedef f32x4 AccT[2][2][4][2];

struct EpiGU {
    bf16_t* H;
    __device__ __forceinline__ void operator()(const AccT& acc, const pg8::Unit& u, int wr, int wc, int fr, int fq) const {
        const int row0 = u.pm * 256 + wr * 64 + fr, col0 = u.pn * 128 + wc * 32 + 8 * fq;
#pragma unroll
        for (int ai = 0; ai < 2; ++ai)
#pragma unroll
            for (int m = 0; m < 4; ++m) {
                bf16_t* rowp = H + (size_t)(row0 + ai * 128 + m * 16) * FF + col0;
                float hv[8];
#pragma unroll
                for (int n = 0; n < 2; ++n)
#pragma unroll
                    for (int j = 0; j < 4; ++j) { const float gv = acc[ai][0][m][n][j], uv = acc[ai][1][m][n][j]; hv[n * 4 + j] = fsilu(gv) * uv; }
                u32x4 w; w.x = cvt_pk_bf16(hv[0], hv[1]); w.y = cvt_pk_bf16(hv[2], hv[3]); w.z = cvt_pk_bf16(hv[4], hv[5]); w.w = cvt_pk_bf16(hv[6], hv[7]);
                *(u32x4*)rowp = w;
            }
    }
};
struct EpiRes {
    float* X; float alpha; const float* colscale;
    __device__ __forceinline__ void operator()(const AccT& acc, const pg8::Unit& u, int wr, int wc, int fr, int fq) const {
        const int row0 = u.pm * 256 + wr * 64 + fr, col0 = u.pn * 256 + wc * 32 + 8 * fq;
        f32x4 cs[2][2];
#pragma unroll
        for (int bj = 0; bj < 2; ++bj)
#pragma unroll
            for (int n = 0; n < 2; ++n) { cs[bj][n] = colscale ? *(const f32x4*)(colscale + col0 + bj * 128 + 4 * n) : (f32x4){1.f, 1.f, 1.f, 1.f}; cs[bj][n] = cs[bj][n] * alpha; }
#pragma unroll
        for (int ai = 0; ai < 2; ++ai)
#pragma unroll
            for (int m = 0; m < 4; ++m) {
                float* rowp = X + (size_t)(row0 + ai * 128 + m * 16) * D + col0;
#pragma unroll
                for (int bj = 0; bj < 2; ++bj)
#pragma unroll
                    for (int n = 0; n < 2; ++n) { f32x4* p = (f32x4*)(rowp + bj * 128 + 4 * n); *p = *p + cs[bj][n] * acc[ai][bj][m][n]; }
            }
    }
};
struct EpiHG {
    bf16_t *Q, *KK, *V, *G; float* LF; const float* lb;
    __device__ __forceinline__ void operator()(const AccT& acc, const pg8::Unit& u, int wr, int wc, int fr, int fq) const {
        const int row0 = u.pm * 256 + wr * 64 + fr, reg = u.pn >> 3, col0 = (u.pn & 7) * 256 + wc * 32 + 8 * fq;
        float lbv[2][8];
#pragma unroll
        for (int bj = 0; bj < 2; ++bj)
#pragma unroll
            for (int j = 0; j < 8; ++j) lbv[bj][j] = (reg == 1) ? lb[col0 + bj * 128 + j] : 0.f;
#pragma unroll
        for (int ai = 0; ai < 2; ++ai)
#pragma unroll
            for (int m = 0; m < 4; ++m) {
                const size_t ro = (size_t)(row0 + ai * 128 + m * 16) * D + col0;
#pragma unroll
                for (int bj = 0; bj < 2; ++bj) {
                    float a[8], o[8];
#pragma unroll
                    for (int n = 0; n < 2; ++n)
#pragma unroll
                        for (int j = 0; j < 4; ++j) a[n * 4 + j] = acc[ai][bj][m][n][j];
                    bf16_t* dst;
                    if (reg == 0) { dst = Q;
#pragma unroll
                        for (int j = 0; j < 8; ++j) o[j] = fsilu(a[j]) * 0.08838834764831845f;
                    } else if (reg == 1) { dst = KK; float lf[8];
#pragma unroll
                        for (int j = 0; j < 8; ++j) { const float f = fminf(fmaxf(a[j], -80.f), 80.f), e = __expf(-f), sig = __builtin_amdgcn_rcpf(1.f + e), l = lbv[bj][j];
                            lf[j] = __logf(l + (1.f - l) * sig); o[j] = (1.f - l) * e * sig; }
                        float* lp = LF + ro + bj * 128;
                        *(f32x4*)lp = (f32x4){lf[0], lf[1], lf[2], lf[3]}; *(f32x4*)(lp + 4) = (f32x4){lf[4], lf[5], lf[6], lf[7]};
                    } else if (reg == 2) { dst = V;
#pragma unroll
                        for (int j = 0; j < 8; ++j) o[j] = a[j];
                    } else { dst = G;
#pragma unroll
                        for (int j = 0; j < 8; ++j) o[j] = fsilu(a[j]);
                    }
                    u32x4 w; w.x = cvt_pk_bf16(o[0], o[1]); w.y = cvt_pk_bf16(o[2], o[3]); w.z = cvt_pk_bf16(o[4], o[5]); w.w = cvt_pk_bf16(o[6], o[7]);
                    *(u32x4*)(dst + ro + bj * 128) = w;
                }
            }
    }
};
struct EpiGLA {
    bf16_t *Q, *KK, *V, *G; float* LF; const float* bgate;
    __device__ __forceinline__ void operator()(const AccT& acc, const pg8::Unit& u, int wr, int wc, int fr, int fq) const {
        const int pn = u.pn; int reg, cbase;
        if (pn < 4) { reg = 0; cbase = pn * 256; } else if (pn < 8) { reg = 1; cbase = (pn - 4) * 256; } else if (pn < 16) { reg = 2; cbase = (pn - 8) * 256; }
        else if (pn < 24) { reg = 3; cbase = (pn - 16) * 256; } else { reg = 4; cbase = (pn - 24) * 256; }
        const int row0 = u.pm * 256 + wr * 64 + fr, col0 = cbase + wc * 32 + 8 * fq;
        float bg[2][8];
#pragma unroll
        for (int bj = 0; bj < 2; ++bj)
#pragma unroll
            for (int j = 0; j < 8; ++j) bg[bj][j] = (reg == 4) ? bgate[col0 + bj * 128 + j] : 0.f;
#pragma unroll
        for (int ai = 0; ai < 2; ++ai)
#pragma unroll
            for (int m = 0; m < 4; ++m) {
                const size_t ro = (size_t)(row0 + ai * 128 + m * 16) * D + col0;
#pragma unroll
                for (int bj = 0; bj < 2; ++bj) {
                    float a[8], o[8];
#pragma unroll
                    for (int n = 0; n < 2; ++n)
#pragma unroll
                        for (int j = 0; j < 4; ++j) a[n * 4 + j] = acc[ai][bj][m][n][j];
                    if (reg == 4) {
                        float lf[8];
#pragma unroll
                        for (int j = 0; j < 8; ++j) { const float z = a[j] + bg[bj][j]; lf[j] = (fminf(z, 0.f) - __logf(1.f + __expf(-fabsf(z)))) * 0.0625f; }
                        float* lp = LF + ro + bj * 128;
                        *(f32x4*)lp = (f32x4){lf[0], lf[1], lf[2], lf[3]}; *(f32x4*)(lp + 4) = (f32x4){lf[4], lf[5], lf[6], lf[7]};
                    } else {
                        bf16_t* dst;
                        if (reg == 0) { dst = Q;
#pragma unroll
                            for (int j = 0; j < 8; ++j) o[j] = a[j] * 0.0625f;
                        } else if (reg == 1) { dst = KK;
#pragma unroll
                            for (int j = 0; j < 8; ++j) o[j] = a[j];
                        } else if (reg == 2) { dst = V;
#pragma unroll
                            for (int j = 0; j < 8; ++j) o[j] = a[j];
                        } else { dst = G;
#pragma unroll
                            for (int j = 0; j < 8; ++j) o[j] = fsilu(a[j]);
                        }
                        u32x4 w; w.x = cvt_pk_bf16(o[0], o[1]); w.y = cvt_pk_bf16(o[2], o[3]); w.z = cvt_pk_bf16(o[4], o[5]); w.w = cvt_pk_bf16(o[6], o[7]);
                        *(u32x4*)(dst + ro + bj * 128) = w;
                    }
                }
            }
    }
};

struct Params { const float* in[26]; float* out; unsigned char* ws; int ph_lo, ph_hi; };
typedef const Params __attribute__((address_space(4))) CParams;
enum { I_XP = 0, I_XS, I_SHG, I_SGLA, I_SPOOL, I_NF1, I_F1G, I_F1U, I_F1D, I_NMIX, I_NF2, I_F2G, I_F2U, I_F2D, I_LBL, I_HWIN, I_HON, I_HWOUT, I_GWIN, I_GWGU, I_GBG, I_GON, I_GWOUT, I_PWG, I_PSC, I_FN };

template <class Src>
__device__ __forceinline__ void transpose_item(const Src& src, int K, bf16_t* WT, int dst_row0, int k0, int n0, LAS float* scr, int lane) {
#pragma unroll 8
    for (int i = 0; i < 32; ++i) { const int kk = 2 * i + (lane >> 5); scr[kk * 33 + (lane & 31)] = src(k0 + kk, n0 + (lane & 31)); }
    LDS_WAIT(); asm volatile("" ::: "memory");
    const int c = lane & 7;
#pragma unroll
    for (int j = 0; j < 4; ++j) { const int n = (lane >> 3) + 8 * j; const LAS float* s = scr + (8 * c) * 33 + n;
        u32x4 o; o.x = pk2(s[0 * 33], s[1 * 33]); o.y = pk2(s[2 * 33], s[3 * 33]); o.z = pk2(s[4 * 33], s[5 * 33]); o.w = pk2(s[6 * 33], s[7 * 33]);
        *(u32x4*)(WT + (size_t)(dst_row0 + n) * K + k0 + 8 * c) = o; }
    LDS_WAIT(); asm volatile("" ::: "memory");
}
struct SrcPlain { const float* W; int ld; __device__ __forceinline__ float operator()(int k, int n) const { return W[(size_t)k * ld + n]; } };
struct SrcGlaGate { const float* win; const float* wgu;
    __device__ __forceinline__ float operator()(int k, int n) const { float s = 0.f;
#pragma unroll
        for (int r = 0; r < 16; ++r) s += win[(size_t)k * GL_WIN_LD + 6144 + r] * wgu[r * GL_DK + n];
        return s; } };

__device__ __forceinline__ void prologue_phase(CParams* P, LAS unsigned char* lds, int gw, int NGW, int wave, int lane) {
    unsigned char* ws = P->ws;
    LAS float* scr = (LAS float*)(lds + wave * 16384);
    constexpr int IT_FFN = (D / 64) * (FF / 32);
    constexpr int IT_HIN = (D / 64) * (8192 / 32), IT_DD = (D / 64) * (D / 32), IT_GIN = (D / 64) * (6144 / 32), IT_GG = (D / 64) * (GL_DK / 32), IT_PL = (512 / 64) * (512 / 32);
    constexpr int N_FFN = 24 * IT_FFN, N_H = 2 * IT_HIN + 2 * IT_DD, N_G = IT_GIN + IT_GG + IT_DD, N_P = 4 * IT_PL;
    constexpr int NITEMS = N_FFN + N_H + N_G + N_P;
    for (int it = gw; it < NITEMS; it += NGW) {
        int r = it;
        if (r < N_FFN) {
            const int mat = r / IT_FFN, item = r % IT_FFN, s = mat / 3, kind = mat % 3, li = s >> 1, which = s & 1;
            if (kind < 2) {
                const float* W = P->in[(which ? I_F2G : I_F1G) + kind] + (size_t)li * D * FF;
                const int nblk = FF / 32, kb = item / nblk, nb = item % nblk, n0 = nb * 32;
                SrcPlain src{W, FF};
                transpose_item(src, D, (bf16_t*)(ws + WS_WGU + (size_t)s * SZ_WGU1), (n0 >> 7) * 256 + (n0 & 127) + kind * 128, kb * 64, n0, scr, lane);
            } else {
                const float* W = P->in[which ? I_F2D : I_F1D] + (size_t)li * FF * D;
                const int nblk = D / 32, kb = item / nblk, nb = item % nblk;
                SrcPlain src{W, D};
                transpose_item(src, FF, (bf16_t*)(ws + WS_WDN + (size_t)s * SZ_WDN1), nb * 32, kb * 64, nb * 32, scr, lane);
            }
            continue;
        }
        r -= N_FFN;
        if (r < N_H) {
            if (r < 2 * IT_HIN) { const int j = r / IT_HIN, item = r % IT_HIN, nblk = 8192 / 32, kb = item / nblk, nb = item % nblk;
                SrcPlain src{P->in[I_HWIN] + (size_t)j * D * 8192, 8192};
                transpose_item(src, D, (bf16_t*)(ws + WS_WHIN) + (size_t)j * 8192 * D, nb * 32, kb * 64, nb * 32, scr, lane);
            } else { r -= 2 * IT_HIN; const int j = r / IT_DD, item = r % IT_DD, nblk = D / 32, kb = item / nblk, nb = item % nblk;
                SrcPlain src{P->in[I_HWOUT] + (size_t)j * D * D, D};
                transpose_item(src, D, (bf16_t*)(ws + WS_WHOUT) + (size_t)j * D * D, nb * 32, kb * 64, nb * 32, scr, lane);
            }
            continue;
        }
        r -= N_H;
        if (r < N_G) {
            if (r < IT_GIN) { const int nblk = 6144 / 32, kb = r / nblk, nb = r % nblk;
                SrcPlain src{P->in[I_GWIN], GL_WIN_LD};
                transpose_item(src, D, (bf16_t*)(ws + WS_WGIN), nb * 32, kb * 64, nb * 32, scr, lane);
            } else if (r < IT_GIN + IT_GG) { r -= IT_GIN; const int nblk = GL_DK / 32, kb = r / nblk, nb = r % nblk;
                SrcGlaGate src{P->in[I_GWIN], P->in[I_GWGU]};
                transpose_item(src, D, (bf16_t*)(ws + WS_WGIN), 6144 + nb * 32, kb * 64, nb * 32, scr, lane);
            } else { r -= IT_GIN + IT_GG; const int nblk = D / 32, kb = r / nblk, nb = r % nblk;
                SrcPlain src{P->in[I_GWOUT], D};
                transpose_item(src, D, (bf16_t*)(ws + WS_WGOUT), nb * 32, kb * 64, nb * 32, scr, lane);
            }
            continue;
        }
        r -= N_G;
        { const int gi = r / IT_PL, item = r % IT_PL, nblk = 512 / 32, kb = item / nblk, nb = item % nblk;
          SrcPlain src{P->in[I_PWG] + (size_t)gi * 512 * 512, 512};
          transpose_item(src, 512, (bf16_t*)(ws + WS_WPOOL), gi * 512 + nb * 32, kb * 64, nb * 32, scr, lane); }
    }
    {
        float* X = (float*)(ws + WS_X);
        const size_t n4 = (size_t)M * D / 4, np4 = (size_t)MP * D / 4;
        for (size_t i = (size_t)gw * 64 + lane; i < n4; i += (size_t)NGW * 64) {
            const f32x4 v = i < np4 ? ((const f32x4*)P->in[I_XP])[i] : ((const f32x4*)P->in[I_XS])[i - np4];
            ((f32x4*)X)[i] = v;
        }
    }
    {
        float* TAB = (float*)(ws + WS_TAB);
        for (int c = gw * 64 + lane; c < D; c += NGW * 64) {
            float l[4], mx = -1e30f;
#pragma unroll
            for (int i = 0; i < 4; ++i) { l[i] = P->in[I_LBL][i * D + c]; mx = fmaxf(mx, l[i]); }
            float e[4], s = 0.f;
#pragma unroll
            for (int i = 0; i < 4; ++i) { e[i] = __expf(l[i] - mx); s += e[i]; }
            TAB[c] = 0.f;
            TAB[D + c] = (e[1] + e[2] + e[3]) / s;
        }
    }
}

__device__ __forceinline__ void norm_phase(const float* X, const float* gain, bf16_t* XN, int gw, int NGW, int lane) {
    for (int m = gw; m < M; m += NGW) {
        const f32x4* xr = (const f32x4*)(X + (size_t)m * D) + lane;
        f32x4 v[8]; float s = 0.f;
#pragma unroll
        for (int j = 0; j < 8; ++j) { v[j] = xr[64 * j]; s += (v[j].x * v[j].x + v[j].y * v[j].y) + (v[j].z * v[j].z + v[j].w * v[j].w); }
        const float r = __builtin_amdgcn_rsqf(wave_sum(s) * (1.f / D) + EPS);
        const f32x4* gr = (const f32x4*)gain + lane;
        u32x2* o = (u32x2*)(XN + (size_t)m * D) + lane;
#pragma unroll
        for (int j = 0; j < 8; ++j) { const f32x4 g = gr[64 * j]; u32x2 w; w.x = pk2(v[j].x * r * g.x, v[j].y * r * g.y); w.y = pk2(v[j].z * r * g.z, v[j].w * r * g.w); o[64 * j] = w; }
    }
}
__device__ __forceinline__ void final_phase(const float* X, const float* gain, float* Y, int gw, int NGW, int lane) {
    for (int m = gw; m < M; m += NGW) {
        const f32x4* xr = (const f32x4*)(X + (size_t)m * D) + lane;
        f32x4 v[8]; float s = 0.f;
#pragma unroll
        for (int j = 0; j < 8; ++j) { v[j] = xr[64 * j]; s += (v[j].x * v[j].x + v[j].y * v[j].y) + (v[j].z * v[j].z + v[j].w * v[j].w); }
        const float r = __builtin_amdgcn_rsqf(wave_sum(s) * (1.f / D) + EPS);
        const f32x4* gr = (const f32x4*)gain + lane;
        f32x4* o = (f32x4*)(Y + (size_t)m * D) + lane;
#pragma unroll
        for (int j = 0; j < 8; ++j) o[64 * j] = v[j] * r * gr[64 * j];
    }
}
template <int NG>
__device__ __forceinline__ void post_phase(const float* O, const float* gain, const bf16_t* G, bf16_t* OG, int gw, int NGW, int lane) {
    for (int m = gw; m < M; m += NGW) {
        const f32x4* xr = (const f32x4*)(O + (size_t)m * D) + lane;
        f32x4 v[8]; float s[NG];
#pragma unroll
        for (int g = 0; g < NG; ++g) s[g] = 0.f;
#pragma unroll
        for (int j = 0; j < 8; ++j) { v[j] = xr[64 * j]; s[j * NG / 8] += (v[j].x * v[j].x + v[j].y * v[j].y) + (v[j].z * v[j].z + v[j].w * v[j].w); }
        float r[NG];
#pragma unroll
        for (int g = 0; g < NG; ++g) r[g] = __builtin_amdgcn_rsqf(wave_sum(s[g]) * ((float)NG / D) + EPS);
        const f32x4* gr = (const f32x4*)gain + lane;
        const u32x2* gg = (const u32x2*)(G + (size_t)m * D) + lane;
        u32x2* o = (u32x2*)(OG + (size_t)m * D) + lane;
#pragma unroll
        for (int j = 0; j < 8; ++j) { const f32x4 g = gr[64 * j]; const u32x2 gw2 = gg[64 * j]; const float rr = r[j * NG / 8];
            u32x2 w; w.x = pk2(v[j].x * rr * g.x * bflo(gw2.x), v[j].y * rr * g.y * bfhi(gw2.x)); w.y = pk2(v[j].z * rr * g.z * bflo(gw2.y), v[j].w * rr * g.w * bfhi(gw2.y)); o[64 * j] = w; }
    }
}

template <int KT> struct LdBf;
template <> struct LdBf<4> { static __device__ __forceinline__ void ld(const bf16_t* p, float* o) { const u32x2 w = *(const u32x2*)p; o[0] = bflo(w.x); o[1] = bfhi(w.x); o[2] = bflo(w.y); o[3] = bfhi(w.y); } };
template <> struct LdBf<8> { static __device__ __forceinline__ void ld(const bf16_t* p, float* o) { const u32x4 w = *(const u32x4*)p; o[0] = bflo(w.x); o[1] = bfhi(w.x); o[2] = bflo(w.y); o[3] = bfhi(w.y); o[4] = bflo(w.z); o[5] = bfhi(w.z); o[6] = bflo(w.w); o[7] = bfhi(w.w); } };
template <int K, int VH, int NH>
__device__ __forceinline__ void scan_simple(const bf16_t* Q, const bf16_t* KK, const float* LF, const bf16_t* V, float* O,
                                            const float* S0, float* SPo, float* SSo, int tid, int G) {
    constexpr int KT = K / 32, NVB = VH / 16;
    const int vi = tid >> 5, kg = tid & 31;
    const int nunits = (PB + SB) * NH * NVB;
    for (int u = blockIdx.x; u < nunits; u += G) {
        const int seq = u / (NH * NVB), rem = u % (NH * NVB), h = rem / NVB, vb = rem % NVB;
        int row0, T; if (seq < PB) { row0 = seq * PT; T = PT; } else { row0 = MP + (seq - PB) * ST; T = ST; }
        float S[KT];
        const size_t sidx = ((size_t)h * K + kg * KT) * VH + vb * 16 + vi;
        if (seq >= PB) { const float* s0 = S0 + (size_t)(seq - PB) * NH * K * VH + sidx;
#pragma unroll
            for (int j = 0; j < KT; ++j) S[j] = s0[(size_t)j * VH]; }
        else {
#pragma unroll
            for (int j = 0; j < KT; ++j) S[j] = 0.f; }
        const int ccol = h * K + kg * KT, vcol = h * VH + vb * 16 + vi;
#pragma unroll 4
        for (int t = 0; t < T; ++t) {
            const size_t r = (size_t)(row0 + t) * D;
            float qf[KT], kf[KT], lf[KT];
            LdBf<KT>::ld(Q + r + ccol, qf); LdBf<KT>::ld(KK + r + ccol, kf);
#pragma unroll
            for (int j = 0; j < KT; j += 4) { const f32x4 l4 = *(const f32x4*)(LF + r + ccol + j); lf[j] = l4.x; lf[j + 1] = l4.y; lf[j + 2] = l4.z; lf[j + 3] = l4.w; }
            const float vv = bf2f(V[r + vcol]);
            float po = 0.f;
#pragma unroll
            for (int j = 0; j < KT; ++j) { S[j] = __expf(lf[j]) * S[j] + kf[j] * vv; po += qf[j] * S[j]; }
#pragma unroll
            for (int o = 1; o < 32; o <<= 1) po += __shfl_xor(po, o);
            if (kg == 0) O[r + vcol] = po;
        }
        float* so = (seq < PB ? SPo + (size_t)seq * NH * K * VH : SSo + (size_t)(seq - PB) * NH * K * VH) + sidx;
#pragma unroll
        for (int j = 0; j < KT; ++j) so[(size_t)j * VH] = S[j];
    }
}

template <int NR>
__device__ __forceinline__ void pool_segment(const float* X, int row0, int tabs0  , const float* hsrc, const LAS float* rs  ,
                                             const f32x4 gain, int w, bool is_prompt, bf16_t* Y, float* pstate  , float* sstate  , int c0) {
    f32x4 ring[16]; f32x4 wsum = (f32x4){0.f, 0.f, 0.f, 0.f};
#pragma unroll
    for (int i = 0; i < 16; ++i) ring[i] = (f32x4){0.f, 0.f, 0.f, 0.f};
#pragma unroll
    for (int i = 0; i < 15 + NR; ++i) {
        f32x4 val;
        if (i < 15) {
            if (hsrc) val = *(const f32x4*)(hsrc + (size_t)i * D + c0);
            else { const int t = tabs0 - 15 + i; val = (t >= 0) ? *(const f32x4*)(X + (size_t)(row0 - 15 + i) * D + c0) * rs[i] * gain : (f32x4){0.f, 0.f, 0.f, 0.f}; }
        } else val = *(const f32x4*)(X + (size_t)(row0 + i - 15) * D + c0) * rs[i] * gain;
        const f32x4 old = (w == 2) ? ring[(i - 2) & 15] : (w == 4) ? ring[(i - 4) & 15] : (w == 8) ? ring[(i - 8) & 15] : ring[i & 15];
        wsum = wsum + val - old;
        ring[i & 15] = val;
        if (i >= 15) {
            const int t = i - 15;
            float cnt = (float)w; if (is_prompt) { const int have = tabs0 + t + 1; cnt = (float)(have < w ? have : w); }
            const float ic = 1.f / cnt;
            const f32x4 y = wsum * ic - val;
            u32x2 o; o.x = pk2(y.x, y.y); o.y = pk2(y.z, y.w);
            *(u32x2*)(Y + (size_t)(row0 + t) * D + c0) = o;
            if (is_prompt) { if (pstate) { const int tt = tabs0 + t - (PT - POOLBUF); if (tt >= 0) *(f32x4*)(pstate + (size_t)tt * D + c0) = val; } }
            else *(f32x4*)(sstate + (size_t)(7 + t) * D + c0) = val;
        }
    }
    if (!is_prompt) {
#pragma unroll
        for (int i = 0; i < 7; ++i) *(f32x4*)(sstate + (size_t)i * D + c0) = *(const f32x4*)(hsrc + (size_t)(8 + i) * D + c0);
    }
}
__device__ __forceinline__ void pool_pre_phase(CParams* P, LAS unsigned char* lds, const float* X, const float* gain, bf16_t* Y, int tid, int wave, int lane, int G) {
    LAS float* rs = (LAS float*)lds;
    const int c0 = tid * 4, w = 2 << (c0 >> 9);
    const f32x4 g4 = *(const f32x4*)(gain + c0);
    for (int u = blockIdx.x; u < M / 32; u += G) {
        const int r0 = u * 32; const bool is_prompt = r0 < MP;
        __syncthreads();
        for (int i = wave; i < 47; i += NWAVES) {
            const int row = r0 - 15 + i;
            const bool need = is_prompt ? ((r0 % PT) - 15 + i >= 0) : (i >= 15);
            float r = 0.f;
            if (need) { const f32x4* xr = (const f32x4*)(X + (size_t)row * D) + lane; float s = 0.f;
#pragma unroll
                for (int j = 0; j < 8; ++j) { const f32x4 v = xr[64 * j]; s += (v.x * v.x + v.y * v.y) + (v.z * v.z + v.w * v.w); }
                r = __builtin_amdgcn_rsqf(wave_sum(s) * (1.f / D) + EPS); }
            if (lane == 0) rs[i] = r;
        }
        __syncthreads();
        if (is_prompt) {
            const int b = r0 / PT, t0 = r0 % PT;
            float* pst = (t0 + 32 == PT) ? P->out + OUT_POOL_P + (size_t)b * POOLBUF * D : nullptr;
            pool_segment<32>(X, r0, t0, nullptr, rs, g4, w, true, Y, pst, nullptr, c0);
        } else {
            for (int sgi = 0; sgi < 4; ++sgi) {
                const int b = (r0 - MP) / ST + sgi;
                pool_segment<8>(X, r0 + sgi * 8, 0, P->in[I_SPOOL] + (size_t)b * POOLBUF * D, rs + sgi * 8, g4, w, false, Y, nullptr, P->out + OUT_POOL_S + (size_t)b * POOLBUF * D, c0);
            }
        }
    }
}

constexpr int NPHASE = 46;
__host__ __device__ inline bool phase_exists(int ph) { if (ph == 0 || ph == NPHASE - 1) return true; const int li = (ph - 1) / 11, k = (ph - 1) % 11; if (li % 3 == 2 && (k == 4 || k == 5 || k == 6)) return false; return true; }

__device__ __forceinline__ CParams* fresh_params() { CParams* p = (CParams*)__builtin_amdgcn_kernarg_segment_ptr(); asm volatile("" : "+s"(p)); return p; }
__device__ __forceinline__ int fresh_tid() { int t = threadIdx.x; asm volatile("" : "+v"(t)); return t; }
#define SITE_BEGIN CParams* pp = fresh_params(); unsigned char* ws = pp->ws; const int tid = fresh_tid(), lane = tid & 63, wave = __builtin_amdgcn_readfirstlane(tid >> 6), G = gridDim.x, bx = blockIdx.x, gw = bx * NWAVES + wave, NGW = G * NWAVES; \
    (void)ws; (void)lane; (void)wave; (void)gw; (void)NGW; (void)tid; (void)G; (void)bx;
#define WSP(T, off) ((T*)(ws + (off)))

__global__ void __launch_bounds__(NTHREADS, 2) mega_fwd(Params P) {
    extern __shared__ __attribute__((aligned(16))) unsigned char lds_raw[];
    LAS unsigned char* lds = (LAS unsigned char*)lds_raw;
    volatile LAS unsigned* MISC = (volatile LAS unsigned*)(lds + MISC_OFF);
    for (int u = threadIdx.x; u < (LDS_BYTES - LDSCTL_OFF) / 4; u += NTHREADS) ((LAS unsigned*)(lds + LDSCTL_OFF))[u] = 0u;
    __syncthreads();
    const int lo = P.ph_lo, hi = P.ph_hi;
    XcdBarrier bar; bar.bar = (unsigned*)(P.ws + WS_CTL) + CW_BAR; bar.x = 0; bar.st = nullptr;
    if (hi - lo > 1) bar = xcd_barrier_post((unsigned*)(P.ws + WS_CTL) + CW_BAR, MISC + 8);
#define IN(k) (lo <= (k) && (k) < hi)
#define SEAM(k) do { if ((k) + 1 < hi) xcd_barrier(bar); } while (0)

    if (IN(0)) { { SITE_BEGIN prologue_phase(pp, lds, gw, NGW, wave, lane); } SEAM(0); }

#pragma unroll 1
    for (int li = 0; li < NLAYER; ++li) {
        const int pb = 1 + li * 11, kind = li % 3, j = li / 3;
#pragma unroll 1
        for (int which = 0; which < 2; ++which) {
            const int p0 = pb + (which ? 8 : 0), s = li * 2 + which;
            if (IN(p0)) { { SITE_BEGIN norm_phase(WSP(float, WS_X), pp->in[which ? I_NF2 : I_NF1] + (size_t)li * D, WSP(bf16_t, WS_XN), gw, NGW, lane); } SEAM(p0); }
            if (IN(p0 + 1)) {
                { SITE_BEGIN
                pg8::Gemm g{WSP(bf16_t, WS_XN), (const bf16_t*)(ws + WS_WGU + (size_t)s * SZ_WGU1), D, D, D, M / 256, 2 * FF / 256, 0};
                pg8::StaticOrder S; S.init(g.nM, g.nN, G, bx);
                EpiGU E{WSP(bf16_t, WS_H)};
                pg8::gemm_phase(lds, g, S, E, tid); }
                SEAM(p0 + 1);
            }
            if (IN(p0 + 2)) {
                { SITE_BEGIN
                pg8::Gemm g{WSP(bf16_t, WS_H), (const bf16_t*)(ws + WS_WDN + (size_t)s * SZ_WDN1), FF, FF, FF, M / 256, D / 256, 0};
                pg8::StaticOrder S; S.init(g.nM, g.nN, G, bx);
                EpiRes E{WSP(float, WS_X), 0.5f, nullptr};
                pg8::gemm_phase(lds, g, S, E, tid); }
                SEAM(p0 + 2);
            }
            if (which == 1) continue;
            if (kind == 0) {
                if (IN(pb + 3)) { { SITE_BEGIN norm_phase(WSP(float, WS_X), pp->in[I_NMIX] + (size_t)li * D, WSP(bf16_t, WS_XN), gw, NGW, lane); } SEAM(pb + 3); }
                if (IN(pb + 4)) {
                    { SITE_BEGIN
                    pg8::Gemm g{WSP(bf16_t, WS_XN), WSP(const bf16_t, WS_WHIN) + (size_t)j * 8192 * D, D, D, D, M / 256, 8192 / 256, 0};
                    pg8::StaticOrder S; S.init(g.nM, g.nN, G, bx);
                    EpiHG E{WSP(bf16_t, WS_Q), WSP(bf16_t, WS_KK), WSP(bf16_t, WS_V), WSP(bf16_t, WS_G), WSP(float, WS_LF), WSP(const float, WS_TAB) + (size_t)j * D};
                    pg8::gemm_phase(lds, g, S, E, tid); }
                    SEAM(pb + 4);
                }
                if (IN(pb + 5)) {
                    { SITE_BEGIN
                    scan_simple<HG_K, HG_V, HG_H>(WSP(bf16_t, WS_Q), WSP(bf16_t, WS_KK), WSP(float, WS_LF), WSP(bf16_t, WS_V), WSP(float, WS_O), pp->in[I_SHG] + (size_t)j * SB * HG_H * HG_K * HG_V,
                        pp->out + OUT_HG_P + (size_t)j * PB * HG_H * HG_K * HG_V, pp->out + OUT_HG_S + (size_t)j * SB * HG_H * HG_K * HG_V, tid, G); }
                    SEAM(pb + 5);
                }
                if (IN(pb + 6)) { { SITE_BEGIN post_phase<1>(WSP(float, WS_O), pp->in[I_HON] + (size_t)j * D, WSP(bf16_t, WS_G), WSP(bf16_t, WS_XN), gw, NGW, lane); } SEAM(pb + 6); }
                if (IN(pb + 7)) {
                    { SITE_BEGIN
                    pg8::Gemm g{WSP(bf16_t, WS_XN), WSP(const bf16_t, WS_WHOUT) + (size_t)j * D * D, D, D, D, M / 256, D / 256, 0};
                    pg8::StaticOrder S; S.init(g.nM, g.nN, G, bx);
                    EpiRes E{WSP(float, WS_X), 1.0f, nullptr};
                    pg8::gemm_phase(lds, g, S, E, tid); }
                    SEAM(pb + 7);
                }
            } else if (kind == 1) {
                if (IN(pb + 3)) { { SITE_BEGIN norm_phase(WSP(float, WS_X), pp->in[I_NMIX] + (size_t)li * D, WSP(bf16_t, WS_XN), gw, NGW, lane); } SEAM(pb + 3); }
                if (IN(pb + 4)) {
                    { SITE_BEGIN
                    pg8::Gemm g{WSP(bf16_t, WS_XN), WSP(const bf16_t, WS_WGIN), D, D, D, M / 256, GL_NIN / 256, 0};
                    pg8::StaticOrder S; S.init(g.nM, g.nN, G, bx);
                    EpiGLA E{WSP(bf16_t, WS_Q), WSP(bf16_t, WS_KK), WSP(bf16_t, WS_V), WSP(bf16_t, WS_G), WSP(float, WS_LF), pp->in[I_GBG] + (size_t)j * GL_DK};
                    pg8::gemm_phase(lds, g, S, E, tid); }
                    SEAM(pb + 4);
                }
                if (IN(pb + 5)) {
                    { SITE_BEGIN
                    scan_simple<GL_K, GL_V, GL_H>(WSP(bf16_t, WS_Q), WSP(bf16_t, WS_KK), WSP(float, WS_LF), WSP(bf16_t, WS_V), WSP(float, WS_O), pp->in[I_SGLA] + (size_t)j * SB * GL_H * GL_K * GL_V,
                        pp->out + OUT_GLA_P + (size_t)j * PB * GL_H * GL_K * GL_V, pp->out + OUT_GLA_S + (size_t)j * SB * GL_H * GL_K * GL_V, tid, G); }
                    SEAM(pb + 5);
                }
                if (IN(pb + 6)) { { SITE_BEGIN post_phase<4>(WSP(float, WS_O), pp->in[I_GON] + (size_t)j * D, WSP(bf16_t, WS_G), WSP(bf16_t, WS_XN), gw, NGW, lane); } SEAM(pb + 6); }
                if (IN(pb + 7)) {
                    { SITE_BEGIN
                    pg8::Gemm g{WSP(bf16_t, WS_XN), WSP(const bf16_t, WS_WGOUT), D, D, D, M / 256, D / 256, 0};
                    pg8::StaticOrder S; S.init(g.nM, g.nN, G, bx);
                    EpiRes E{WSP(float, WS_X), 1.0f, nullptr};
                    pg8::gemm_phase(lds, g, S, E, tid); }
                    SEAM(pb + 7);
                }
            } else {
                if (IN(pb + 3)) { { SITE_BEGIN pool_pre_phase(pp, lds, WSP(float, WS_X), pp->in[I_NMIX] + (size_t)li * D, WSP(bf16_t, WS_XN), tid, wave, lane, G); } SEAM(pb + 3 + 3); }
                if (IN(pb + 7)) {
                    { SITE_BEGIN
                    pg8::Gemm g{WSP(bf16_t, WS_XN), WSP(const bf16_t, WS_WPOOL), D, 512, 512, M / 256, D / 256, 1};
                    pg8::StaticOrder S; S.init(g.nM, g.nN, G, bx);
                    EpiRes E{WSP(float, WS_X), 1.0f, pp->in[I_PSC] + (size_t)j * D};
                    pg8::gemm_phase(lds, g, S, E, tid); }
                    SEAM(pb + 7);
                }
            }
        }
    }
    if (IN(NPHASE - 1)) { SITE_BEGIN final_phase(WSP(float, WS_X), pp->in[I_FN], pp->out + OUT_Y, gw, NGW, lane); }
#undef IN
#undef SEAM
}

extern "C" void kernel_launch(void* const* d_in, const int* in_sizes, int n_in, void* d_out, int out_size, void* d_ws, size_t ws_size, hipStream_t stream) {
    static int grid = 0;
    if (grid == 0) {
        if (n_in != 26 || (size_t)out_size != OUT_TOTAL || ws_size < WS_END) { fprintf(stderr, "kernel_launch: unexpected sizes n_in %d out %d ws %zu (need %zu)\n", n_in, out_size, ws_size, (size_t)WS_END); grid = -1; return; }
        int dev = 0, cus = 0, per_cu = 0;
        if (hipGetDevice(&dev) != hipSuccess || hipDeviceGetAttribute(&cus, hipDeviceAttributeMultiprocessorCount, dev) != hipSuccess) { grid = -1; return; }
        if (hipFuncSetAttribute((const void*)mega_fwd, hipFuncAttributeMaxDynamicSharedMemorySize, LDS_BYTES) != hipSuccess) { fprintf(stderr, "kernel_launch: hipFuncSetAttribute failed\n"); grid = -1; return; }
        if (hipOccupancyMaxActiveBlocksPerMultiprocessor(&per_cu, (const void*)mega_fwd, NTHREADS, LDS_BYTES) != hipSuccess || per_cu < 1) fprintf(stderr, "kernel_launch: occupancy query reports %d\n", per_cu);
        (void)hipGetLastError();
        grid = cus;
    }
    if (grid < 0) return;
    if (hipMemsetAsync((char*)d_ws + WS_CTL, 0, CTL_ZERO_BYTES, stream) != hipSuccess) return;
    Params p{};
    for (int i = 0; i < 26; ++i) p.in[i] = (const float*)d_in[i];
    p.out = (float*)d_out; p.ws = (unsigned char*)d_ws;
#if MK_PER_PHASE_LAUNCH
    for (int ph = 0; ph < NPHASE; ++ph) {
        if (!phase_exists(ph)) continue;
        p.ph_lo = ph; p.ph_hi = ph + 1;
        hipLaunchKernelGGL(mega_fwd, dim3(grid), dim3(NTHREADS), LDS_BYTES, stream, p);
    }
#else
    p.ph_lo = 0; p.ph_hi = NPHASE;
    hipLaunchKernelGGL(mega_fwd, dim3(grid), dim3(NTHREADS), LDS_BYTES, stream, p);
#endif
    (void)in_sizes;
}
```

```cpp
#include <hip/hip_runtime.h>
#include <cstdio>
#include <cstdint>

#ifndef USE_SIMPLE_SCAN
#define USE_SIMPLE_SCAN 0
#endif
#ifndef MK_PER_PHASE_LAUNCH
#define MK_PER_PHASE_LAUNCH 0
#endif

#define LAS __attribute__((address_space(3)))
#define GAS __attribute__((address_space(1)))
typedef unsigned short bf16_t;
typedef short bf16x8 __attribute__((ext_vector_type(8)));
typedef float f32x4 __attribute__((ext_vector_type(4)));
typedef float f32x2 __attribute__((ext_vector_type(2)));
typedef unsigned u32x4 __attribute__((ext_vector_type(4)));
typedef unsigned u32x2 __attribute__((ext_vector_type(2)));

constexpr int D = 2048, FF = 5632, NLAYER = 4;
constexpr int PB = 4, PT = 2048, SB = 128, ST = 8;
constexpr int MP = PB * PT, MS = SB * ST, M = MP + MS;
constexpr int HG_H = 16, HG_K = 128, HG_V = 128;
constexpr int GL_H = 4, GL_K = 256, GL_V = 512, GL_DK = 1024, GL_NIN = 7168, GL_WIN_LD = 6160;
constexpr int POOLBUF = 15;
constexpr float EPS = 1e-6f;
constexpr int NWAVES = 8, NTHREADS = 512;

constexpr size_t OUT_Y = 0;
constexpr size_t OUT_HG_P = (size_t)M * D;
constexpr size_t OUT_GLA_P = OUT_HG_P + (size_t)2 * PB * HG_H * HG_K * HG_V;
constexpr size_t OUT_POOL_P = OUT_GLA_P + (size_t)PB * GL_H * GL_K * GL_V;
constexpr size_t OUT_HG_S = OUT_POOL_P + (size_t)PB * POOLBUF * D;
constexpr size_t OUT_GLA_S = OUT_HG_S + (size_t)2 * SB * HG_H * HG_K * HG_V;
constexpr size_t OUT_POOL_S = OUT_GLA_S + (size_t)SB * GL_H * GL_K * GL_V;
constexpr size_t OUT_TOTAL = OUT_POOL_S + (size_t)SB * POOLBUF * D;
static_assert(OUT_TOTAL == 161341440ull, "output size");

constexpr size_t MiB = 1u << 20;
constexpr size_t al(size_t x) { return (x + MiB - 1) / MiB * MiB; }
constexpr size_t WS_CTL = 0, CTL_ZERO_BYTES = 1 * MiB;
constexpr size_t WS_TAB = 1 * MiB;
constexpr size_t SZ_WGU1 = (size_t)2 * FF * D * 2, SZ_WDN1 = (size_t)D * FF * 2;
constexpr size_t WS_WGU = 2 * MiB;
constexpr size_t WS_WDN = WS_WGU + al(8 * SZ_WGU1);
constexpr size_t WS_WHIN = WS_WDN + al(8 * SZ_WDN1);
constexpr size_t WS_WHOUT = WS_WHIN + al((size_t)2 * 8192 * D * 2);
constexpr size_t WS_WGIN = WS_WHOUT + al((size_t)2 * D * D * 2);
constexpr size_t WS_WGOUT = WS_WGIN + al((size_t)GL_NIN * D * 2);
constexpr size_t WS_WPOOL = WS_WGOUT + al((size_t)D * D * 2);
constexpr size_t WS_X = WS_WPOOL + al((size_t)D * 512 * 2);
constexpr size_t WS_XN = WS_X + al((size_t)M * D * 4);
constexpr size_t WS_H = WS_XN + al((size_t)M * D * 2);
constexpr size_t WS_Q = WS_H + al((size_t)M * FF * 2);
constexpr size_t WS_KK = WS_Q + al((size_t)M * D * 2);
constexpr size_t WS_V = WS_KK + al((size_t)M * D * 2);
constexpr size_t WS_G = WS_V + al((size_t)M * D * 2);
constexpr size_t WS_LF = WS_G + al((size_t)M * D * 2);
constexpr size_t WS_O = WS_LF + al((size_t)M * D * 4);
constexpr size_t WS_VT = WS_O + al((size_t)M * D * 4);
constexpr size_t WS_DL = WS_VT + al((size_t)M * D * 2);
constexpr size_t WS_END = WS_DL + al((size_t)256 * D * 4);
constexpr size_t WS_QI = WS_H, WS_KDT = WS_QI + al((size_t)M * D * 2), WS_AM = WS_KDT + al((size_t)M * D * 2);
static_assert(WS_AM + (size_t)144 * 16 * 64 * 64 * 2 <= WS_Q, "scan overlay fits in H");

constexpr int CW_BAR = 4096, CW_QUEUE = 8192;

constexpr int RING_BYTES = 131072, LDSCTL_OFF = RING_BYTES, MISC_OFF = LDSCTL_OFF + 320, LDS_BYTES = 147456;

__device__ __forceinline__ unsigned f2bf(float f) { unsigned u = __builtin_bit_cast(unsigned, f); return (u + 0x7fffu + ((u >> 16) & 1u)) >> 16; }
__device__ __forceinline__ unsigned pk2(float lo, float hi) { return f2bf(lo) | (f2bf(hi) << 16); }
__device__ __forceinline__ float bf2f(unsigned short b) { return __builtin_bit_cast(float, ((unsigned)b) << 16); }
__device__ __forceinline__ float bflo(unsigned w) { return __builtin_bit_cast(float, w << 16); }
__device__ __forceinline__ float bfhi(unsigned w) { return __builtin_bit_cast(float, w & 0xffff0000u); }
__device__ __forceinline__ float wave_sum(float v) {
#pragma unroll
    for (int o = 1; o < 64; o <<= 1) v += __shfl_xor(v, o);
    return v;
}
__device__ __forceinline__ float fsigmoid(float x) { return __builtin_amdgcn_rcpf(1.f + __expf(-x)); }
__device__ __forceinline__ float fsilu(float x) { return x * fsigmoid(x); }
#define LDS_WAIT() asm volatile("s_waitcnt lgkmcnt(0)" ::: "memory")

#define XB_TMO      128
#define XB_XCNT(j)  (256  + 64 * (j))
#define XB_XSUB(j)  (1280 + 64 * (j))
#define XB_XGEN(j)  (2304 + 64 * (j))
#define XB_TOP      3328
#define XB_TOPGEN   3392
#define XCD_BAR_WORDS 3456
#define XB_SPIN_CAP (1u << 22)

__device__ __forceinline__ unsigned xb_ld(unsigned* p)              { return __hip_atomic_load(p, __ATOMIC_RELAXED, __HIP_MEMORY_SCOPE_AGENT); }
__device__ __forceinline__ unsigned xb_add(unsigned* p, unsigned v) { return __hip_atomic_fetch_add(p, v, __ATOMIC_RELAXED, __HIP_MEMORY_SCOPE_AGENT); }
__device__ __forceinline__ unsigned xb_xcc_id() { return (unsigned)__builtin_amdgcn_s_getreg((3 << 11) | 20) & 0xFu; }
#define XB_SPIN(cond, bar) do { unsigned _sp = 0; while (cond) { __builtin_amdgcn_s_sleep(1); \
    if ((++_sp & 255u) == 0u) { if (xb_ld(&(bar)[XB_TMO])) break; if (_sp > XB_SPIN_CAP) { atomicAdd(&(bar)[XB_TMO], 1u); break; } } } } while (0)

struct XcdBarrier { unsigned* bar; unsigned x; volatile LAS unsigned* st; };

__device__ __forceinline__ XcdBarrier xcd_barrier_post(unsigned* bar, volatile LAS unsigned* st) {
    XcdBarrier b; b.bar = bar; b.x = xb_xcc_id(); b.st = st;
    if (threadIdx.x == 0) (void)xb_add(&bar[XB_XCNT(b.x)], 1u);
    return b;
}
__device__ __forceinline__ void xcd_barrier_complete(unsigned* bar, unsigned x, unsigned& nloc, unsigned& nx) {
    const unsigned G = gridDim.x * gridDim.y * gridDim.z;
    unsigned sum, cnt, mine, sp = 0u;
    for (;;) {
        sum = 0u; cnt = 0u; mine = 0u;
#pragma unroll
        for (unsigned j = 0; j < 16; ++j) { const unsigned c = xb_ld(&bar[XB_XCNT(j)]); sum += c; cnt += (c > 0u) ? 1u : 0u; mine = (j == x) ? c : mine; }
        if (sum == G) break;
        __builtin_amdgcn_s_sleep(1);
        if ((++sp & 255u) == 0u) { if (xb_ld(&bar[XB_TMO])) break; if (sp > XB_SPIN_CAP) { atomicAdd(&bar[XB_TMO], 1u); break; } }
    }
    nloc = mine > 0u ? mine : 1u; nx = cnt > 0u ? cnt : 1u;
}
__device__ __forceinline__ void xcd_barrier(const XcdBarrier& b, const bool leader  ) {
    asm volatile("s_waitcnt vmcnt(0)" ::: "memory");
    __syncthreads();
    if (leader) {
        unsigned* bar = b.bar;
        __builtin_amdgcn_s_waitcnt(0);
        unsigned nloc = b.st[0], nx = b.st[1];
        if (nloc == 0u) { xcd_barrier_complete(bar, b.x, nloc, nx); b.st[0] = nloc; b.st[1] = nx; }
        const unsigned old = xb_add(&bar[XB_XSUB(b.x)], 1u);
        const unsigned gen = old / nloc;
        if (old + 1u == (gen + 1u) * nloc) {
            __builtin_amdgcn_fence(__ATOMIC_RELEASE, "agent");
            asm volatile("s_waitcnt vmcnt(0)" ::: "memory");
            const unsigned og = xb_add(&bar[XB_TOP], 1u);
            const unsigned tg = og / nx;
            if (og + 1u == (tg + 1u) * nx) xb_add(&bar[XB_TOPGEN], 1u);
            else XB_SPIN(xb_ld(&bar[XB_TOPGEN]) == tg, bar);
            __builtin_amdgcn_fence(__ATOMIC_ACQUIRE, "agent");
            xb_add(&bar[XB_XGEN(b.x)], 1u);
            asm volatile("s_waitcnt vmcnt(0)" ::: "memory");
        } else {
            XB_SPIN(xb_ld(&bar[XB_XGEN(b.x)]) == gen, bar);
            __builtin_amdgcn_fence(__ATOMIC_ACQUIRE, "agent");
            asm volatile("s_waitcnt vmcnt(0)" ::: "memory");
        }
    }
    __syncthreads();
}

namespace pg8 {
constexpr int BM = 256, BK = 64, HALF = 128, HTB = HALF * BK * 2, STAGE_BYTES = 8 * HTB, NXCD = 8, WGM = 8;
__host__ __device__ __forceinline__ int lds_byte(int r, int c) { const int st = (r >> 4) * 2 + (c >> 5), rr = r & 15, cc = c & 31, ob = rr * 64 + cc * 2; return st * 1024 + (ob ^ (((ob >> 9) & 1) << 5)); }
__host__ __device__ __forceinline__ void stage_rc(int b, int& R, int& C) { const int st = b / 1024, sb = b % 1024, swz = sb ^ (((sb >> 9) & 1) << 5); R = (st >> 1) * 16 + swz / 64; C = (st & 1) * 32 + (swz % 64) / 2; }
__host__ __device__ __forceinline__ int perm32(int rho) { const int n = rho >> 4, i = rho & 15; return 8 * (i >> 2) + 4 * n + (i & 3); }

struct Unit { int pm, pn; };
struct Gemm { const bf16_t* A; const bf16_t* Bt; int lda, ldb, K, nM, nN, grp; };

struct StaticOrder {
    int nM, nN, nwg, G, c;
    __device__ void init(int nM_, int nN_, int G_, int c_) { nM = nM_; nN = nN_; nwg = nM * nN; G = G_; c = c_; }
    __device__ bool next(int i, Unit& u) const {
        const long L = (long)i * G + c; if (L >= nwg) return false;
        int wgid = (int)L; { const int q = nwg / NXCD, r = nwg % NXCD, xcd = wgid % NXCD, off = wgid / NXCD; wgid = (xcd < r ? xcd * (q + 1) : r * (q + 1) + (xcd - r) * q) + off; }
        const int nig = WGM * nN, gid = wgid / nig, fm = gid * WGM, gsz = (nM - fm) < WGM ? (nM - fm) : WGM;
        u.pm = fm + ((wgid % nig) % gsz); u.pn = (wgid % nig) / gsz; return true;
    }
};

template <class Epi>
__device__ __forceinline__ void gemm_phase(LAS unsigned char* lds, const Gemm g, const StaticOrder& S, const Epi& E, const int tid) {
    const int wid = __builtin_amdgcn_readfirstlane(tid >> 6), lane = tid & 63, wr = wid >> 2, wc = wid & 3, fr = lane & 15, fq = lane >> 4;
    const int K = g.K, nt = K / BK;
    unsigned voffA[2], voffB[2];
#pragma unroll
    for (int i = 0; i < 2; ++i) { int R, C; stage_rc(tid * 16 + i * 8192, R, C); const int Rb = (R & ~31) + perm32(R & 31);
        voffA[i] = (unsigned)(R * g.lda + C) * 2u; voffB[i] = (unsigned)(Rb * g.ldb + C) * 2u; }
    const size_t kstep = (size_t)(BK * 2);
    const size_t hstepA = (size_t)HALF * g.lda * 2, hstepB = (size_t)HALF * g.ldb * 2;
    const size_t tstepA = 2 * hstepA, tstepB = 2 * hstepB;
    const unsigned ldsw = (unsigned)wid * 1024u;
    const int aoff = lds_byte(wr * 64 + fr, fq * 8), boff = lds_byte(wc * 32 + fr, fq * 8);
#define PG8_SA(b, h) (((b) * 2 + (h)) * HTB)
#define PG8_SB(b, h) ((4 + (b) * 2 + (h)) * HTB)
#define PG8_STAGE(bufoff, gbase, voff) do { _Pragma("unroll") for (int _i = 0; _i < 2; ++_i) \
        __builtin_amdgcn_global_load_lds((const unsigned*)((const char*)(gbase) + (voff)[_i]), (LAS unsigned*)(lds + (bufoff) + ldsw + _i * 8192), 16, 0, 0); } while (0)
#define PG8_LDA(dst, b, h) do { _Pragma("unroll") for (int m = 0; m < 4; ++m) _Pragma("unroll") for (int k = 0; k < 2; ++k) dst[m][k] = *(const LAS bf16x8*)(lds + PG8_SA(b, h) + aoff + m * 2048 + k * 1024); } while (0)
#define PG8_LDB(dst, b, h) do { _Pragma("unroll") for (int n = 0; n < 2; ++n) _Pragma("unroll") for (int k = 0; k < 2; ++k) dst[n][k] = *(const LAS bf16x8*)(lds + PG8_SB(b, h) + boff + n * 2048 + k * 1024); } while (0)
#define PG8_MMA(ai, bj, At, Bt) do { __builtin_amdgcn_s_setprio(1); _Pragma("unroll") for (int m = 0; m < 4; ++m) _Pragma("unroll") for (int n = 0; n < 2; ++n) _Pragma("unroll") for (int k = 0; k < 2; ++k) \
        acc[ai][bj][m][n] = __builtin_amdgcn_mfma_f32_16x16x32_bf16(Bt[n][k], At[m][k], acc[ai][bj][m][n], 0, 0, 0); __builtin_amdgcn_s_setprio(0); } while (0)
#define PG8_WAIT_V(n) asm volatile("s_waitcnt vmcnt(" #n ")" ::: "memory")
#define PG8_WAIT_L(n) asm volatile("s_waitcnt lgkmcnt(" #n ")" ::: "memory")
#define PG8_BAR __builtin_amdgcn_s_barrier()
#define PG8_SCHED __builtin_amdgcn_sched_barrier(0)
#define PG8_ABASE(u) ((const char*)g.A + (size_t)(u).pm * tstepA + (g.grp ? (size_t)((u).pn >> 1) * (size_t)K * 2 : (size_t)0))
#define PG8_BBASE(u) ((const char*)g.Bt + (size_t)(u).pn * tstepB)
    Unit cur, nxt; int ui = 0;
    if (!S.next(0, cur)) return;
    f32x4 acc[2][2][4][2];
#pragma unroll
    for (int a = 0; a < 2; ++a)
#pragma unroll
        for (int b = 0; b < 2; ++b)
#pragma unroll
            for (int m = 0; m < 4; ++m)
#pragma unroll
                for (int n = 0; n < 2; ++n) acc[a][b][m][n] = (f32x4){0.f, 0.f, 0.f, 0.f};
    bf16x8 At[4][2], B0[2][2], B1[2][2];
    const char* cA = PG8_ABASE(cur); const char* cB = PG8_BBASE(cur);
    PG8_STAGE(PG8_SB(0, 0), cB, voffB); PG8_STAGE(PG8_SB(0, 1), cB + hstepB, voffB); PG8_STAGE(PG8_SA(0, 0), cA, voffA); PG8_STAGE(PG8_SA(0, 1), cA + hstepA, voffA);
    if (wr == 1) PG8_BAR;
    PG8_WAIT_V(2); PG8_BAR;
    PG8_STAGE(PG8_SB(1, 0), cB + kstep, voffB); PG8_STAGE(PG8_SA(1, 0), cA + kstep, voffA); PG8_STAGE(PG8_SB(1, 1), cB + hstepB + kstep, voffB);
    PG8_WAIT_V(6); PG8_BAR;
    for (;;) {
        const bool has_next = S.next(ui + 1, nxt);
        const char* nA = has_next ? PG8_ABASE(nxt) : cA; const char* nB = has_next ? PG8_BBASE(nxt) : cB;
        for (int t = 0; t < nt; t += 2) {
            const bool last = (t == nt - 2);
            const char* a1 = cA + (size_t)(t + 1) * kstep;
            const char* a2 = last ? nA : cA + (size_t)(t + 2) * kstep; const char* b2 = last ? nB : cB + (size_t)(t + 2) * kstep;
            const char* a3 = a2 + kstep; const char* b3 = b2 + kstep;
            PG8_LDB(B0, 0, 0); PG8_LDB(B1, 0, 1); PG8_SCHED; PG8_LDA(At, 0, 0); PG8_STAGE(PG8_SA(1, 1), a1 + hstepA, voffA);
            PG8_WAIT_V(8); PG8_WAIT_L(0); PG8_BAR; PG8_MMA(0, 0, At, B0); PG8_MMA(0, 1, At, B1); PG8_BAR; PG8_SCHED;
            PG8_LDA(At, 0, 1); PG8_STAGE(PG8_SB(0, 0), b2, voffB); PG8_STAGE(PG8_SB(0, 1), b2 + hstepB, voffB); PG8_STAGE(PG8_SA(0, 0), a2, voffA);
            PG8_WAIT_V(8); PG8_WAIT_L(0); PG8_BAR; PG8_MMA(1, 0, At, B0); PG8_MMA(1, 1, At, B1); PG8_BAR; PG8_SCHED;
            PG8_LDB(B0, 1, 0); PG8_LDB(B1, 1, 1); PG8_SCHED; PG8_LDA(At, 1, 0); PG8_STAGE(PG8_SA(0, 1), a2 + hstepA, voffA);
            PG8_WAIT_V(8); PG8_WAIT_L(0); PG8_BAR; PG8_MMA(0, 0, At, B0); PG8_MMA(0, 1, At, B1); PG8_BAR; PG8_SCHED;
            PG8_LDA(At, 1, 1); PG8_STAGE(PG8_SB(1, 0), b3, voffB); PG8_STAGE(PG8_SB(1, 1), b3 + hstepB, voffB); PG8_STAGE(PG8_SA(1, 0), a3, voffA);
            PG8_WAIT_V(8); PG8_WAIT_L(0); PG8_BAR; PG8_MMA(1, 0, At, B0); PG8_MMA(1, 1, At, B1); PG8_BAR; PG8_SCHED;
        }
        if (wr == 0) PG8_BAR;
        E(acc, cur, wr, wc, fr, fq);
        if (!has_next) break;
#pragma unroll
        for (int a = 0; a < 2; ++a)
#pragma unroll
            for (int b = 0; b < 2; ++b)
#pragma unroll
                for (int m = 0; m < 4; ++m)
#pragma unroll
                    for (int n = 0; n < 2; ++n) acc[a][b][m][n] = (f32x4){0.f, 0.f, 0.f, 0.f};
        cur = nxt; cA = nA; cB = nB; ++ui;
        if (wr == 1) PG8_BAR;
    }
    PG8_WAIT_V(0);
    PG8_BAR;
#undef PG8_SA
#undef PG8_SB
#undef PG8_STAGE
#undef PG8_LDA
#undef PG8_LDB
#undef PG8_MMA
#undef PG8_WAIT_V
#undef PG8_WAIT_L
#undef PG8_BAR
#undef PG8_SCHED
#undef PG8_ABASE
#undef PG8_BBASE
}
}

__device__ __forceinline__ unsigned cvt_pk_bf16(float lo, float hi) { unsigned r; asm volatile("v_cvt_pk_bf16_f32 %0, %1, %2" : "=v"(r) : "v"(lo), "v"(hi)); return r; }
typedef f32x4 AccT[2][2][4][2];

struct EpiGU {
    bf16_t* H;
    __device__ __forceinline__ void operator()(const AccT& acc, const pg8::Unit& u, int wr, int wc, int fr, int fq) const {
        const int row0 = u.pm * 256 + wr * 64 + fr, col0 = u.pn * 128 + wc * 32 + 8 * fq;
#pragma unroll
        for (int ai = 0; ai < 2; ++ai)
#pragma unroll
            for (int m = 0; m < 4; ++m) {
                bf16_t* rowp = H + (size_t)(row0 + ai * 128 + m * 16) * FF + col0;
                float hv[8];
#pragma unroll
                for (int n = 0; n < 2; ++n)
#pragma unroll
                    for (int j = 0; j < 4; ++j) { const float gv = acc[ai][0][m][n][j], uv = acc[ai][1][m][n][j]; hv[n * 4 + j] = fsilu(gv) * uv; }
                u32x4 w; w.x = cvt_pk_bf16(hv[0], hv[1]); w.y = cvt_pk_bf16(hv[2], hv[3]); w.z = cvt_pk_bf16(hv[4], hv[5]); w.w = cvt_pk_bf16(hv[6], hv[7]);
                *(u32x4*)rowp = w;
            }
    }
};
struct EpiRes {
    float* X; float alpha; const float* colscale;
    __device__ __forceinline__ void operator()(const AccT& acc, const pg8::Unit& u, int wr, int wc, int fr, int fq) const {
        const int row0 = u.pm * 256 + wr * 64 + fr, col0 = u.pn * 256 + wc * 32 + 8 * fq;
        f32x4 cs[2][2];
#pragma unroll
        for (int bj = 0; bj < 2; ++bj)
#pragma unroll
            for (int n = 0; n < 2; ++n) { cs[bj][n] = colscale ? *(const f32x4*)(colscale + col0 + bj * 128 + 4 * n) : (f32x4){1.f, 1.f, 1.f, 1.f}; cs[bj][n] = cs[bj][n] * alpha; }
#pragma unroll
        for (int ai = 0; ai < 2; ++ai)
#pragma unroll
            for (int m = 0; m < 4; ++m) {
                float* rowp = X + (size_t)(row0 + ai * 128 + m * 16) * D + col0;
#pragma unroll
                for (int bj = 0; bj < 2; ++bj)
#pragma unroll
                    for (int n = 0; n < 2; ++n) { f32x4* p = (f32x4*)(rowp + bj * 128 + 4 * n); *p = *p + cs[bj][n] * acc[ai][bj][m][n]; }
            }
    }
};
struct EpiHG {
    bf16_t *Q, *KK, *V, *G; float* LF; const float* lb;
    __device__ __forceinline__ void operator()(const AccT& acc, const pg8::Unit& u, int wr, int wc, int fr, int fq) const {
        const int row0 = u.pm * 256 + wr * 64 + fr, reg = u.pn >> 3, col0 = (u.pn & 7) * 256 + wc * 32 + 8 * fq;
        float lbv[2][8];
#pragma unroll
        for (int bj = 0; bj < 2; ++bj)
#pragma unroll
            for (int j = 0; j < 8; ++j) lbv[bj][j] = (reg == 1) ? lb[col0 + bj * 128 + j] : 0.f;
#pragma unroll
        for (int ai = 0; ai < 2; ++ai)
#pragma unroll
            for (int m = 0; m < 4; ++m) {
                const size_t ro = (size_t)(row0 + ai * 128 + m * 16) * D + col0;
#pragma unroll
                for (int bj = 0; bj < 2; ++bj) {
                    float a[8], o[8];
#pragma unroll
                    for (int n = 0; n < 2; ++n)
#pragma unroll
                        for (int j = 0; j < 4; ++j) a[n * 4 + j] = acc[ai][bj][m][n][j];
                    bf16_t* dst;
                    if (reg == 0) { dst = Q;
#pragma unroll
                        for (int j = 0; j < 8; ++j) o[j] = fsilu(a[j]) * 0.08838834764831845f;
                    } else if (reg == 1) { dst = KK; float lf[8];
#pragma unroll
                        for (int j = 0; j < 8; ++j) { const float f = fminf(fmaxf(a[j], -80.f), 80.f), e = __expf(-f), sig = __builtin_amdgcn_rcpf(1.f + e), l = lbv[bj][j];
                            lf[j] = __logf(l + (1.f - l) * sig); o[j] = (1.f - l) * e * sig; }
                        float* lp = LF + ro + bj * 128;
                        *(f32x4*)lp = (f32x4){lf[0], lf[1], lf[2], lf[3]}; *(f32x4*)(lp + 4) = (f32x4){lf[4], lf[5], lf[6], lf[7]};
                    } else if (reg == 2) { dst = V;
#pragma unroll
                        for (int j = 0; j < 8; ++j) o[j] = a[j];
                    } else { dst = G;
#pragma unroll
                        for (int j = 0; j < 8; ++j) o[j] = fsilu(a[j]);
                    }
                    u32x4 w; w.x = cvt_pk_bf16(o[0], o[1]); w.y = cvt_pk_bf16(o[2], o[3]); w.z = cvt_pk_bf16(o[4], o[5]); w.w = cvt_pk_bf16(o[6], o[7]);
                    *(u32x4*)(dst + ro + bj * 128) = w;
                }
            }
    }
};
struct EpiGLA {
    bf16_t *Q, *KK, *V, *G; float* LF; const float* bgate;
    __device__ __forceinline__ void operator()(const AccT& acc, const pg8::Unit& u, int wr, int wc, int fr, int fq) const {
        const int pn = u.pn; int reg, cbase;
        if (pn < 4) { reg = 0; cbase = pn * 256; } else if (pn < 8) { reg = 1; cbase = (pn - 4) * 256; } else if (pn < 16) { reg = 2; cbase = (pn - 8) * 256; }
        else if (pn < 24) { reg = 3; cbase = (pn - 16) * 256; } else { reg = 4; cbase = (pn - 24) * 256; }
        const int row0 = u.pm * 256 + wr * 64 + fr, col0 = cbase + wc * 32 + 8 * fq;
        float bg[2][8];
#pragma unroll
        for (int bj = 0; bj < 2; ++bj)
#pragma unroll
            for (int j = 0; j < 8; ++j) bg[bj][j] = (reg == 4) ? bgate[col0 + bj * 128 + j] : 0.f;
#pragma unroll
        for (int ai = 0; ai < 2; ++ai)
#pragma unroll
            for (int m = 0; m < 4; ++m) {
                const size_t ro = (size_t)(row0 + ai * 128 + m * 16) * D + col0;
#pragma unroll
                for (int bj = 0; bj < 2; ++bj) {
                    float a[8], o[8];
#pragma unroll
                    for (int n = 0; n < 2; ++n)
#pragma unroll
                        for (int j = 0; j < 4; ++j) a[n * 4 + j] = acc[ai][bj][m][n][j];
                    if (reg == 4) {
                        float lf[8];
#pragma unroll
                        for (int j = 0; j < 8; ++j) { const float z = a[j] + bg[bj][j]; lf[j] = (fminf(z, 0.f) - __logf(1.f + __expf(-fabsf(z)))) * 0.0625f; }
                        float* lp = LF + ro + bj * 128;
                        *(f32x4*)lp = (f32x4){lf[0], lf[1], lf[2], lf[3]}; *(f32x4*)(lp + 4) = (f32x4){lf[4], lf[5], lf[6], lf[7]};
                    } else {
                        bf16_t* dst;
                        if (reg == 0) { dst = Q;
#pragma unroll
                            for (int j = 0; j < 8; ++j) o[j] = a[j] * 0.0625f;
                        } else if (reg == 1) { dst = KK;
#pragma unroll
                            for (int j = 0; j < 8; ++j) o[j] = a[j];
                        } else if (reg == 2) { dst = V;
#pragma unroll
                            for (int j = 0; j < 8; ++j) o[j] = a[j];
                        } else { dst = G;
#pragma unroll
                            for (int j = 0; j < 8; ++j) o[j] = fsilu(a[j]);
                        }
                        u32x4 w; w.x = cvt_pk_bf16(o[0], o[1]); w.y = cvt_pk_bf16(o[2], o[3]); w.z = cvt_pk_bf16(o[4], o[5]); w.w = cvt_pk_bf16(o[6], o[7]);
                        *(u32x4*)(dst + ro + bj * 128) = w;
                    }
                }
            }
    }
};

struct Params { const float* in[26]; float* out; unsigned char* ws; int ph_lo, ph_hi; };
typedef const Params __attribute__((address_space(4))) CParams;
enum { I_XP = 0, I_XS, I_SHG, I_SGLA, I_SPOOL, I_NF1, I_F1G, I_F1U, I_F1D, I_NMIX, I_NF2, I_F2G, I_F2U, I_F2D, I_LBL, I_HWIN, I_HON, I_HWOUT, I_GWIN, I_GWGU, I_GBG, I_GON, I_GWOUT, I_PWG, I_PSC, I_FN };

template <class Src>
__device__ __forceinline__ void transpose_item(const Src& src, int K, bf16_t* WT, int dst_row0, int k0, int n0, LAS float* scr, int lane) {
#pragma unroll 8
    for (int i = 0; i < 32; ++i) { const int kk = 2 * i + (lane >> 5); scr[kk * 33 + (lane & 31)] = src(k0 + kk, n0 + (lane & 31)); }
    LDS_WAIT(); asm volatile("" ::: "memory");
    const int c = lane & 7;
#pragma unroll
    for (int j = 0; j < 4; ++j) { const int n = (lane >> 3) + 8 * j; const LAS float* s = scr + (8 * c) * 33 + n;
        u32x4 o; o.x = pk2(s[0 * 33], s[1 * 33]); o.y = pk2(s[2 * 33], s[3 * 33]); o.z = pk2(s[4 * 33], s[5 * 33]); o.w = pk2(s[6 * 33], s[7 * 33]);
        *(u32x4*)(WT + (size_t)(dst_row0 + n) * K + k0 + 8 * c) = o; }
    LDS_WAIT(); asm volatile("" ::: "memory");
}
struct SrcPlain { const float* W; int ld; __device__ __forceinline__ float operator()(int k, int n) const { return W[(size_t)k * ld + n]; } };
struct SrcGlaGate { const float* win; const float* wgu;
    __device__ __forceinline__ float operator()(int k, int n) const { float s = 0.f;
#pragma unroll
        for (int r = 0; r < 16; ++r) s += win[(size_t)k * GL_WIN_LD + 6144 + r] * wgu[r * GL_DK + n];
        return s; } };

__device__ __forceinline__ void prologue_phase(CParams* P, LAS unsigned char* lds, int gw, int NGW, int wave, int lane) {
    unsigned char* ws = P->ws;
    LAS float* scr = (LAS float*)(lds + wave * 16384);
    constexpr int IT_FFN = (D / 64) * (FF / 32);
    constexpr int IT_HIN = (D / 64) * (8192 / 32), IT_DD = (D / 64) * (D / 32), IT_GIN = (D / 64) * (6144 / 32), IT_GG = (D / 64) * (GL_DK / 32), IT_PL = (512 / 64) * (512 / 32);
    constexpr int N_FFN = 24 * IT_FFN, N_H = 2 * IT_HIN + 2 * IT_DD, N_G = IT_GIN + IT_GG + IT_DD, N_P = 4 * IT_PL;
    constexpr int NITEMS = N_FFN + N_H + N_G + N_P;
    for (int it = gw; it < NITEMS; it += NGW) {
        int r = it;
        if (r < N_FFN) {
            const int mat = r / IT_FFN, item = r % IT_FFN, s = mat / 3, kind = mat % 3, li = s >> 1, which = s & 1;
            if (kind < 2) {
                const float* W = P->in[(which ? I_F2G : I_F1G) + kind] + (size_t)li * D * FF;
                const int nblk = FF / 32, kb = item / nblk, nb = item % nblk, n0 = nb * 32;
                SrcPlain src{W, FF};
                transpose_item(src, D, (bf16_t*)(ws + WS_WGU + (size_t)s * SZ_WGU1), (n0 >> 7) * 256 + (n0 & 127) + kind * 128, kb * 64, n0, scr, lane);
            } else {
                const float* W = P->in[which ? I_F2D : I_F1D] + (size_t)li * FF * D;
                const int nblk = D / 32, kb = item / nblk, nb = item % nblk;
                SrcPlain src{W, D};
                transpose_item(src, FF, (bf16_t*)(ws + WS_WDN + (size_t)s * SZ_WDN1), nb * 32, kb * 64, nb * 32, scr, lane);
            }
            continue;
        }
        r -= N_FFN;
        if (r < N_H) {
            if (r < 2 * IT_HIN) { const int j = r / IT_HIN, item = r % IT_HIN, nblk = 8192 / 32, kb = item / nblk, nb = item % nblk;
                SrcPlain src{P->in[I_HWIN] + (size_t)j * D * 8192, 8192};
                transpose_item(src, D, (bf16_t*)(ws + WS_WHIN) + (size_t)j * 8192 * D, nb * 32, kb * 64, nb * 32, scr, lane);
            } else { r -= 2 * IT_HIN; const int j = r / IT_DD, item = r % IT_DD, nblk = D / 32, kb = item / nblk, nb = item % nblk;
                SrcPlain src{P->in[I_HWOUT] + (size_t)j * D * D, D};
                transpose_item(src, D, (bf16_t*)(ws + WS_WHOUT) + (size_t)j * D * D, nb * 32, kb * 64, nb * 32, scr, lane);
            }
            continue;
        }
        r -= N_H;
        if (r < N_G) {
            if (r < IT_GIN) { const int nblk = 6144 / 32, kb = r / nblk, nb = r % nblk;
                SrcPlain src{P->in[I_GWIN], GL_WIN_LD};
                transpose_item(src, D, (bf16_t*)(ws + WS_WGIN), nb * 32, kb * 64, nb * 32, scr, lane);
            } else if (r < IT_GIN + IT_GG) { r -= IT_GIN; const int nblk = GL_DK / 32, kb = r / nblk, nb = r % nblk;
                SrcGlaGate src{P->in[I_GWIN], P->in[I_GWGU]};
                transpose_item(src, D, (bf16_t*)(ws + WS_WGIN), 6144 + nb * 32, kb * 64, nb * 32, scr, lane);
            } else { r -= IT_GIN + IT_GG; const int nblk = D / 32, kb = r / nblk, nb = r % nblk;
                SrcPlain src{P->in[I_GWOUT], D};
                transpose_item(src, D, (bf16_t*)(ws + WS_WGOUT), nb * 32, kb * 64, nb * 32, scr, lane);
            }
            continue;
        }
        r -= N_G;
        { const int gi = r / IT_PL, item = r % IT_PL, nblk = 512 / 32, kb = item / nblk, nb = item % nblk;
          SrcPlain src{P->in[I_PWG] + (size_t)gi * 512 * 512, 512};
          transpose_item(src, 512, (bf16_t*)(ws + WS_WPOOL), gi * 512 + nb * 32, kb * 64, nb * 32, scr, lane); }
    }
    {
        float* X = (float*)(ws + WS_X);
        const size_t n4 = (size_t)M * D / 4, np4 = (size_t)MP * D / 4;
        for (size_t i = (size_t)gw * 64 + lane; i < n4; i += (size_t)NGW * 64) {
            const f32x4 v = i < np4 ? ((const f32x4*)P->in[I_XP])[i] : ((const f32x4*)P->in[I_XS])[i - np4];
            ((f32x4*)X)[i] = v;
        }
    }
    {
        float* TAB = (float*)(ws + WS_TAB);
        for (int c = gw * 64 + lane; c < D; c += NGW * 64) {
            float l[4], mx = -1e30f;
#pragma unroll
            for (int i = 0; i < 4; ++i) { l[i] = P->in[I_LBL][i * D + c]; mx = fmaxf(mx, l[i]); }
            float e[4], s = 0.f;
#pragma unroll
            for (int i = 0; i < 4; ++i) { e[i] = __expf(l[i] - mx); s += e[i]; }
            TAB[c] = 0.f;
            TAB[D + c] = (e[1] + e[2] + e[3]) / s;
        }
    }
}

__device__ __forceinline__ void norm_phase(const float* X, const float* gain, bf16_t* XN, int gw, int NGW, int lane) {
    for (int m = gw; m < M; m += NGW) {
        const f32x4* xr = (const f32x4*)(X + (size_t)m * D) + lane;
        f32x4 v[8]; float s = 0.f;
#pragma unroll
        for (int j = 0; j < 8; ++j) { v[j] = xr[64 * j]; s += (v[j].x * v[j].x + v[j].y * v[j].y) + (v[j].z * v[j].z + v[j].w * v[j].w); }
        const float r = __builtin_amdgcn_rsqf(wave_sum(s) * (1.f / D) + EPS);
        const f32x4* gr = (const f32x4*)gain + lane;
        u32x2* o = (u32x2*)(XN + (size_t)m * D) + lane;
#pragma unroll
        for (int j = 0; j < 8; ++j) { const f32x4 g = gr[64 * j]; u32x2 w; w.x = pk2(v[j].x * r * g.x, v[j].y * r * g.y); w.y = pk2(v[j].z * r * g.z, v[j].w * r * g.w); o[64 * j] = w; }
    }
}
__device__ __forceinline__ void final_phase(const float* X, const float* gain, float* Y, int gw, int NGW, int lane) {
    for (int m = gw; m < M; m += NGW) {
        const f32x4* xr = (const f32x4*)(X + (size_t)m * D) + lane;
        f32x4 v[8]; float s = 0.f;
#pragma unroll
        for (int j = 0; j < 8; ++j) { v[j] = xr[64 * j]; s += (v[j].x * v[j].x + v[j].y * v[j].y) + (v[j].z * v[j].z + v[j].w * v[j].w); }
        const float r = __builtin_amdgcn_rsqf(wave_sum(s) * (1.f / D) + EPS);
        const f32x4* gr = (const f32x4*)gain + lane;
        f32x4* o = (f32x4*)(Y + (size_t)m * D) + lane;
#pragma unroll
        for (int j = 0; j < 8; ++j) o[64 * j] = v[j] * r * gr[64 * j];
    }
}
template <int NG>
__device__ __forceinline__ void post_phase(const float* O, const float* gain, const bf16_t* G, bf16_t* OG, int gw, int NGW, int lane) {
    for (int m = gw; m < M; m += NGW) {
        const f32x4* xr = (const f32x4*)(O + (size_t)m * D) + lane;
        f32x4 v[8]; float s[NG];
#pragma unroll
        for (int g = 0; g < NG; ++g) s[g] = 0.f;
#pragma unroll
        for (int j = 0; j < 8; ++j) { v[j] = xr[64 * j]; s[j * NG / 8] += (v[j].x * v[j].x + v[j].y * v[j].y) + (v[j].z * v[j].z + v[j].w * v[j].w); }
        float r[NG];
#pragma unroll
        for (int g = 0; g < NG; ++g) r[g] = __builtin_amdgcn_rsqf(wave_sum(s[g]) * ((float)NG / D) + EPS);
        const f32x4* gr = (const f32x4*)gain + lane;
        const u32x2* gg = (const u32x2*)(G + (size_t)m * D) + lane;
        u32x2* o = (u32x2*)(OG + (size_t)m * D) + lane;
#pragma unroll
        for (int j = 0; j < 8; ++j) { const f32x4 g = gr[64 * j]; const u32x2 gw2 = gg[64 * j]; const float rr = r[j * NG / 8];
            u32x2 w; w.x = pk2(v[j].x * rr * g.x * bflo(gw2.x), v[j].y * rr * g.y * bfhi(gw2.x)); w.y = pk2(v[j].z * rr * g.z * bflo(gw2.y), v[j].w * rr * g.w * bfhi(gw2.y)); o[64 * j] = w; }
    }
}

template <int KT> struct LdBf;
template <> struct LdBf<4> { static __device__ __forceinline__ void ld(const bf16_t* p, float* o) { const u32x2 w = *(const u32x2*)p; o[0] = bflo(w.x); o[1] = bfhi(w.x); o[2] = bflo(w.y); o[3] = bfhi(w.y); } };
template <> struct LdBf<8> { static __device__ __forceinline__ void ld(const bf16_t* p, float* o) { const u32x4 w = *(const u32x4*)p; o[0] = bflo(w.x); o[1] = bfhi(w.x); o[2] = bflo(w.y); o[3] = bfhi(w.y); o[4] = bflo(w.z); o[5] = bfhi(w.z); o[6] = bflo(w.w); o[7] = bfhi(w.w); } };
template <int K, int VH, int NH>
__device__ __forceinline__ void scan_simple(const bf16_t* Q, const bf16_t* KK, const float* LF, const bf16_t* V, float* O,
                                            const float* S0, float* SPo, float* SSo, int tid, int G) {
    constexpr int KT = K / 32, NVB = VH / 16;
    const int vi = tid >> 5, kg = tid & 31;
    const int nunits = (PB + SB) * NH * NVB;
    for (int u = blockIdx.x; u < nunits; u += G) {
        const int seq = u / (NH * NVB), rem = u % (NH * NVB), h = rem / NVB, vb = rem % NVB;
        int row0, T; if (seq < PB) { row0 = seq * PT; T = PT; } else { row0 = MP + (seq - PB) * ST; T = ST; }
        float S[KT];
        const size_t sidx = ((size_t)h * K + kg * KT) * VH + vb * 16 + vi;
        if (seq >= PB) { const float* s0 = S0 + (size_t)(seq - PB) * NH * K * VH + sidx;
#pragma unroll
            for (int j = 0; j < KT; ++j) S[j] = s0[(size_t)j * VH]; }
        else {
#pragma unroll
            for (int j = 0; j < KT; ++j) S[j] = 0.f; }
        const int ccol = h * K + kg * KT, vcol = h * VH + vb * 16 + vi;
#pragma unroll 4
        for (int t = 0; t < T; ++t) {
            const size_t r = (size_t)(row0 + t) * D;
            float qf[KT], kf[KT], lf[KT];
            LdBf<KT>::ld(Q + r + ccol, qf); LdBf<KT>::ld(KK + r + ccol, kf);
#pragma unroll
            for (int j = 0; j < KT; j += 4) { const f32x4 l4 = *(const f32x4*)(LF + r + ccol + j); lf[j] = l4.x; lf[j + 1] = l4.y; lf[j + 2] = l4.z; lf[j + 3] = l4.w; }
            const float vv = bf2f(V[r + vcol]);
            float po = 0.f;
#pragma unroll
            for (int j = 0; j < KT; ++j) { S[j] = __expf(lf[j]) * S[j] + kf[j] * vv; po += qf[j] * S[j]; }
#pragma unroll
            for (int o = 1; o < 32; o <<= 1) po += __shfl_xor(po, o);
            if (kg == 0) O[r + vcol] = po;
        }
        float* so = (seq < PB ? SPo + (size_t)seq * NH * K * VH : SSo + (size_t)(seq - PB) * NH * K * VH) + sidx;
#pragma unroll
        for (int j = 0; j < KT; ++j) so[(size_t)j * VH] = S[j];
    }
}


__device__ __forceinline__ int permK(int c) { const int kk = c & 31; return (c & ~31) + 8 * ((kk & 15) >> 2) + 4 * (kk >> 4) + (kk & 3); }
template <int K, int VH, int NH>
__device__ __forceinline__ void scan_s1(const bf16_t* Q, const bf16_t* KK, const float* LF, const bf16_t* V, bf16_t* QI, bf16_t* KDT, bf16_t* AM, bf16_t* VT, float* DL,
                                        LAS unsigned char* lds, int tid, int G, int bx) {
    constexpr int RG = 512 / K, RPT = 64 / RG, KS = K * 2 + 16, NHK = NH * K;
    constexpr int L_TOT = 0, L_QT = 2048, L_KT = L_QT + 64 * KS, L_VTT = L_QT;
    static_assert(L_VTT + VH * 144 <= RING_BYTES && L_KT + 64 * KS <= RING_BYTES, "S1 LDS");
    const int c = tid % K, rg = tid / K, lane = tid & 63, wave = tid >> 6, l15 = lane & 15, g4 = lane >> 4;
    LAS float* TOT = (LAS float*)(lds + L_TOT);
    for (int u = bx; u < 144 * NH; u += G) {
        const int blk = u / NH, h = u % NH, r0 = blk * 64; const bool is_prompt = blk < 128;
        __syncthreads();
        float b[RPT];
        { const float* lfp = LF + (size_t)(r0 + rg * RPT) * D + h * K + c;
#pragma unroll
          for (int i = 0; i < RPT; ++i) b[i] = lfp[(size_t)i * D]; }
        float bref = 0.f, blast = 0.f;
        if (is_prompt) {
#pragma unroll
            for (int i = 1; i < RPT; ++i) b[i] += b[i - 1];
            TOT[rg * K + c] = b[RPT - 1];
            __syncthreads();
            float pre = 0.f, tot = 0.f;
#pragma unroll
            for (int r = 0; r < RG; ++r) { const float t = TOT[r * K + c]; if (r < rg) pre += t; if (r * RPT < 32) bref += t; tot += t; }
            blast = tot;
#pragma unroll
            for (int i = 0; i < RPT; ++i) b[i] += pre;
        } else {
#pragma unroll
            for (int i = 0; i < RPT; ++i) if (i & 7) b[i] += b[i - 1];
        }
        unsigned kdp[RPT / 2];
#pragma unroll
        for (int i = 0; i < RPT; i += 2) {
            float kdv[2];
#pragma unroll
            for (int e = 0; e < 2; ++e) {
                const int t = rg * RPT + i + e; const size_t ro = (size_t)(r0 + t) * D + h * K + c;
                const float qv = bf2f(Q[ro]), kv = bf2f(KK[ro]), bb = b[i + e];
                const float bl = is_prompt ? blast : b[(i + e) | 7];
                const float qi = qv * __expf(bb);
                kdv[e] = kv * __expf(bl - bb);
                const float qt = is_prompt ? qv * __expf(fminf(bb - bref, 80.f)) : qi;
                const float kt = kv * __expf(fminf(bref - bb, 80.f));
                QI[(size_t)(r0 + t) * NHK + h * K + permK(c)] = (bf16_t)f2bf(qi);
                *(LAS bf16_t*)(lds + L_QT + t * KS + c * 2) = (bf16_t)f2bf(qt);
                *(LAS bf16_t*)(lds + L_KT + t * KS + c * 2) = (bf16_t)f2bf(kt);
                if (!is_prompt && ((i + e) & 7) == 7) DL[(size_t)(128 + (blk - 128) * 8 + (t >> 3)) * NHK + h * K + c] = __expf(bb);
            }
            kdp[i / 2] = pk2(kdv[0], kdv[1]);
        }
        if (is_prompt && rg == 0) DL[(size_t)blk * NHK + h * K + c] = __expf(blast);
        { bf16_t* kp = KDT + ((size_t)(blk * NH + h) * K + c) * 64 + rg * RPT;
#pragma unroll
          for (int n = 0; n < RPT / 8; ++n) { u32x4 w; w.x = kdp[4 * n]; w.y = kdp[4 * n + 1]; w.z = kdp[4 * n + 2]; w.w = kdp[4 * n + 3]; *(u32x4*)(kp + 8 * n) = w; } }
        __syncthreads();
        { const int tt = wave >> 1;
#pragma unroll
          for (int e = 0; e < 2; ++e) {
              const int st = (wave & 1) * 2 + e;
              f32x4 acc = (f32x4){0.f, 0.f, 0.f, 0.f};
              if (st <= tt) {
#pragma unroll
                  for (int ks = 0; ks < K / 32; ++ks) {
                      const bf16x8 af = *(const LAS bf16x8*)(lds + L_KT + (16 * st + l15) * KS + ks * 64 + g4 * 16);
                      const bf16x8 bfr = *(const LAS bf16x8*)(lds + L_QT + (16 * tt + l15) * KS + ks * 64 + g4 * 16);
                      acc = __builtin_amdgcn_mfma_f32_16x16x32_bf16(af, bfr, acc, 0, 0, 0);
                  }
              }
              const int t = 16 * tt + l15; float o[4];
#pragma unroll
              for (int r = 0; r < 4; ++r) { const int sidx = 16 * st + 4 * g4 + r; const bool keep = (sidx <= t) && (is_prompt || (sidx >> 3) == (t >> 3)); o[r] = keep ? acc[r] : 0.f; }
              u32x2 w; w.x = pk2(o[0], o[1]); w.y = pk2(o[2], o[3]);
              *(u32x2*)(AM + ((size_t)(blk * NH + h) * 64 + t) * 64 + 16 * st + 4 * g4) = w;
          } }
        __syncthreads();
        { constexpr int NP = 64 * VH / 8 / 512;
#pragma unroll
          for (int n = 0; n < NP; ++n) { const int p = tid + n * 512, sr = p / (VH / 8), v8 = p % (VH / 8);
              const u32x4 w = *(const u32x4*)(V + (size_t)(r0 + sr) * D + h * VH + v8 * 8);
              LAS bf16_t* d = (LAS bf16_t*)(lds + L_VTT) + (v8 * 8) * 72 + sr;
              d[0 * 72] = (bf16_t)(w.x & 0xffff); d[1 * 72] = (bf16_t)(w.x >> 16); d[2 * 72] = (bf16_t)(w.y & 0xffff); d[3 * 72] = (bf16_t)(w.y >> 16);
              d[4 * 72] = (bf16_t)(w.z & 0xffff); d[5 * 72] = (bf16_t)(w.z >> 16); d[6 * 72] = (bf16_t)(w.w & 0xffff); d[7 * 72] = (bf16_t)(w.w >> 16); }
          __syncthreads();
#pragma unroll
          for (int n = 0; n < NP; ++n) { const int p = tid + n * 512, v = p >> 3, s8 = p & 7;
              const u32x4 w = *(const LAS u32x4*)(lds + L_VTT + v * 144 + s8 * 16);
              *(u32x4*)(VT + ((size_t)(blk * NH + h) * VH + v) * 64 + s8 * 8) = w; } }
    }
}

template <int K, int VH, int NH>
__device__ __forceinline__ void scan_s2(const bf16_t* QI, const bf16_t* KDT, const bf16_t* AM, const bf16_t* VT, const float* DL, const float* S0, float* SPo, float* SSo, float* O,
                                        LAS unsigned char* lds, unsigned* qhead, int tid, int G, int bx) {
    constexpr int NVQ = VH / 128, NKT = K / 16, NKS = K / 32, QS = K * 2 + 16, RS = 144, NHK = NH * K;
    constexpr int L_QI = 0, L_KDT = L_QI + 64 * QS, L_A = L_KDT + K * RS, L_VT = L_A + 64 * RS, L_DL = L_VT + 128 * RS, L_END = L_DL + 8 * K * 4;
    static_assert(L_END <= RING_BYTES, "S2 LDS");
    constexpr int P_QI = 64 * (K / 8) / 512, P_KD = K * 8 / 512;
    const int lane = tid & 63, wave = tid >> 6, l15 = lane & 15, g4 = lane >> 4;
    volatile LAS unsigned* qslot = (volatile LAS unsigned*)(lds + MISC_OFF + 64);

    u32x4 rq[P_QI], rk[P_KD], ra, rv[2], rd;
#define S2_LOAD(blk_, h_, vq_, ndl_) do { const int _blk = (blk_), _h = (h_), _vq = (vq_); \
        _Pragma("unroll") for (int n = 0; n < P_QI; ++n) { const int p = tid + n * 512, row = p / (K / 8), pc = p % (K / 8); rq[n] = *(const u32x4*)(QI + (size_t)(_blk * 64 + row) * NHK + _h * K + pc * 8); } \
        _Pragma("unroll") for (int n = 0; n < P_KD; ++n) { const int p = tid + n * 512; rk[n] = *(const u32x4*)(KDT + (size_t)(_blk * NH + _h) * K * 64 + (size_t)p * 8); } \
        ra = *(const u32x4*)(AM + (size_t)(_blk * NH + _h) * 4096 + (size_t)tid * 8); \
        _Pragma("unroll") for (int n = 0; n < 2; ++n) { const int p = tid + n * 512; rv[n] = *(const u32x4*)(VT + ((size_t)(_blk * NH + _h) * VH + _vq * 128) * 64 + (size_t)p * 8); } \
        if ((ndl_) == 1) { if (tid < K / 4) rd = *(const u32x4*)(DL + (size_t)_blk * NHK + _h * K + tid * 4); } \
        else { if (tid < 2 * K) { const int sg = tid / (K / 4), pc = tid % (K / 4); rd = *(const u32x4*)(DL + (size_t)(128 + (_blk - 128) * 8 + sg) * NHK + _h * K + pc * 4); } } } while (0)
#define S2_STORE(ndl_) do { \
        _Pragma("unroll") for (int n = 0; n < P_QI; ++n) { const int p = tid + n * 512, row = p / (K / 8), pc = p % (K / 8); *(LAS u32x4*)(lds + L_QI + row * QS + pc * 16) = rq[n]; } \
        _Pragma("unroll") for (int n = 0; n < P_KD; ++n) { const int p = tid + n * 512; *(LAS u32x4*)(lds + L_KDT + (p >> 3) * RS + (p & 7) * 16) = rk[n]; } \
        *(LAS u32x4*)(lds + L_A + (tid >> 3) * RS + (tid & 7) * 16) = ra; \
        _Pragma("unroll") for (int n = 0; n < 2; ++n) { const int p = tid + n * 512; *(LAS u32x4*)(lds + L_VT + (p >> 3) * RS + (p & 7) * 16) = rv[n]; } \
        if ((ndl_) == 1) { if (tid < K / 4) *(LAS u32x4*)(lds + L_DL + tid * 16) = rd; } \
        else { if (tid < 2 * K) *(LAS u32x4*)(lds + L_DL + tid * 16) = rd; } } while (0)

    f32x4 S[NKT];
    if (bx < PB * NH * NVQ) {
        const int b = bx / (NH * NVQ), h = (bx / NVQ) % NH, vq = bx % NVQ;
        const int col = h * VH + vq * 128 + wave * 16 + l15;
#pragma unroll
        for (int kt = 0; kt < NKT; ++kt) S[kt] = (f32x4){0.f, 0.f, 0.f, 0.f};
        __syncthreads();
        S2_LOAD(b * 32, h, vq, 1); S2_STORE(1);
        __syncthreads();
#pragma unroll 1
        for (int ch = 0; ch < 32; ++ch) {
            const int blk = b * 32 + ch;
            if (ch + 1 < 32) S2_LOAD(blk + 1, h, vq, 1);
            bf16x8 vfr[2];
#pragma unroll
            for (int ss = 0; ss < 2; ++ss) vfr[ss] = *(const LAS bf16x8*)(lds + L_VT + (wave * 16 + l15) * RS + ss * 64 + g4 * 16);
            f32x4 oacc[4];
#pragma unroll
            for (int tt = 0; tt < 4; ++tt) oacc[tt] = (f32x4){0.f, 0.f, 0.f, 0.f};
#pragma unroll
            for (int ks = 0; ks < NKS; ++ks) {
                union { u32x4 u; bf16x8 v; } sb;
                sb.u.x = cvt_pk_bf16(S[2 * ks][0], S[2 * ks][1]); sb.u.y = cvt_pk_bf16(S[2 * ks][2], S[2 * ks][3]);
                sb.u.z = cvt_pk_bf16(S[2 * ks + 1][0], S[2 * ks + 1][1]); sb.u.w = cvt_pk_bf16(S[2 * ks + 1][2], S[2 * ks + 1][3]);
#pragma unroll
                for (int tt = 0; tt < 4; ++tt) { const bf16x8 af = *(const LAS bf16x8*)(lds + L_QI + (16 * tt + l15) * QS + ks * 64 + g4 * 16);
                    oacc[tt] = __builtin_amdgcn_mfma_f32_16x16x32_bf16(af, sb.v, oacc[tt], 0, 0, 0); }
            }
#pragma unroll
            for (int tt = 0; tt < 4; ++tt)
#pragma unroll
                for (int ss = 0; ss < 2; ++ss) { const bf16x8 af = *(const LAS bf16x8*)(lds + L_A + (16 * tt + l15) * RS + ss * 64 + g4 * 16);
                    oacc[tt] = __builtin_amdgcn_mfma_f32_16x16x32_bf16(af, vfr[ss], oacc[tt], 0, 0, 0); }
#pragma unroll
            for (int kt = 0; kt < NKT; ++kt) {
                const f32x4 dl = *(const LAS f32x4*)(lds + L_DL + (16 * kt + 4 * g4) * 4);
                S[kt] = S[kt] * dl;
#pragma unroll
                for (int ss = 0; ss < 2; ++ss) { const bf16x8 af = *(const LAS bf16x8*)(lds + L_KDT + (16 * kt + l15) * RS + ss * 64 + g4 * 16);
                    S[kt] = __builtin_amdgcn_mfma_f32_16x16x32_bf16(af, vfr[ss], S[kt], 0, 0, 0); }
            }
#pragma unroll
            for (int tt = 0; tt < 4; ++tt)
#pragma unroll
                for (int r = 0; r < 4; ++r) O[(size_t)(blk * 64 + 16 * tt + 4 * g4 + r) * D + col] = oacc[tt][r];
            __syncthreads();
            if (ch + 1 < 32) S2_STORE(1);
            __syncthreads();
        }
        float* so = SPo + ((size_t)(b * NH + h) * K) * VH + vq * 128 + wave * 16 + l15;
#pragma unroll
        for (int kt = 0; kt < NKT; ++kt)
#pragma unroll
            for (int r = 0; r < 4; ++r) so[(size_t)(16 * kt + 4 * g4 + r) * VH] = S[kt][r];
    }
    constexpr int NTASK = 16 * NH * NVQ * 2;
    for (;;) {
        __syncthreads();
        if (tid == 0) qslot[0] = __hip_atomic_fetch_add(qhead, 1u, __ATOMIC_RELAXED, __HIP_MEMORY_SCOPE_AGENT);
        __syncthreads();
        const int task = (int)qslot[0];
        if (task >= NTASK) break;
        const int half = task & 1, vq = (task >> 1) % NVQ, h = (task / (2 * NVQ)) % NH, sblk = task / (2 * NVQ * NH), blk = 128 + sblk;
        const int col = h * VH + vq * 128 + wave * 16 + l15;
        S2_LOAD(blk, h, vq, 8); S2_STORE(8);
        __syncthreads();
        const bf16x8 vfr0 = *(const LAS bf16x8*)(lds + L_VT + (wave * 16 + l15) * RS + half * 64 + g4 * 16);
#pragma unroll 1
        for (int jj = 0; jj < 4; ++jj) {
            const int j = half * 4 + jj, bseq = sblk * 8 + j;
            const float* s0 = S0 + ((size_t)(bseq * NH + h) * K) * VH + vq * 128 + wave * 16 + l15;
#pragma unroll
            for (int kt = 0; kt < NKT; ++kt)
#pragma unroll
                for (int r = 0; r < 4; ++r) S[kt][r] = s0[(size_t)(16 * kt + 4 * g4 + r) * VH];
            const int arow = 8 * j + (l15 & 7);
            f32x4 oacc = (f32x4){0.f, 0.f, 0.f, 0.f};
#pragma unroll
            for (int ks = 0; ks < NKS; ++ks) {
                union { u32x4 u; bf16x8 v; } sb;
                sb.u.x = cvt_pk_bf16(S[2 * ks][0], S[2 * ks][1]); sb.u.y = cvt_pk_bf16(S[2 * ks][2], S[2 * ks][3]);
                sb.u.z = cvt_pk_bf16(S[2 * ks + 1][0], S[2 * ks + 1][1]); sb.u.w = cvt_pk_bf16(S[2 * ks + 1][2], S[2 * ks + 1][3]);
                const bf16x8 af = *(const LAS bf16x8*)(lds + L_QI + arow * QS + ks * 64 + g4 * 16);
                oacc = __builtin_amdgcn_mfma_f32_16x16x32_bf16(af, sb.v, oacc, 0, 0, 0);
            }
            { const bf16x8 af = *(const LAS bf16x8*)(lds + L_A + arow * RS + half * 64 + g4 * 16);
              oacc = __builtin_amdgcn_mfma_f32_16x16x32_bf16(af, vfr0, oacc, 0, 0, 0); }
#pragma unroll
            for (int kt = 0; kt < NKT; ++kt) {
                const f32x4 dl = *(const LAS f32x4*)(lds + L_DL + j * K * 4 + (16 * kt + 4 * g4) * 4);
                S[kt] = S[kt] * dl;
                union { u32x4 u; bf16x8 v; } af; af.u = *(const LAS u32x4*)(lds + L_KDT + (16 * kt + l15) * RS + half * 64 + g4 * 16);
                if (g4 != jj) af.u = (u32x4){0u, 0u, 0u, 0u};
                S[kt] = __builtin_amdgcn_mfma_f32_16x16x32_bf16(af.v, vfr0, S[kt], 0, 0, 0);
            }
            if (g4 < 2) {
#pragma unroll
                for (int r = 0; r < 4; ++r) O[(size_t)(blk * 64 + 8 * j + 4 * g4 + r) * D + col] = oacc[r];
            }
            float* so = SSo + ((size_t)(bseq * NH + h) * K) * VH + vq * 128 + wave * 16 + l15;
#pragma unroll
            for (int kt = 0; kt < NKT; ++kt)
#pragma unroll
                for (int r = 0; r < 4; ++r) so[(size_t)(16 * kt + 4 * g4 + r) * VH] = S[kt][r];
        }
    }
#undef S2_LOAD
#undef S2_STORE
}

template <int NR>
__device__ __forceinline__ void pool_segment(const float* X, int row0, int tabs0  , const float* hsrc, const LAS float* rs  ,
                                             const f32x4 gain, int w, bool is_prompt, bf16_t* Y, float* pstate  , float* sstate  , int c0) {
    f32x4 ring[16]; f32x4 wsum = (f32x4){0.f, 0.f, 0.f, 0.f};
#pragma unroll
    for (int i = 0; i < 16; ++i) ring[i] = (f32x4){0.f, 0.f, 0.f, 0.f};
#pragma unroll
    for (int i = 0; i < 15 + NR; ++i) {
        f32x4 val;
        if (i < 15) {
            if (hsrc) val = *(const f32x4*)(hsrc + (size_t)i * D + c0);
            else { const int t = tabs0 - 15 + i; val = (t >= 0) ? *(const f32x4*)(X + (size_t)(row0 - 15 + i) * D + c0) * rs[i] * gain : (f32x4){0.f, 0.f, 0.f, 0.f}; }
        } else val = *(const f32x4*)(X + (size_t)(row0 + i - 15) * D + c0) * rs[i] * gain;
        const f32x4 old = (w == 2) ? ring[(i - 2) & 15] : (w == 4) ? ring[(i - 4) & 15] : (w == 8) ? ring[(i - 8) & 15] : ring[i & 15];
        wsum = wsum + val - old;
        ring[i & 15] = val;
        if (i >= 15) {
            const int t = i - 15;
            float cnt = (float)w; if (is_prompt) { const int have = tabs0 + t + 1; cnt = (float)(have < w ? have : w); }
            const float ic = 1.f / cnt;
            const f32x4 y = wsum * ic - val;
            u32x2 o; o.x = pk2(y.x, y.y); o.y = pk2(y.z, y.w);
            *(u32x2*)(Y + (size_t)(row0 + t) * D + c0) = o;
            if (is_prompt) { if (pstate) { const int tt = tabs0 + t - (PT - POOLBUF); if (tt >= 0) *(f32x4*)(pstate + (size_t)tt * D + c0) = val; } }
            else *(f32x4*)(sstate + (size_t)(7 + t) * D + c0) = val;
        }
    }
    if (!is_prompt) {
#pragma unroll
        for (int i = 0; i < 7; ++i) *(f32x4*)(sstate + (size_t)i * D + c0) = *(const f32x4*)(hsrc + (size_t)(8 + i) * D + c0);
    }
}
__device__ __forceinline__ void pool_pre_phase(CParams* P, LAS unsigned char* lds, const float* X, const float* gain, bf16_t* Y, int tid, int wave, int lane, int G) {
    LAS float* rs = (LAS float*)lds;
    const int c0 = tid * 4, w = 2 << (c0 >> 9);
    const f32x4 g4 = *(const f32x4*)(gain + c0);
    for (int u = blockIdx.x; u < M / 32; u += G) {
        const int r0 = u * 32; const bool is_prompt = r0 < MP;
        __syncthreads();
        for (int i = wave; i < 47; i += NWAVES) {
            const int row = r0 - 15 + i;
            const bool need = is_prompt ? ((r0 % PT) - 15 + i >= 0) : (i >= 15);
            float r = 0.f;
            if (need) { const f32x4* xr = (const f32x4*)(X + (size_t)row * D) + lane; float s = 0.f;
#pragma unroll
                for (int j = 0; j < 8; ++j) { const f32x4 v = xr[64 * j]; s += (v.x * v.x + v.y * v.y) + (v.z * v.z + v.w * v.w); }
                r = __builtin_amdgcn_rsqf(wave_sum(s) * (1.f / D) + EPS); }
            if (lane == 0) rs[i] = r;
        }
        __syncthreads();
        if (is_prompt) {
            const int b = r0 / PT, t0 = r0 % PT;
            float* pst = (t0 + 32 == PT) ? P->out + OUT_POOL_P + (size_t)b * POOLBUF * D : nullptr;
            pool_segment<32>(X, r0, t0, nullptr, rs, g4, w, true, Y, pst, nullptr, c0);
        } else {
            for (int sgi = 0; sgi < 4; ++sgi) {
                const int b = (r0 - MP) / ST + sgi;
                pool_segment<8>(X, r0 + sgi * 8, 0, P->in[I_SPOOL] + (size_t)b * POOLBUF * D, rs + sgi * 8, g4, w, false, Y, nullptr, P->out + OUT_POOL_S + (size_t)b * POOLBUF * D, c0);
            }
        }
    }
}

constexpr int NPHASE = 50;
__host__ __device__ inline bool phase_exists(int ph) { if (ph == 0 || ph == NPHASE - 1) return true; const int li = (ph - 1) / 12, k = (ph - 1) % 12; if (li % 3 == 2 && (k >= 4 && k <= 7)) return false;
#if USE_SIMPLE_SCAN
    if (k == 5) return false;
#endif
    return true; }

__device__ __forceinline__ CParams* fresh_params() { CParams* p = (CParams*)__builtin_amdgcn_kernarg_segment_ptr(); asm volatile("" : "+s"(p)); return p; }
__device__ __forceinline__ int fresh_tid(int wave0) { int l = __builtin_amdgcn_mbcnt_hi(~0u, __builtin_amdgcn_mbcnt_lo(~0u, 0u)); asm volatile("" : "+v"(l)); return wave0 * 64 + l; }
#define SITE_BEGIN CParams* pp = fresh_params(); unsigned char* ws = pp->ws; const int tid = fresh_tid(wave0), lane = tid & 63, wave = __builtin_amdgcn_readfirstlane(tid >> 6), G = gridDim.x, bx = blockIdx.x, gw = bx * NWAVES + wave, NGW = G * NWAVES; \
    (void)ws; (void)lane; (void)wave; (void)gw; (void)NGW; (void)tid; (void)G; (void)bx;
#define WSP(T, off) ((T*)(ws + (off)))

__global__ void __launch_bounds__(NTHREADS, 2) mega_fwd(Params P) {
    extern __shared__ __attribute__((aligned(16))) unsigned char lds_raw[];
    LAS unsigned char* lds = (LAS unsigned char*)lds_raw;
    volatile LAS unsigned* MISC = (volatile LAS unsigned*)(lds + MISC_OFF);
    const int wave0 = __builtin_amdgcn_readfirstlane(threadIdx.x >> 6);
    for (int u = threadIdx.x; u < (LDS_BYTES - LDSCTL_OFF) / 4; u += NTHREADS) ((LAS unsigned*)(lds + LDSCTL_OFF))[u] = 0u;
    __syncthreads();
    const int lo = P.ph_lo, hi = P.ph_hi;
    XcdBarrier bar; bar.bar = (unsigned*)(P.ws + WS_CTL) + CW_BAR; bar.x = 0; bar.st = nullptr;
    if (hi - lo > 1) bar = xcd_barrier_post((unsigned*)(P.ws + WS_CTL) + CW_BAR, MISC + 8);
#define IN(k) (lo <= (k) && (k) < hi)
#define SEAM(k) do { if ((k) + 1 < hi) xcd_barrier(bar, fresh_tid(wave0) == 0); } while (0)

    if (IN(0)) { { SITE_BEGIN prologue_phase(pp, lds, gw, NGW, wave, lane); } SEAM(0); }

#pragma unroll 1
    for (int li = 0; li < NLAYER; ++li) {
        const int pb = 1 + li * 12, kind = li % 3, j = li / 3;
#pragma unroll 1
        for (int which = 0; which < 2; ++which) {
            const int p0 = pb + (which ? 9 : 0), s = li * 2 + which;
            if (IN(p0)) { { SITE_BEGIN norm_phase(WSP(float, WS_X), pp->in[which ? I_NF2 : I_NF1] + (size_t)li * D, WSP(bf16_t, WS_XN), gw, NGW, lane); } SEAM(p0); }
            if (IN(p0 + 1)) {
                { SITE_BEGIN
                pg8::Gemm g{WSP(bf16_t, WS_XN), (const bf16_t*)(ws + WS_WGU + (size_t)s * SZ_WGU1), D, D, D, M / 256, 2 * FF / 256, 0};
                pg8::StaticOrder S; S.init(g.nM, g.nN, G, bx);
                EpiGU E{WSP(bf16_t, WS_H)};
                pg8::gemm_phase(lds, g, S, E, tid); }
                SEAM(p0 + 1);
            }
            if (IN(p0 + 2)) {
                { SITE_BEGIN
                pg8::Gemm g{WSP(bf16_t, WS_H), (const bf16_t*)(ws + WS_WDN + (size_t)s * SZ_WDN1), FF, FF, FF, M / 256, D / 256, 0};
                pg8::StaticOrder S; S.init(g.nM, g.nN, G, bx);
                EpiRes E{WSP(float, WS_X), 0.5f, nullptr};
                pg8::gemm_phase(lds, g, S, E, tid); }
                SEAM(p0 + 2);
            }
            if (which == 1) continue;
            if (kind == 0) {
                if (IN(pb + 3)) { { SITE_BEGIN norm_phase(WSP(float, WS_X), pp->in[I_NMIX] + (size_t)li * D, WSP(bf16_t, WS_XN), gw, NGW, lane); } SEAM(pb + 3); }
                if (IN(pb + 4)) {
                    { SITE_BEGIN
                    pg8::Gemm g{WSP(bf16_t, WS_XN), WSP(const bf16_t, WS_WHIN) + (size_t)j * 8192 * D, D, D, D, M / 256, 8192 / 256, 0};
                    pg8::StaticOrder S; S.init(g.nM, g.nN, G, bx);
                    EpiHG E{WSP(bf16_t, WS_Q), WSP(bf16_t, WS_KK), WSP(bf16_t, WS_V), WSP(bf16_t, WS_G), WSP(float, WS_LF), WSP(const float, WS_TAB) + (size_t)j * D};
                    pg8::gemm_phase(lds, g, S, E, tid); }
                    SEAM(pb + 4);
                }
#if USE_SIMPLE_SCAN
                if (IN(pb + 6)) {
                    { SITE_BEGIN
                    scan_simple<HG_K, HG_V, HG_H>(WSP(bf16_t, WS_Q), WSP(bf16_t, WS_KK), WSP(float, WS_LF), WSP(bf16_t, WS_V), WSP(float, WS_O), pp->in[I_SHG] + (size_t)j * SB * HG_H * HG_K * HG_V,
                        pp->out + OUT_HG_P + (size_t)j * PB * HG_H * HG_K * HG_V, pp->out + OUT_HG_S + (size_t)j * SB * HG_H * HG_K * HG_V, tid, G); }
                    SEAM(pb + 6);
                }
#else
                if (IN(pb + 5)) {
                    { SITE_BEGIN
                    scan_s1<HG_K, HG_V, HG_H>(WSP(bf16_t, WS_Q), WSP(bf16_t, WS_KK), WSP(float, WS_LF), WSP(bf16_t, WS_V), WSP(bf16_t, WS_QI), WSP(bf16_t, WS_KDT), WSP(bf16_t, WS_AM), WSP(bf16_t, WS_VT), WSP(float, WS_DL), lds, tid, G, bx); }
                    SEAM(pb + 5);
                }
                if (IN(pb + 6)) {
                    { SITE_BEGIN
                    scan_s2<HG_K, HG_V, HG_H>(WSP(bf16_t, WS_QI), WSP(bf16_t, WS_KDT), WSP(bf16_t, WS_AM), WSP(bf16_t, WS_VT), WSP(float, WS_DL), pp->in[I_SHG] + (size_t)j * SB * HG_H * HG_K * HG_V,
                        pp->out + OUT_HG_P + (size_t)j * PB * HG_H * HG_K * HG_V, pp->out + OUT_HG_S + (size_t)j * SB * HG_H * HG_K * HG_V, WSP(float, WS_O), lds, WSP(unsigned, WS_CTL) + CW_QUEUE + 64 * li, tid, G, bx); }
                    SEAM(pb + 6);
                }
#endif
                if (IN(pb + 7)) { { SITE_BEGIN post_phase<1>(WSP(float, WS_O), pp->in[I_HON] + (size_t)j * D, WSP(bf16_t, WS_G), WSP(bf16_t, WS_XN), gw, NGW, lane); } SEAM(pb + 7); }
                if (IN(pb + 8)) {
                    { SITE_BEGIN
                    pg8::Gemm g{WSP(bf16_t, WS_XN), WSP(const bf16_t, WS_WHOUT) + (size_t)j * D * D, D, D, D, M / 256, D / 256, 0};
                    pg8::StaticOrder S; S.init(g.nM, g.nN, G, bx);
                    EpiRes E{WSP(float, WS_X), 1.0f, nullptr};
                    pg8::gemm_phase(lds, g, S, E, tid); }
                    SEAM(pb + 8);
                }
            } else if (kind == 1) {
                if (IN(pb + 3)) { { SITE_BEGIN norm_phase(WSP(float, WS_X), pp->in[I_NMIX] + (size_t)li * D, WSP(bf16_t, WS_XN), gw, NGW, lane); } SEAM(pb + 3); }
                if (IN(pb + 4)) {
                    { SITE_BEGIN
                    pg8::Gemm g{WSP(bf16_t, WS_XN), WSP(const bf16_t, WS_WGIN), D, D, D, M / 256, GL_NIN / 256, 0};
                    pg8::StaticOrder S; S.init(g.nM, g.nN, G, bx);
                    EpiGLA E{WSP(bf16_t, WS_Q), WSP(bf16_t, WS_KK), WSP(bf16_t, WS_V), WSP(bf16_t, WS_G), WSP(float, WS_LF), pp->in[I_GBG] + (size_t)j * GL_DK};
                    pg8::gemm_phase(lds, g, S, E, tid); }
                    SEAM(pb + 4);
                }
#if USE_SIMPLE_SCAN
                if (IN(pb + 6)) {
                    { SITE_BEGIN
                    scan_simple<GL_K, GL_V, GL_H>(WSP(bf16_t, WS_Q), WSP(bf16_t, WS_KK), WSP(float, WS_LF), WSP(bf16_t, WS_V), WSP(float, WS_O), pp->in[I_SGLA] + (size_t)j * SB * GL_H * GL_K * GL_V,
                        pp->out + OUT_GLA_P + (size_t)j * PB * GL_H * GL_K * GL_V, pp->out + OUT_GLA_S + (size_t)j * SB * GL_H * GL_K * GL_V, tid, G); }
                    SEAM(pb + 6);
                }
#else
                if (IN(pb + 5)) {
                    { SITE_BEGIN
                    scan_s1<GL_K, GL_V, GL_H>(WSP(bf16_t, WS_Q), WSP(bf16_t, WS_KK), WSP(float, WS_LF), WSP(bf16_t, WS_V), WSP(bf16_t, WS_QI), WSP(bf16_t, WS_KDT), WSP(bf16_t, WS_AM), WSP(bf16_t, WS_VT), WSP(float, WS_DL), lds, tid, G, bx); }
                    SEAM(pb + 5);
                }
                if (IN(pb + 6)) {
                    { SITE_BEGIN
                    scan_s2<GL_K, GL_V, GL_H>(WSP(bf16_t, WS_QI), WSP(bf16_t, WS_KDT), WSP(bf16_t, WS_AM), WSP(bf16_t, WS_VT), WSP(float, WS_DL), pp->in[I_SGLA] + (size_t)j * SB * GL_H * GL_K * GL_V,
                        pp->out + OUT_GLA_P + (size_t)j * PB * GL_H * GL_K * GL_V, pp->out + OUT_GLA_S + (size_t)j * SB * GL_H * GL_K * GL_V, WSP(float, WS_O), lds, WSP(unsigned, WS_CTL) + CW_QUEUE + 64 * li, tid, G, bx); }
                    SEAM(pb + 6);
                }
#endif
                if (IN(pb + 7)) { { SITE_BEGIN post_phase<4>(WSP(float, WS_O), pp->in[I_GON] + (size_t)j * D, WSP(bf16_t, WS_G), WSP(bf16_t, WS_XN), gw, NGW, lane); } SEAM(pb + 7); }
                if (IN(pb + 8)) {
                    { SITE_BEGIN
                    pg8::Gemm g{WSP(bf16_t, WS_XN), WSP(const bf16_t, WS_WGOUT), D, D, D, M / 256, D / 256, 0};
                    pg8::StaticOrder S; S.init(g.nM, g.nN, G, bx);
                    EpiRes E{WSP(float, WS_X), 1.0f, nullptr};
                    pg8::gemm_phase(lds, g, S, E, tid); }
                    SEAM(pb + 8);
                }
            } else {
                if (IN(pb + 3)) { { SITE_BEGIN pool_pre_phase(pp, lds, WSP(float, WS_X), pp->in[I_NMIX] + (size_t)li * D, WSP(bf16_t, WS_XN), tid, wave, lane, G); } SEAM(pb + 7); }
                if (IN(pb + 8)) {
                    { SITE_BEGIN
                    pg8::Gemm g{WSP(bf16_t, WS_XN), WSP(const bf16_t, WS_WPOOL), D, 512, 512, M / 256, D / 256, 1};
                    pg8::StaticOrder S; S.init(g.nM, g.nN, G, bx);
                    EpiRes E{WSP(float, WS_X), 1.0f, pp->in[I_PSC] + (size_t)j * D};
                    pg8::gemm_phase(lds, g, S, E, tid); }
                    SEAM(pb + 8);
                }
            }
        }
    }
    if (IN(NPHASE - 1)) { SITE_BEGIN final_phase(WSP(float, WS_X), pp->in[I_FN], pp->out + OUT_Y, gw, NGW, lane); }
#undef IN
#undef SEAM
}

extern "C" void kernel_launch(void* const* d_in, const int* in_sizes, int n_in, void* d_out, int out_size, void* d_ws, size_t ws_size, hipStream_t stream) {
    static int grid = 0;
    if (grid == 0) {
        if (n_in != 26 || (size_t)out_size != OUT_TOTAL || ws_size < WS_END) { fprintf(stderr, "kernel_launch: unexpected sizes n_in %d out %d ws %zu (need %zu)\n", n_in, out_size, ws_size, (size_t)WS_END); grid = -1; return; }
        int dev = 0, cus = 0, per_cu = 0;
        if (hipGetDevice(&dev) != hipSuccess || hipDeviceGetAttribute(&cus, hipDeviceAttributeMultiprocessorCount, dev) != hipSuccess) { grid = -1; return; }
        if (hipFuncSetAttribute((const void*)mega_fwd, hipFuncAttributeMaxDynamicSharedMemorySize, LDS_BYTES) != hipSuccess) { fprintf(stderr, "kernel_launch: hipFuncSetAttribute failed\n"); grid = -1; return; }
        if (hipOccupancyMaxActiveBlocksPerMultiprocessor(&per_cu, (const void*)mega_fwd, NTHREADS, LDS_BYTES) != hipSuccess || per_cu < 1) fprintf(stderr, "kernel_launch: occupancy query reports %d\n", per_cu);
        (void)hipGetLastError();
        grid = cus;
    }
    if (grid < 0) return;
    if (hipMemsetAsync((char*)d_ws + WS_CTL, 0, CTL_ZERO_BYTES, stream) != hipSuccess) return;
    Params p{};
    for (int i = 0; i < 26; ++i) p.in[i] = (const float*)d_in[i];
    p.out = (float*)d_out; p.ws = (unsigned char*)d_ws;
#if MK_PER_PHASE_LAUNCH
    for (int ph = 0; ph < NPHASE; ++ph) {
        if (!phase_exists(ph)) continue;
        p.ph_lo = ph; p.ph_hi = ph + 1;
        hipLaunchKernelGGL(mega_fwd, dim3(grid), dim3(NTHREADS), LDS_BYTES, stream, p);
    }
#else
    p.ph_lo = 0; p.ph_hi = NPHASE;
    hipLaunchKernelGGL(mega_fwd, dim3(grid), dim3(NTHREADS), LDS_BYTES, stream, p);
#endif
    (void)in_sizes;
}
```

```cpp
#include <hip/hip_runtime.h>
#include <cstdio>
#include <cstdint>

#ifndef USE_SIMPLE_SCAN
#define USE_SIMPLE_SCAN 0
#endif
#ifndef REP_PRO
#define REP_PRO 1
#endif
#ifndef REP_GU
#define REP_GU 1
#endif
#ifndef REP_SCAN
#define REP_SCAN 1
#endif
#ifndef REP_NORM
#define REP_NORM 1
#endif
#ifndef PROBE_MASK
#define PROBE_MASK 0
#endif
#ifndef PROBE_MUL
#define PROBE_MUL 4
#endif
#ifndef MK_PER_PHASE_LAUNCH
#define MK_PER_PHASE_LAUNCH 0
#endif

#define LAS __attribute__((address_space(3)))
#define GAS __attribute__((address_space(1)))
typedef unsigned short bf16_t;
typedef short bf16x8 __attribute__((ext_vector_type(8)));
typedef float f32x4 __attribute__((ext_vector_type(4)));
typedef float f32x2 __attribute__((ext_vector_type(2)));
typedef unsigned u32x4 __attribute__((ext_vector_type(4)));
typedef unsigned u32x2 __attribute__((ext_vector_type(2)));

constexpr int D = 2048, FF = 5632, NLAYER = 4;
constexpr int PB = 4, PT = 2048, SB = 128, ST = 8;
constexpr int MP = PB * PT, MS = SB * ST, M = MP + MS;
constexpr int HG_H = 16, HG_K = 128, HG_V = 128;
constexpr int GL_H = 4, GL_K = 256, GL_V = 512, GL_DK = 1024, GL_NIN = 7168, GL_WIN_LD = 6160;
constexpr int POOLBUF = 15;
constexpr float EPS = 1e-6f;
constexpr int NWAVES = 8, NTHREADS = 512;

constexpr size_t OUT_Y = 0;
constexpr size_t OUT_HG_P = (size_t)M * D;
constexpr size_t OUT_GLA_P = OUT_HG_P + (size_t)2 * PB * HG_H * HG_K * HG_V;
constexpr size_t OUT_POOL_P = OUT_GLA_P + (size_t)PB * GL_H * GL_K * GL_V;
constexpr size_t OUT_HG_S = OUT_POOL_P + (size_t)PB * POOLBUF * D;
constexpr size_t OUT_GLA_S = OUT_HG_S + (size_t)2 * SB * HG_H * HG_K * HG_V;
constexpr size_t OUT_POOL_S = OUT_GLA_S + (size_t)SB * GL_H * GL_K * GL_V;
constexpr size_t OUT_TOTAL = OUT_POOL_S + (size_t)SB * POOLBUF * D;
static_assert(OUT_TOTAL == 161341440ull, "output size");

constexpr size_t MiB = 1u << 20;
constexpr size_t al(size_t x) { return (x + MiB - 1) / MiB * MiB; }
constexpr size_t WS_CTL = 0, CTL_ZERO_BYTES = 128 * 1024;
constexpr size_t WS_TAB = 1 * MiB;
constexpr size_t SZ_WGU1 = (size_t)2 * FF * D * 2, SZ_WDN1 = (size_t)D * FF * 2;
constexpr size_t WS_WGU = 2 * MiB;
constexpr size_t WS_WDN = WS_WGU + al(8 * SZ_WGU1);
constexpr size_t WS_WHIN = WS_WDN + al(8 * SZ_WDN1);
constexpr size_t WS_WHOUT = WS_WHIN + al((size_t)2 * 8192 * D * 2);
constexpr size_t WS_WGIN = WS_WHOUT + al((size_t)2 * D * D * 2);
constexpr size_t WS_WGOUT = WS_WGIN + al((size_t)GL_NIN * D * 2);
constexpr size_t WS_WPOOL = WS_WGOUT + al((size_t)D * D * 2);
constexpr size_t WS_X = WS_WPOOL + al((size_t)D * 512 * 2);
constexpr size_t WS_XN = WS_X + al((size_t)M * D * 4);
constexpr size_t WS_H = WS_XN + al((size_t)M * D * 2);
constexpr size_t WS_Q = WS_H + al((size_t)M * FF * 2);
constexpr size_t WS_KK = WS_Q + al((size_t)M * D * 2);
constexpr size_t WS_V = WS_KK + al((size_t)M * D * 2);
constexpr size_t WS_G = WS_V + al((size_t)M * D * 2);
constexpr size_t WS_LF = WS_G + al((size_t)M * D * 2);
constexpr size_t WS_O = WS_LF + al((size_t)M * D * 4);
constexpr size_t WS_VT = WS_O + al((size_t)M * D * 4);
constexpr size_t WS_DL = WS_VT + al((size_t)M * D * 2);
constexpr size_t WS_PART = WS_DL + al((size_t)256 * D * 4);
constexpr size_t WS_OG = WS_PART + al((size_t)8 * MS * D * 4);
constexpr size_t WS_SS = WS_OG + al((size_t)M * D * 2);
constexpr size_t WS_SSO = WS_SS + al((size_t)M * 32 * 4);
constexpr size_t WS_R = WS_SSO + al((size_t)M * 32 * 4);
constexpr size_t WS_END = WS_R + al((size_t)M * 4);
constexpr size_t WS_QI = WS_H, WS_KDT = WS_QI + al((size_t)M * D * 2), WS_AM = WS_KDT + al((size_t)M * D * 2);
static_assert(WS_AM + (size_t)144 * 16 * 64 * 64 * 2 <= WS_Q, "scan overlay fits in H");

constexpr int CW_XRANK = 3072  , CW_BAR = 4096, CW_QUEUE = 8192, CW_GUFLAG = 16384  ;

constexpr int RING_BYTES = 131072, LDSCTL_OFF = RING_BYTES, MISC_OFF = LDSCTL_OFF + 320, LDS_BYTES = 147456;

__device__ __forceinline__ unsigned f2bf(float f) { unsigned u = __builtin_bit_cast(unsigned, f); return (u + 0x7fffu + ((u >> 16) & 1u)) >> 16; }
typedef _Float16 f16x2_t __attribute__((ext_vector_type(2)));
__device__ __forceinline__ unsigned pkh2(float lo, float hi) { f16x2_t h; h.x = (_Float16)lo; h.y = (_Float16)hi; return __builtin_bit_cast(unsigned, h); }
__device__ __forceinline__ float hlo(unsigned w) { return (float)__builtin_bit_cast(f16x2_t, w).x; }
__device__ __forceinline__ float hhi(unsigned w) { return (float)__builtin_bit_cast(f16x2_t, w).y; }
__device__ __forceinline__ unsigned pk2(float lo, float hi) { unsigned r; asm("v_cvt_pk_bf16_f32 %0, %1, %2" : "=v"(r) : "v"(lo), "v"(hi)); return r; }
__device__ __forceinline__ float bf2f(unsigned short b) { return __builtin_bit_cast(float, ((unsigned)b) << 16); }
__device__ __forceinline__ float bflo(unsigned w) { return __builtin_bit_cast(float, w << 16); }
__device__ __forceinline__ float bfhi(unsigned w) { return __builtin_bit_cast(float, w & 0xffff0000u); }
__device__ __forceinline__ void lds_barrier() { asm volatile("s_waitcnt lgkmcnt(0)" ::: "memory"); __builtin_amdgcn_s_barrier(); asm volatile("" ::: "memory"); }

__device__ __forceinline__ float wave_sum(float v) {
#pragma unroll
    for (int o = 1; o < 64; o <<= 1) v += __shfl_xor(v, o);
    return v;
}
__device__ __forceinline__ float fsigmoid(float x) { return __builtin_amdgcn_rcpf(1.f + __expf(-x)); }
__device__ __forceinline__ float fsilu(float x) { return x * fsigmoid(x); }
#define LDS_WAIT() asm volatile("s_waitcnt lgkmcnt(0)" ::: "memory")

#define XB_TMO      128
#define XB_XCNT(j)  (256  + 64 * (j))
#define XB_XSUB(j)  (1280 + 64 * (j))
#define XB_XGEN(j)  (2304 + 64 * (j))
#define XB_TOP      3328
#define XB_TOPGEN   3392
#define XCD_BAR_WORDS 3456
#define XB_SPIN_CAP (1u << 22)

__device__ __forceinline__ unsigned xb_ld(unsigned* p)              { return __hip_atomic_load(p, __ATOMIC_RELAXED, __HIP_MEMORY_SCOPE_AGENT); }
__device__ __forceinline__ unsigned xb_add(unsigned* p, unsigned v) { return __hip_atomic_fetch_add(p, v, __ATOMIC_RELAXED, __HIP_MEMORY_SCOPE_AGENT); }
__device__ __forceinline__ unsigned xb_xcc_id() { return (unsigned)__builtin_amdgcn_s_getreg((3 << 11) | 20) & 0xFu; }
#define XB_SPIN(cond, bar) do { unsigned _sp = 0; while (cond) { __builtin_amdgcn_s_sleep(1); \
    if ((++_sp & 255u) == 0u) { if (xb_ld(&(bar)[XB_TMO])) break; if (_sp > XB_SPIN_CAP) { atomicAdd(&(bar)[XB_TMO], 1u); break; } } } } while (0)

struct XcdBarrier { unsigned* bar; unsigned x; volatile LAS unsigned* st; };

__device__ __forceinline__ XcdBarrier xcd_barrier_post(unsigned* bar, volatile LAS unsigned* st) {
    XcdBarrier b; b.bar = bar; b.x = xb_xcc_id(); b.st = st;
    if (threadIdx.x == 0) (void)xb_add(&bar[XB_XCNT(b.x)], 1u);
    return b;
}
__device__ __forceinline__ void xcd_barrier_complete(unsigned* bar, unsigned x, unsigned& nloc, unsigned& nx) {
    const unsigned G = gridDim.x * gridDim.y * gridDim.z;
    unsigned sum, cnt, mine, sp = 0u;
    for (;;) {
        sum = 0u; cnt = 0u; mine = 0u;
#pragma unroll
        for (unsigned j = 0; j < 16; ++j) { const unsigned c = xb_ld(&bar[XB_XCNT(j)]); sum += c; cnt += (c > 0u) ? 1u : 0u; mine = (j == x) ? c : mine; }
        if (sum == G) break;
        __builtin_amdgcn_s_sleep(1);
        if ((++sp & 255u) == 0u) { if (xb_ld(&bar[XB_TMO])) break; if (sp > XB_SPIN_CAP) { atomicAdd(&bar[XB_TMO], 1u); break; } }
    }
    nloc = mine > 0u ? mine : 1u; nx = cnt > 0u ? cnt : 1u;
}
__device__ __forceinline__ void xcd_barrier(const XcdBarrier& b, const bool leader  ) {
    asm volatile("s_waitcnt vmcnt(0)" ::: "memory");
    __syncthreads();
    if (leader) {
        unsigned* bar = b.bar;
        __builtin_amdgcn_s_waitcnt(0);
        unsigned nloc = b.st[0], nx = b.st[1];
        if (nloc == 0u) { xcd_barrier_complete(bar, b.x, nloc, nx); b.st[0] = nloc; b.st[1] = nx; }
        const unsigned old = xb_add(&bar[XB_XSUB(b.x)], 1u);
        const unsigned gen = old / nloc;
        if (old + 1u == (gen + 1u) * nloc) {
            __builtin_amdgcn_fence(__ATOMIC_RELEASE, "agent");
            asm volatile("s_waitcnt vmcnt(0)" ::: "memory");
            const unsigned og = xb_add(&bar[XB_TOP], 1u);
            const unsigned tg = og / nx;
            if (og + 1u == (tg + 1u) * nx) xb_add(&bar[XB_TOPGEN], 1u);
            else XB_SPIN(xb_ld(&bar[XB_TOPGEN]) == tg, bar);
            __builtin_amdgcn_fence(__ATOMIC_ACQUIRE, "agent");
            xb_add(&bar[XB_XGEN(b.x)], 1u);
            asm volatile("s_waitcnt vmcnt(0)" ::: "memory");
        } else {
            XB_SPIN(xb_ld(&bar[XB_XGEN(b.x)]) == gen, bar);
            __builtin_amdgcn_fence(__ATOMIC_ACQUIRE, "agent");
            asm volatile("s_waitcnt vmcnt(0)" ::: "memory");
        }
    }
    __syncthreads();
}

namespace pg8 {
constexpr int BM = 256, BK = 64, HALF = 128, HTB = HALF * BK * 2, STAGE_BYTES = 8 * HTB, NXCD = 8, WGM = 8;
__host__ __device__ __forceinline__ int lds_byte(int r, int c) { const int st = (r >> 4) * 2 + (c >> 5), rr = r & 15, cc = c & 31, ob = rr * 64 + cc * 2; return st * 1024 + (ob ^ (((ob >> 9) & 1) << 5)); }
__host__ __device__ __forceinline__ void stage_rc(int b, int& R, int& C) { const int st = b / 1024, sb = b % 1024, swz = sb ^ (((sb >> 9) & 1) << 5); R = (st >> 1) * 16 + swz / 64; C = (st & 1) * 32 + (swz % 64) / 2; }
__host__ __device__ __forceinline__ int perm32(int rho) { const int n = rho >> 4, i = rho & 15; return 8 * (i >> 2) + 4 * n + (i & 3); }

struct Unit { int pm, pn, kt0, nt, split; };
struct Gemm { const bf16_t* A; const bf16_t* Bt; int lda, ldb, K, nM, nN, grp; };

struct StaticOrder {
    int nM, nN, nwg, G, c, ntk;
    __device__ void init(int nM_, int nN_, int G_, int c_, int ntk_) { nM = nM_; nN = nN_; nwg = nM * nN; G = G_; c = c_; ntk = ntk_; }
    __device__ bool next(int i, Unit& u) const {
        const long L = (long)i * G + c; if (L >= nwg) return false;
        int wgid = (int)L; { const int q = nwg / NXCD, r = nwg % NXCD, xcd = wgid % NXCD, off = wgid / NXCD; wgid = (xcd < r ? xcd * (q + 1) : r * (q + 1) + (xcd - r) * q) + off; }
        const int nig = WGM * nN, gid = wgid / nig, fm = gid * WGM, gsz = (nM - fm) < WGM ? (nM - fm) : WGM;
        u.pm = fm + ((wgid % nig) % gsz); u.pn = (wgid % nig) / gsz; u.kt0 = 0; u.nt = ntk; u.split = -1; return true;
    }
};
template <int NM, int NN, int NTK, int NG> struct TailSplitOrder {
    static constexpr int nwg = NM * NN, nfull = (2 * (nwg % NG) > NG || (NTK & 3)) ? nwg : (nwg / NG) * NG, ntail = nwg - nfull;
    int c;
    __device__ void init(int c_) { c = c_; }
    __device__ bool next(int i, Unit& u) const {
        int L = i * NG + c; u.kt0 = 0; u.nt = NTK; u.split = -1;
        if (i * NG >= nfull) {
            if (ntail == 0) { if (L >= nwg) return false; }
            else { if (i * NG > nfull || c >= 2 * ntail) return false;
                   const int part = c >= ntail ? 1 : 0, tc = c - part * ntail; L = nfull + tc; constexpr int n0 = (NTK * 7 / 16) & ~1;
                   u.kt0 = part * n0; u.nt = part ? NTK - n0 : n0; u.split = part + 2 * tc; }
        }
        int wgid = L; { constexpr int q = nwg / NXCD, r = nwg % NXCD; const int xcd = wgid % NXCD, off = wgid / NXCD; wgid = (xcd < r ? xcd * (q + 1) : r * (q + 1) + (xcd - r) * q) + off; }
        constexpr int nig = WGM * NN; const int gid = wgid / nig, fm = gid * WGM, gsz = (NM - fm) < WGM ? (NM - fm) : WGM;
        u.pm = fm + ((wgid % nig) % gsz); u.pn = (wgid % nig) / gsz; return true;
    }
};
struct ResOrder {
    int c, ntk, nsplit;
    __device__ void init(int c_, int ntk_) { c = c_; ntk = ntk_; nsplit = ntk_ >= 16 ? 8 : ntk_ / 2; }
    __device__ bool next(int i, Unit& u) const {
        const int x = c & 7, r = c >> 3;
        if (i == 0) { u.pm = 4 * x + (r >> 3); u.pn = r & 7; u.kt0 = 0; u.nt = ntk; u.split = -1; return true; }
        if (i == 1 && x < nsplit) { const int pairs = ntk >> 1, p0 = x * pairs / nsplit, p1 = (x + 1) * pairs / nsplit;
            u.pm = 32 + (r >> 3); u.pn = r & 7; u.kt0 = 2 * p0; u.nt = 2 * (p1 - p0); u.split = x; return true; }
        return false;
    }
};

template <class Epi, class Sched>
__device__ __forceinline__ void gemm_phase(LAS unsigned char* lds, const Gemm g, const Sched& S, const Epi& E, const int tid) {
    const int wid = __builtin_amdgcn_readfirstlane(tid >> 6), lane = tid & 63, wr = wid >> 2, wc = wid & 3, fr = lane & 15, fq = lane >> 4;
    const int K = g.K;
    unsigned voffA[2], voffB[2];
#pragma unroll
    for (int i = 0; i < 2; ++i) { int R, C; stage_rc(tid * 16 + i * 8192, R, C); const int Rb = (R & ~31) + perm32(R & 31);
        voffA[i] = (unsigned)(R * g.lda + C) * 2u; voffB[i] = (unsigned)(Rb * g.ldb + C) * 2u; }
    const size_t kstep = (size_t)(BK * 2);
    const size_t hstepA = (size_t)HALF * g.lda * 2, hstepB = (size_t)HALF * g.ldb * 2;
    const size_t tstepA = 2 * hstepA, tstepB = 2 * hstepB;
    const unsigned ldsw = (unsigned)wid * 1024u;
    const int aoff = lds_byte(wr * 64 + fr, fq * 8), boff = lds_byte(wc * 32 + fr, fq * 8);
#define PG8_SA(b, h) (((b) * 2 + (h)) * HTB)
#define PG8_SB(b, h) ((4 + (b) * 2 + (h)) * HTB)
#define PG8_STAGE(bufoff, gbase, voff) do { _Pragma("unroll") for (int _i = 0; _i < 2; ++_i) \
        __builtin_amdgcn_global_load_lds((const unsigned*)((const char*)(gbase) + (voff)[_i]), (LAS unsigned*)(lds + (bufoff) + ldsw + _i * 8192), 16, 0, 0); } while (0)
#define PG8_LDA(dst, b, h) do { _Pragma("unroll") for (int m = 0; m < 4; ++m) _Pragma("unroll") for (int k = 0; k < 2; ++k) dst[m][k] = *(const LAS bf16x8*)(lds + PG8_SA(b, h) + aoff + m * 2048 + k * 1024); } while (0)
#define PG8_LDB(dst, b, h) do { _Pragma("unroll") for (int n = 0; n < 2; ++n) _Pragma("unroll") for (int k = 0; k < 2; ++k) dst[n][k] = *(const LAS bf16x8*)(lds + PG8_SB(b, h) + boff + n * 2048 + k * 1024); } while (0)
#define PG8_MMA(ai, bj, At, Bt) do { __builtin_amdgcn_s_setprio(1); _Pragma("unroll") for (int m = 0; m < 4; ++m) _Pragma("unroll") for (int n = 0; n < 2; ++n) _Pragma("unroll") for (int k = 0; k < 2; ++k) \
        acc[ai][bj][m][n] = __builtin_amdgcn_mfma_f32_16x16x32_bf16(Bt[n][k], At[m][k], acc[ai][bj][m][n], 0, 0, 0); __builtin_amdgcn_s_setprio(0); } while (0)
#define PG8_WAIT_V(n) asm volatile("s_waitcnt vmcnt(" #n ")" ::: "memory")
#define PG8_WAIT_L(n) asm volatile("s_waitcnt lgkmcnt(" #n ")" ::: "memory")
#define PG8_BAR __builtin_amdgcn_s_barrier()
#define PG8_SCHED __builtin_amdgcn_sched_barrier(0)
#define PG8_ABASE(u) ((const char*)g.A + (size_t)(u).pm * tstepA + (g.grp ? (size_t)((u).pn >> 1) * (size_t)K * 2 : (size_t)0) + (size_t)(u).kt0 * kstep)
#define PG8_BBASE(u) ((const char*)g.Bt + (size_t)(u).pn * tstepB + (size_t)(u).kt0 * kstep)
    Unit cur, nxt; int ui = 0;
    if (!S.next(0, cur)) return;
    f32x4 acc[2][2][4][2];
#pragma unroll
    for (int a = 0; a < 2; ++a)
#pragma unroll
        for (int b = 0; b < 2; ++b)
#pragma unroll
            for (int m = 0; m < 4; ++m)
#pragma unroll
                for (int n = 0; n < 2; ++n) acc[a][b][m][n] = (f32x4){0.f, 0.f, 0.f, 0.f};
    bf16x8 At[4][2], B0[2][2], B1[2][2];
    const char* cA = PG8_ABASE(cur); const char* cB = PG8_BBASE(cur);
    PG8_STAGE(PG8_SB(0, 0), cB, voffB); PG8_STAGE(PG8_SB(0, 1), cB + hstepB, voffB); PG8_STAGE(PG8_SA(0, 0), cA, voffA); PG8_STAGE(PG8_SA(0, 1), cA + hstepA, voffA);
    if (wr == 1) PG8_BAR;
    PG8_WAIT_V(2); PG8_BAR;
    PG8_STAGE(PG8_SB(1, 0), cB + kstep, voffB); PG8_STAGE(PG8_SA(1, 0), cA + kstep, voffA); PG8_STAGE(PG8_SB(1, 1), cB + hstepB + kstep, voffB);
    PG8_WAIT_V(6); PG8_BAR;
    for (;;) {
        const bool has_next = S.next(ui + 1, nxt);
        const char* nA = has_next ? PG8_ABASE(nxt) : cA; const char* nB = has_next ? PG8_BBASE(nxt) : cB;
        const int nt = cur.nt;
        E.prefetch(cur, tid, lds, ui & 1);
        for (int t = 0; t < nt; t += 2) {
            const bool last = (t == nt - 2);
            const char* a1 = cA + (size_t)(t + 1) * kstep;
            const char* a2 = last ? nA : cA + (size_t)(t + 2) * kstep; const char* b2 = last ? nB : cB + (size_t)(t + 2) * kstep;
            const char* a3 = a2 + kstep; const char* b3 = b2 + kstep;
            PG8_LDB(B0, 0, 0); PG8_LDB(B1, 0, 1); PG8_SCHED; PG8_LDA(At, 0, 0); PG8_STAGE(PG8_SA(1, 1), a1 + hstepA, voffA);
            PG8_WAIT_V(8); PG8_WAIT_L(0); PG8_BAR; PG8_MMA(0, 0, At, B0); PG8_MMA(0, 1, At, B1); PG8_BAR; PG8_SCHED;
            PG8_LDA(At, 0, 1); PG8_STAGE(PG8_SB(0, 0), b2, voffB); PG8_STAGE(PG8_SB(0, 1), b2 + hstepB, voffB); PG8_STAGE(PG8_SA(0, 0), a2, voffA);
            PG8_WAIT_V(8); PG8_WAIT_L(0); PG8_BAR; PG8_MMA(1, 0, At, B0); PG8_MMA(1, 1, At, B1); PG8_BAR; PG8_SCHED;
            PG8_LDB(B0, 1, 0); PG8_LDB(B1, 1, 1); PG8_SCHED; PG8_LDA(At, 1, 0); PG8_STAGE(PG8_SA(0, 1), a2 + hstepA, voffA);
            PG8_WAIT_V(8); PG8_WAIT_L(0); PG8_BAR; PG8_MMA(0, 0, At, B0); PG8_MMA(0, 1, At, B1); PG8_BAR; PG8_SCHED;
            PG8_LDA(At, 1, 1); PG8_STAGE(PG8_SB(1, 0), b3, voffB); PG8_STAGE(PG8_SB(1, 1), b3 + hstepB, voffB); PG8_STAGE(PG8_SA(1, 0), a3, voffA);
            PG8_WAIT_V(8); PG8_WAIT_L(0); PG8_BAR; PG8_MMA(1, 0, At, B0); PG8_MMA(1, 1, At, B1); PG8_BAR; PG8_SCHED;
        }
        if (wr == 0) PG8_BAR;
        E.combine(acc, cur, tid);
        E(acc, cur, wr, wc, fr, fq, lds, tid, ui & 1);
        if (!has_next) break;
#pragma unroll
        for (int a = 0; a < 2; ++a)
#pragma unroll
            for (int b = 0; b < 2; ++b)
#pragma unroll
                for (int m = 0; m < 4; ++m)
#pragma unroll
                    for (int n = 0; n < 2; ++n) acc[a][b][m][n] = (f32x4){0.f, 0.f, 0.f, 0.f};
        cur = nxt; cA = nA; cB = nB; ++ui;
        if (wr == 1) PG8_BAR;
    }
    PG8_WAIT_V(0);
    PG8_BAR;
#undef PG8_SA
#undef PG8_SB
#undef PG8_STAGE
#undef PG8_LDA
#undef PG8_LDB
#undef PG8_MMA
#undef PG8_WAIT_V
#undef PG8_WAIT_L
#undef PG8_BAR
#undef PG8_SCHED
#undef PG8_ABASE
#undef PG8_BBASE
}
}

__device__ __forceinline__ unsigned cvt_pk_bf16(float lo, float hi) { unsigned r; asm volatile("v_cvt_pk_bf16_f32 %0, %1, %2" : "=v"(r) : "v"(lo), "v"(hi)); return r; }
typedef f32x4 AccT[2][2][4][2];

template <int NP> __device__ __forceinline__ float row_scale(const float* P, int row, int fq) {
    const float* p = P + (size_t)row * NP + fq * (NP / 4); float s;
    if (NP == 32) { const f32x4 a = *(const f32x4*)p, b2 = *(const f32x4*)(p + 4); s = ((a.x + a.y) + (a.z + a.w)) + ((b2.x + b2.y) + (b2.z + b2.w)); }
    else { const f32x4 a = *(const f32x4*)p; s = (a.x + a.y) + (a.z + a.w); }
    s += __shfl_xor(s, 16); s += __shfl_xor(s, 32);
    return __builtin_amdgcn_rsqf(s * (1.f / D) + EPS);
}
constexpr int RSC_OFF = LDSCTL_OFF + 2048;
__device__ __forceinline__ void rs_dma(const float* R, int pm, int tid, LAS unsigned char* lds, int par) {
    const int wid = __builtin_amdgcn_readfirstlane(tid >> 6);
    if (wid < 4) {
        const float* gsrc = R + pm * 256 + wid * 64 + (tid & 63); const unsigned dst = (unsigned)__builtin_amdgcn_readfirstlane((int)(RSC_OFF + par * 1024 + wid * 256)); unsigned keep;
        asm volatile("s_mov_b32 %0, m0\n\ts_mov_b32 m0, %2\n\ts_nop 0\n\tglobal_load_lds_dword %1, off\n\ts_mov_b32 m0, %0" : "=&s"(keep) : "v"(gsrc), "s"(dst) : "memory");
    }
}
__device__ __forceinline__ void rs_read8(LAS unsigned char* lds, int wr, int fr, float (&r)[2][4], int par) {
    const LAS float* T = (const LAS float*)(lds + RSC_OFF + par * 1024);
#pragma unroll
    for (int ai = 0; ai < 2; ++ai)
#pragma unroll
        for (int m = 0; m < 4; ++m) r[ai][m] = T[ai * 128 + wr * 64 + m * 16 + fr];
}
template <int NP> __device__ __forceinline__ void row_scales8_direct(const float* P, int pm, int tid, LAS unsigned char* lds, int wr, int fr, float (&r)[2][4]) {
    LAS float* T = (LAS float*)(lds + RSC_OFF);
    { const float* p = P + (size_t)(pm * 256 + (tid >> 1)) * NP + (tid & 1) * (NP / 2); float s;
      if (NP == 32) { const f32x4 a = *(const f32x4*)p, b2 = *(const f32x4*)(p + 4), c = *(const f32x4*)(p + 8), d = *(const f32x4*)(p + 12);
          s = (((a.x + a.y) + (a.z + a.w)) + ((b2.x + b2.y) + (b2.z + b2.w))) + (((c.x + c.y) + (c.z + c.w)) + ((d.x + d.y) + (d.z + d.w))); }
      else { const f32x4 a = *(const f32x4*)p, b2 = *(const f32x4*)(p + 4); s = ((a.x + a.y) + (a.z + a.w)) + ((b2.x + b2.y) + (b2.z + b2.w)); }
      s += __shfl_xor(s, 1);
      if (!(tid & 1)) T[tid >> 1] = __builtin_amdgcn_rsqf(s * (1.f / D) + EPS); }
    asm volatile("s_waitcnt lgkmcnt(0)" ::: "memory"); __builtin_amdgcn_s_barrier(); asm volatile("" ::: "memory");
    rs_read8(lds, wr, fr, r, 0);
}
struct EpiGU {
    bf16_t* H; const float* SS; float* SLAB; unsigned* flags;
    __device__ __forceinline__ void prefetch(const pg8::Unit& u, int tid, LAS unsigned char* lds, int par) const { rs_dma(SS, u.pm, tid, lds, par); }
    __device__ __forceinline__ void combine(AccT& a, const pg8::Unit& u, int tid) const {
        if (u.split < 0 || !(u.split & 1)) return;
        unsigned* fl = flags + (u.split >> 1);
        if (tid == 0) { while (xb_ld(fl) == 0u) __builtin_amdgcn_s_sleep(1);
            __builtin_amdgcn_fence(__ATOMIC_ACQUIRE, "agent"); asm volatile("s_waitcnt vmcnt(0)" ::: "memory"); }
        __syncthreads();
        const u32x4* slab = (const u32x4*)SLAB + (size_t)(u.split >> 1) * (16 * 512); const unsigned ut = (unsigned)tid;
        u32x4 t[16];
#pragma unroll
        for (int i = 0; i < 16; ++i) t[i] = (slab + i * 512)[ut];
#pragma unroll
        for (int i = 0; i < 16; ++i) {
            f32x4& a0 = a[i >> 3][(i >> 2) & 1][i & 3][0]; f32x4& a1 = a[i >> 3][(i >> 2) & 1][i & 3][1];
            a0 = a0 + (f32x4){bflo(t[i].x), bfhi(t[i].x), bflo(t[i].y), bfhi(t[i].y)};
            a1 = a1 + (f32x4){bflo(t[i].z), bfhi(t[i].z), bflo(t[i].w), bfhi(t[i].w)};
        }
    }
    __device__ __forceinline__ void operator()(const AccT& acc, const pg8::Unit& u, int wr, int wc, int fr, int fq, LAS unsigned char* lds, int tid, int par) const {
        const int row0 = u.pm * 256 + wr * 64 + fr, col0 = u.pn * 128 + wc * 32 + 8 * fq;
        const bool tail = u.split >= 0;
        const unsigned ut = (unsigned)tid;
        if (tail) {
            unsigned* fl = flags + (u.split >> 1);
            if (!(u.split & 1)) {
                u32x4* sw = (u32x4*)SLAB + (size_t)(u.split >> 1) * (16 * 512);
#pragma unroll
                for (int ai = 0; ai < 2; ++ai)
#pragma unroll
                    for (int bj = 0; bj < 2; ++bj)
#pragma unroll
                        for (int m = 0; m < 4; ++m) { const f32x4 p0 = acc[ai][bj][m][0], p1 = acc[ai][bj][m][1];
                            u32x4 w; w.x = cvt_pk_bf16(p0.x, p0.y); w.y = cvt_pk_bf16(p0.z, p0.w); w.z = cvt_pk_bf16(p1.x, p1.y); w.w = cvt_pk_bf16(p1.z, p1.w);
                            (sw + ((ai * 2 + bj) * 4 + m) * 512)[ut] = w; }
                __syncthreads();
                if (tid == 0) { __builtin_amdgcn_fence(__ATOMIC_RELEASE, "agent"); asm volatile("s_waitcnt vmcnt(0)" ::: "memory"); (void)xb_add(fl, 1u); }
                return;
            }
        }
        float rs8[2][4]; rs_read8(lds, wr, fr, rs8, par);
#pragma unroll
        for (int ai = 0; ai < 2; ++ai)
#pragma unroll
            for (int m = 0; m < 4; ++m) {
                const int row = row0 + ai * 128 + m * 16;
                const float r = rs8[ai][m];
                bf16_t* rowp = H + (size_t)row * FF + col0;
                float hv[8];
#pragma unroll
                for (int n = 0; n < 2; ++n)
#pragma unroll
                    for (int j = 0; j < 4; ++j) { const float gv = acc[ai][0][m][n][j] * r, uv = acc[ai][1][m][n][j] * r; hv[n * 4 + j] = fsilu(gv) * uv; }
                u32x4 w; w.x = cvt_pk_bf16(hv[0], hv[1]); w.y = cvt_pk_bf16(hv[2], hv[3]); w.z = cvt_pk_bf16(hv[4], hv[5]); w.w = cvt_pk_bf16(hv[6], hv[7]);
                *(u32x4*)rowp = w;
            }
    }
};
template <int NP, int HALF> struct EpiRes {
    float* X; bf16_t* XB; float* SS; const float* colscale; const float* RP; float* PART;
    __device__ __forceinline__ void prefetch(const pg8::Unit&, int, LAS unsigned char*, int) const {}
    __device__ __forceinline__ void combine(AccT&, const pg8::Unit&, int) const {}
    __device__ __forceinline__ void operator()(const AccT& acc, const pg8::Unit& u, int wr, int wc, int fr, int fq, LAS unsigned char* lds, int tid, int par) const {
        const int row0 = u.pm * 256 + wr * 64 + fr, col0 = u.pn * 256 + wc * 32 + 8 * fq;
        if (u.split >= 0) {
#pragma unroll
            for (int ai = 0; ai < 2; ++ai)
#pragma unroll
                for (int m = 0; m < 4; ++m) {
                    bf16_t* rowp = (bf16_t*)PART + ((size_t)u.split * MS + (size_t)(row0 + ai * 128 + m * 16 - MP)) * D + col0;
#pragma unroll
                    for (int bj = 0; bj < 2; ++bj) { const f32x4 p0 = acc[ai][bj][m][0], p1 = acc[ai][bj][m][1];
                        u32x4 w; w.x = cvt_pk_bf16(p0.x, p0.y); w.y = cvt_pk_bf16(p0.z, p0.w); w.z = cvt_pk_bf16(p1.x, p1.y); w.w = cvt_pk_bf16(p1.z, p1.w);
                        *(u32x4*)(rowp + bj * 128) = w; }
                }
            return;
        }
        f32x4 cs[2][2];
#pragma unroll
        for (int bj = 0; bj < 2; ++bj)
#pragma unroll
            for (int n = 0; n < 2; ++n) { cs[bj][n] = colscale ? *(const f32x4*)(colscale + col0 + bj * 128 + 4 * n) : (f32x4){1.f, 1.f, 1.f, 1.f}; if (HALF) cs[bj][n] = cs[bj][n] * 0.5f; }
        float rs8[2][4];
        if (NP > 0) row_scales8_direct<NP == 0 ? 16 : NP>(RP, u.pm, tid, lds, wr, fr, rs8);
        constexpr bool PIPE = (NP == 0 && HALF == 1);
        f32x4 xo[PIPE ? 2 : 1][2][2][2];
#define RES_LD(buf, q_) do { _Pragma("unroll") for (int mm = 0; mm < 2; ++mm) _Pragma("unroll") for (int bj = 0; bj < 2; ++bj) _Pragma("unroll") for (int n = 0; n < 2; ++n) \
            xo[buf][mm][bj][n] = *(const f32x4*)(X + (size_t)(row0 + ((q_) >> 1) * 128 + (2 * ((q_) & 1) + mm) * 16) * D + col0 + bj * 128 + 4 * n); } while (0)
        if (PIPE) RES_LD(0, 0);
#pragma unroll
        for (int q = 0; q < 4; ++q) {
            const int ai = q >> 1, mp = q & 1;
            if (PIPE) { if (q + 1 < 4) RES_LD((q + 1) & 1, q + 1); } else RES_LD(0, q);
            __builtin_amdgcn_sched_barrier(0);
#pragma unroll
            for (int mm = 0; mm < 2; ++mm) {
                const int m = 2 * mp + mm, row = row0 + ai * 128 + m * 16;
                const float r = NP > 0 ? rs8[ai][m] : 1.f;
                float* rowp = X + (size_t)row * D + col0; bf16_t* rowb = XB + (size_t)row * D + col0;
                float ss = 0.f;
#pragma unroll
                for (int bj = 0; bj < 2; ++bj) {
                    const f32x4 x0 = xo[PIPE ? (q & 1) : 0][mm][bj][0] + cs[bj][0] * (acc[ai][bj][m][0] * r), x1 = xo[PIPE ? (q & 1) : 0][mm][bj][1] + cs[bj][1] * (acc[ai][bj][m][1] * r);
                    *(f32x4*)(rowp + bj * 128) = x0; *(f32x4*)(rowp + bj * 128 + 4) = x1;
                    ss += ((x0.x * x0.x + x0.y * x0.y) + (x0.z * x0.z + x0.w * x0.w)) + ((x1.x * x1.x + x1.y * x1.y) + (x1.z * x1.z + x1.w * x1.w));
                    u32x4 w; w.x = cvt_pk_bf16(x0.x, x0.y); w.y = cvt_pk_bf16(x0.z, x0.w); w.z = cvt_pk_bf16(x1.x, x1.y); w.w = cvt_pk_bf16(x1.z, x1.w);
                    *(u32x4*)(rowb + bj * 128) = w;
                }
                ss += __shfl_xor(ss, 16); ss += __shfl_xor(ss, 32);
                if (fq == 0) SS[(size_t)row * 32 + u.pn * 4 + wc] = ss;
            }
            __builtin_amdgcn_sched_barrier(0);
        }
#undef RES_LD
    }
};
struct EpiHG {
    bf16_t *Q, *KK, *V, *G; float* LF; const float* lb; const float* SS;
    __device__ __forceinline__ void prefetch(const pg8::Unit&, int, LAS unsigned char*, int) const {}
    __device__ __forceinline__ void combine(AccT&, const pg8::Unit&, int) const {}
    __device__ __forceinline__ void operator()(const AccT& acc, const pg8::Unit& u, int wr, int wc, int fr, int fq, LAS unsigned char* lds, int tid, int par) const {
        const int row0 = u.pm * 256 + wr * 64 + fr, reg = u.pn >> 3, col0 = (u.pn & 7) * 256 + wc * 32 + 8 * fq;
        float lbv[2][8];
#pragma unroll
        for (int bj = 0; bj < 2; ++bj)
#pragma unroll
            for (int j = 0; j < 8; ++j) lbv[bj][j] = (reg == 1) ? lb[col0 + bj * 128 + j] : 0.f;
        float rs8[2][4]; row_scales8_direct<32>(SS, u.pm, tid, lds, wr, fr, rs8);
#pragma unroll
        for (int ai = 0; ai < 2; ++ai)
#pragma unroll
            for (int m = 0; m < 4; ++m) {
                const size_t ro = (size_t)(row0 + ai * 128 + m * 16) * D + col0;
                const float rsc = rs8[ai][m];
#pragma unroll
                for (int bj = 0; bj < 2; ++bj) {
                    float a[8], o[8];
#pragma unroll
                    for (int n = 0; n < 2; ++n)
#pragma unroll
                        for (int j = 0; j < 4; ++j) a[n * 4 + j] = acc[ai][bj][m][n][j] * rsc;
                    bf16_t* dst;
                    if (reg == 0) { dst = Q;
#pragma unroll
                        for (int j = 0; j < 8; ++j) o[j] = fsilu(a[j]) * 0.08838834764831845f;
                    } else if (reg == 1) { dst = KK; float lf[8];
#pragma unroll
                        for (int j = 0; j < 8; ++j) { const float f = fminf(fmaxf(a[j], -80.f), 80.f), e = __expf(-f), sig = __builtin_amdgcn_rcpf(1.f + e), l = lbv[bj][j];
                            lf[j] = __logf(l + (1.f - l) * sig); o[j] = (1.f - l) * e * sig; }
                        u32x4 lw; lw.x = pkh2(lf[0], lf[1]); lw.y = pkh2(lf[2], lf[3]); lw.z = pkh2(lf[4], lf[5]); lw.w = pkh2(lf[6], lf[7]);
                        *(u32x4*)((unsigned short*)LF + ro + bj * 128) = lw;
                    } else if (reg == 2) { dst = V;
#pragma unroll
                        for (int j = 0; j < 8; ++j) o[j] = a[j];
                    } else { dst = G;
#pragma unroll
                        for (int j = 0; j < 8; ++j) o[j] = fsilu(a[j]);
                    }
                    u32x4 w; w.x = cvt_pk_bf16(o[0], o[1]); w.y = cvt_pk_bf16(o[2], o[3]); w.z = cvt_pk_bf16(o[4], o[5]); w.w = cvt_pk_bf16(o[6], o[7]);
                    *(u32x4*)(dst + ro + bj * 128) = w;
                }
            }
    }
};
struct EpiGLA {
    bf16_t *Q, *KK, *V, *G; float* LF; const float* bgate; const float* SS;
    __device__ __forceinline__ void prefetch(const pg8::Unit&, int, LAS unsigned char*, int) const {}
    __device__ __forceinline__ void combine(AccT&, const pg8::Unit&, int) const {}
    __device__ __forceinline__ void operator()(const AccT& acc, const pg8::Unit& u, int wr, int wc, int fr, int fq, LAS unsigned char* lds, int tid, int par) const {
        const int pn = u.pn; int reg, cbase;
        if (pn < 4) { reg = 0; cbase = pn * 256; } else if (pn < 8) { reg = 1; cbase = (pn - 4) * 256; } else if (pn < 16) { reg = 2; cbase = (pn - 8) * 256; }
        else if (pn < 24) { reg = 3; cbase = (pn - 16) * 256; } else { reg = 4; cbase = (pn - 24) * 256; }
        const int row0 = u.pm * 256 + wr * 64 + fr, col0 = cbase + wc * 32 + 8 * fq;
        float bg[2][8];
#pragma unroll
        for (int bj = 0; bj < 2; ++bj)
#pragma unroll
            for (int j = 0; j < 8; ++j) bg[bj][j] = (reg == 4) ? bgate[col0 + bj * 128 + j] : 0.f;
        float rs8[2][4]; row_scales8_direct<32>(SS, u.pm, tid, lds, wr, fr, rs8);
#pragma unroll
        for (int ai = 0; ai < 2; ++ai)
#pragma unroll
            for (int m = 0; m < 4; ++m) {
                const size_t ro = (size_t)(row0 + ai * 128 + m * 16) * D + col0;
                const float rsc = rs8[ai][m];
#pragma unroll
                for (int bj = 0; bj < 2; ++bj) {
                    float a[8], o[8];
#pragma unroll
                    for (int n = 0; n < 2; ++n)
#pragma unroll
                        for (int j = 0; j < 4; ++j) a[n * 4 + j] = acc[ai][bj][m][n][j] * rsc;
                    if (reg == 4) {
                        float lf[8];
#pragma unroll
                        for (int j = 0; j < 8; ++j) { const float z = a[j] + bg[bj][j]; lf[j] = (fminf(z, 0.f) - __logf(1.f + __expf(-fabsf(z)))) * 0.0625f; }
                        u32x4 lw; lw.x = pkh2(lf[0], lf[1]); lw.y = pkh2(lf[2], lf[3]); lw.z = pkh2(lf[4], lf[5]); lw.w = pkh2(lf[6], lf[7]);
                        *(u32x4*)((unsigned short*)LF + ro + bj * 128) = lw;
                    } else {
                        bf16_t* dst;
                        if (reg == 0) { dst = Q;
#pragma unroll
                            for (int j = 0; j < 8; ++j) o[j] = a[j] * 0.0625f;
                        } else if (reg == 1) { dst = KK;
#pragma unroll
                            for (int j = 0; j < 8; ++j) o[j] = a[j];
                        } else if (reg == 2) { dst = V;
#pragma unroll
                            for (int j = 0; j < 8; ++j) o[j] = a[j];
                        } else { dst = G;
#pragma unroll
                            for (int j = 0; j < 8; ++j) o[j] = fsilu(a[j]);
                        }
                        u32x4 w; w.x = cvt_pk_bf16(o[0], o[1]); w.y = cvt_pk_bf16(o[2], o[3]); w.z = cvt_pk_bf16(o[4], o[5]); w.w = cvt_pk_bf16(o[6], o[7]);
                        *(u32x4*)(dst + ro + bj * 128) = w;
                    }
                }
            }
    }
};

struct Params { const float* in[26]; float* out; unsigned char* ws; int ph_lo, ph_hi; };
typedef const Params __attribute__((address_space(4))) CParams;
enum { I_XP = 0, I_XS, I_SHG, I_SGLA, I_SPOOL, I_NF1, I_F1G, I_F1U, I_F1D, I_NMIX, I_NF2, I_F2G, I_F2U, I_F2D, I_LBL, I_HWIN, I_HON, I_HWOUT, I_GWIN, I_GWGU, I_GBG, I_GON, I_GWOUT, I_PWG, I_PSC, I_FN };

template <class Src>
__device__ __forceinline__ void transpose_item(const Src& src, int K, bf16_t* WT, int dst_row0, int k0, int n0, LAS float* scr, int lane, const float* gain) {
    const int c = lane & 7;
    f32x4 g0 = (f32x4){1.f, 1.f, 1.f, 1.f}, g1 = g0;
    if (gain) { g0 = *(const f32x4*)(gain + k0 + 8 * c); g1 = *(const f32x4*)(gain + k0 + 8 * c + 4); }
    float wv[32];
#pragma unroll
    for (int i = 0; i < 32; ++i) wv[i] = src(k0 + 2 * i + (lane >> 5), n0 + (lane & 31));
#pragma unroll
    for (int i = 0; i < 32; ++i) scr[(2 * i + (lane >> 5)) * 33 + (lane & 31)] = wv[i];
    LDS_WAIT(); asm volatile("" ::: "memory");
#pragma unroll
    for (int j = 0; j < 4; ++j) { const int n = (lane >> 3) + 8 * j; const LAS float* s = scr + (8 * c) * 33 + n;
        u32x4 o; o.x = pk2(s[0 * 33] * g0.x, s[1 * 33] * g0.y); o.y = pk2(s[2 * 33] * g0.z, s[3 * 33] * g0.w); o.z = pk2(s[4 * 33] * g1.x, s[5 * 33] * g1.y); o.w = pk2(s[6 * 33] * g1.z, s[7 * 33] * g1.w);
        *(u32x4*)(WT + (size_t)(dst_row0 + n) * K + k0 + 8 * c) = o; }
    LDS_WAIT(); asm volatile("" ::: "memory");
}
struct SrcPlain { const float* W; int ld; __device__ __forceinline__ float operator()(int k, int n) const { return __builtin_nontemporal_load(W + (size_t)k * ld + n); } };
struct SrcGlaGate { const float* win; const float* wgu;
    __device__ __forceinline__ float operator()(int k, int n) const { float s = 0.f;
#pragma unroll
        for (int r = 0; r < 16; ++r) s += win[(size_t)k * GL_WIN_LD + 6144 + r] * wgu[r * GL_DK + n];
        return s; } };

__device__ __forceinline__ void prologue_phase(CParams* P, LAS unsigned char* lds, int gw, int NGW, int wave, int lane) {
    unsigned char* ws = P->ws;
    LAS float* scr = (LAS float*)(lds + wave * 16384);
    constexpr int IT_FFN = (D / 64) * (FF / 32);
    constexpr int IT_HIN = (D / 64) * (8192 / 32), IT_DD = (D / 64) * (D / 32), IT_GIN = (D / 64) * (6144 / 32), IT_GG = (D / 64) * (GL_DK / 32), IT_PL = (512 / 64) * (512 / 32);
    constexpr int N_FFN = 24 * IT_FFN, N_H = 2 * IT_HIN + 2 * IT_DD, N_G = IT_GIN + IT_GG + IT_DD, N_P = 4 * IT_PL;
    constexpr int NITEMS = N_FFN + N_H + N_G + N_P;
    for (int it = gw; it < NITEMS; it += NGW) {
        int r = it;
        if (r < N_FFN) {
            const int mat = r / IT_FFN, item = r % IT_FFN, s = mat / 3, kind = mat % 3, li = s >> 1, which = s & 1;
            if (kind < 2) {
                const float* W = P->in[(which ? I_F2G : I_F1G) + kind] + (size_t)li * D * FF;
                const int nblk = FF / 32, kb = item / nblk, nb = item % nblk, n0 = nb * 32;
                SrcPlain src{W, FF};
                transpose_item(src, D, (bf16_t*)(ws + WS_WGU + (size_t)s * SZ_WGU1), (n0 >> 7) * 256 + (n0 & 127) + kind * 128, kb * 64, n0, scr, lane, P->in[which ? I_NF2 : I_NF1] + (size_t)li * D);
            } else {
                const float* W = P->in[which ? I_F2D : I_F1D] + (size_t)li * FF * D;
                const int nblk = D / 32, kb = item / nblk, nb = item % nblk;
                SrcPlain src{W, D};
                transpose_item(src, FF, (bf16_t*)(ws + WS_WDN + (size_t)s * SZ_WDN1), nb * 32, kb * 64, nb * 32, scr, lane, nullptr);
            }
            continue;
        }
        r -= N_FFN;
        if (r < N_H) {
            if (r < 2 * IT_HIN) { const int j = r / IT_HIN, item = r % IT_HIN, nblk = 8192 / 32, kb = item / nblk, nb = item % nblk;
                SrcPlain src{P->in[I_HWIN] + (size_t)j * D * 8192, 8192};
                transpose_item(src, D, (bf16_t*)(ws + WS_WHIN) + (size_t)j * 8192 * D, nb * 32, kb * 64, nb * 32, scr, lane, P->in[I_NMIX] + (size_t)(3 * j) * D);
            } else { r -= 2 * IT_HIN; const int j = r / IT_DD, item = r % IT_DD, nblk = D / 32, kb = item / nblk, nb = item % nblk;
                SrcPlain src{P->in[I_HWOUT] + (size_t)j * D * D, D};
                transpose_item(src, D, (bf16_t*)(ws + WS_WHOUT) + (size_t)j * D * D, nb * 32, kb * 64, nb * 32, scr, lane, P->in[I_HON] + (size_t)j * D);
            }
            continue;
        }
        r -= N_H;
        if (r < N_G) {
            if (r < IT_GIN) { const int nblk = 6144 / 32, kb = r / nblk, nb = r % nblk;
                SrcPlain src{P->in[I_GWIN], GL_WIN_LD};
                transpose_item(src, D, (bf16_t*)(ws + WS_WGIN), nb * 32, kb * 64, nb * 32, scr, lane, P->in[I_NMIX] + (size_t)1 * D);
            } else if (r < IT_GIN + IT_GG) { r -= IT_GIN; const int nblk = GL_DK / 32, kb = r / nblk, nb = r % nblk;
                SrcGlaGate src{P->in[I_GWIN], P->in[I_GWGU]};
                transpose_item(src, D, (bf16_t*)(ws + WS_WGIN), 6144 + nb * 32, kb * 64, nb * 32, scr, lane, P->in[I_NMIX] + (size_t)1 * D);
            } else { r -= IT_GIN + IT_GG; const int nblk = D / 32, kb = r / nblk, nb = r % nblk;
                SrcPlain src{P->in[I_GWOUT], D};
                transpose_item(src, D, (bf16_t*)(ws + WS_WGOUT), nb * 32, kb * 64, nb * 32, scr, lane, nullptr);
            }
            continue;
        }
        r -= N_G;
        { const int gi = r / IT_PL, item = r % IT_PL, nblk = 512 / 32, kb = item / nblk, nb = item % nblk;
          SrcPlain src{P->in[I_PWG] + (size_t)gi * 512 * 512, 512};
          transpose_item(src, 512, (bf16_t*)(ws + WS_WPOOL), gi * 512 + nb * 32, kb * 64, nb * 32, scr, lane, nullptr); }
    }
    {
        float* X = (float*)(ws + WS_X); bf16_t* XB = (bf16_t*)(ws + WS_XN); float* SS = (float*)(ws + WS_SS);
        for (int m = gw; m < M; m += NGW) {
            const f32x4* xr = (m < MP ? (const f32x4*)(P->in[I_XP] + (size_t)m * D) : (const f32x4*)(P->in[I_XS] + (size_t)(m - MP) * D)) + lane;
            f32x4* xo = (f32x4*)(X + (size_t)m * D) + lane; u32x2* xb = (u32x2*)(XB + (size_t)m * D) + lane;
            float sq = 0.f;
#pragma unroll
            for (int j = 0; j < 8; ++j) { const f32x4 v = xr[64 * j]; xo[64 * j] = v; u32x2 w; w.x = pk2(v.x, v.y); w.y = pk2(v.z, v.w); xb[64 * j] = w; sq += (v.x * v.x + v.y * v.y) + (v.z * v.z + v.w * v.w); }
            sq = wave_sum(sq);
            if (lane < 32) SS[(size_t)m * 32 + lane] = lane == 0 ? sq : 0.f;
            if (lane == 0) ((float*)(ws + WS_R))[m] = __builtin_amdgcn_rsqf(sq * (1.f / D) + EPS);
        }
    }
    {
        float* TAB = (float*)(ws + WS_TAB);
        for (int c = gw * 64 + lane; c < D; c += NGW * 64) {
            float l[4], mx = -1e30f;
#pragma unroll
            for (int i = 0; i < 4; ++i) { l[i] = P->in[I_LBL][i * D + c]; mx = fmaxf(mx, l[i]); }
            float e[4], s = 0.f;
#pragma unroll
            for (int i = 0; i < 4; ++i) { e[i] = __expf(l[i] - mx); s += e[i]; }
            TAB[c] = 0.f;
            TAB[D + c] = (e[1] + e[2] + e[3]) / s;
        }
    }
}

__device__ __forceinline__ void norm_phase(float* X, const float* gain, bf16_t* XN, int gw, int NGW, int lane) {
    for (int m = gw; m < M; m += NGW) {
        const f32x4* xr = (const f32x4*)(X + (size_t)m * D) + lane;
        f32x4 v[8]; float s = 0.f;
#pragma unroll
        for (int j = 0; j < 8; ++j) v[j] = xr[64 * j];
#pragma unroll
        for (int j = 0; j < 8; ++j) s += (v[j].x * v[j].x + v[j].y * v[j].y) + (v[j].z * v[j].z + v[j].w * v[j].w);
        const float r = __builtin_amdgcn_rsqf(wave_sum(s) * (1.f / D) + EPS);
        const f32x4* gr = (const f32x4*)gain + lane;
        u32x2* o = (u32x2*)(XN + (size_t)m * D) + lane;
#pragma unroll
        for (int j = 0; j < 8; ++j) { const f32x4 g = gr[64 * j]; u32x2 w; w.x = pk2(v[j].x * r * g.x, v[j].y * r * g.y); w.y = pk2(v[j].z * r * g.z, v[j].w * r * g.w); o[64 * j] = w; }
    }
}
__device__ __forceinline__ void final_phase(const float* X, const float* gain, float* Y, const float* PART, int gw, int NGW, int lane) {
    f32x4 gv[8];
#pragma unroll
    for (int j = 0; j < 8; ++j) gv[j] = *((const f32x4*)gain + lane + 64 * j);
    for (int m = gw; m < M; m += NGW) {
        const f32x4* xr = (const f32x4*)(X + (size_t)m * D) + lane;
        f32x4 v[8]; float s = 0.f;
#pragma unroll
        for (int j = 0; j < 8; ++j) v[j] = xr[64 * j];
        if (m >= MP) {
#pragma unroll
            for (int hh = 0; hh < 2; ++hh) {
                u32x2 pw[4][8];
#pragma unroll
                for (int j = 0; j < 4; ++j)
#pragma unroll
                    for (int sp = 0; sp < 8; ++sp) pw[j][sp] = *((const u32x2*)((const bf16_t*)PART + ((size_t)sp * MS + (m - MP)) * D) + lane + 64 * (4 * hh + j));
#pragma unroll
                for (int j = 0; j < 4; ++j) {
                    f32x4 a = (f32x4){0.f, 0.f, 0.f, 0.f};
#pragma unroll
                    for (int sp = 0; sp < 8; ++sp) a = a + (f32x4){bflo(pw[j][sp].x), bfhi(pw[j][sp].x), bflo(pw[j][sp].y), bfhi(pw[j][sp].y)};
                    v[4 * hh + j] = v[4 * hh + j] + a * 0.5f;
                }
            }
        }
#pragma unroll
        for (int j = 0; j < 8; ++j) s += (v[j].x * v[j].x + v[j].y * v[j].y) + (v[j].z * v[j].z + v[j].w * v[j].w);
        const float r = __builtin_amdgcn_rsqf(wave_sum(s) * (1.f / D) + EPS);
        f32x4* o = (f32x4*)(Y + (size_t)m * D) + lane;
#pragma unroll
        for (int j = 0; j < 8; ++j) { const f32x4 y = v[j] * r * gv[j]; __builtin_nontemporal_store(y, o + 64 * j); }
    }
}
template <int NG>
__device__ __forceinline__ void post_phase(const bf16_t* O  , const float* gain, const bf16_t* G, bf16_t* OG, int gw, int NGW, int lane) {
    f32x4 gv[8];
#pragma unroll
    for (int j = 0; j < 8; ++j) gv[j] = *((const f32x4*)gain + lane + 64 * j);
    for (int m = gw; m < M; m += NGW) {
        const u32x2* xr = (const u32x2*)(O + (size_t)m * D) + lane;
        const u32x2* gg = (const u32x2*)(G + (size_t)m * D) + lane;
        f32x4 v[8]; u32x2 vq[8], gq[8]; float s[NG];
#pragma unroll
        for (int j = 0; j < 8; ++j) { vq[j] = xr[64 * j]; gq[j] = gg[64 * j]; }
#pragma unroll
        for (int j = 0; j < 8; ++j) v[j] = (f32x4){bflo(vq[j].x), bfhi(vq[j].x), bflo(vq[j].y), bfhi(vq[j].y)};
#pragma unroll
        for (int g = 0; g < NG; ++g) s[g] = 0.f;
#pragma unroll
        for (int j = 0; j < 8; ++j) s[j * NG / 8] += (v[j].x * v[j].x + v[j].y * v[j].y) + (v[j].z * v[j].z + v[j].w * v[j].w);
        float r[NG];
#pragma unroll
        for (int g = 0; g < NG; ++g) r[g] = __builtin_amdgcn_rsqf(wave_sum(s[g]) * ((float)NG / D) + EPS);
        u32x2* o = (u32x2*)(OG + (size_t)m * D) + lane;
#pragma unroll
        for (int j = 0; j < 8; ++j) { const f32x4 g = gv[j]; const u32x2 gw2 = gq[j]; const float rr = r[j * NG / 8];
            u32x2 w; w.x = pk2(v[j].x * rr * g.x * bflo(gw2.x), v[j].y * rr * g.y * bfhi(gw2.x)); w.y = pk2(v[j].z * rr * g.z * bflo(gw2.y), v[j].w * rr * g.w * bfhi(gw2.y)); o[64 * j] = w; }
    }
}

template <int NP  , int HALF>
__device__ __forceinline__ void fix_phase(float* X, bf16_t* XB, float* SS, float* R, const float* PART, int nsplit, const float* colscale, const float* RP, LAS unsigned char* lds, int bx, int wave, int gw, int NGW, int lane) {
    {
        const int m = MP + 4 * bx + (wave & 3), hf = wave >> 2;
        f32x4* xr = (f32x4*)(X + (size_t)m * D) + lane + 256 * hf; u32x2* xb = (u32x2*)(XB + (size_t)m * D) + lane + 256 * hf;
        u32x2 pw[4][8]; f32x4 xv[4];
#pragma unroll
        for (int j = 0; j < 4; ++j) { xv[j] = xr[64 * j];
#pragma unroll
            for (int sp = 0; sp < 8; ++sp) pw[j][sp] = (sp < nsplit) ? *((const u32x2*)((const bf16_t*)PART + ((size_t)sp * MS + (m - MP)) * D) + lane + 256 * hf + 64 * j) : (u32x2){0u, 0u}; }
        float rpv = 0.f; if (NP > 0) rpv = lane < NP ? RP[(size_t)m * NP + lane] : 0.f;
        f32x4 csv[4];
#pragma unroll
        for (int j = 0; j < 4; ++j) csv[j] = colscale ? *((const f32x4*)colscale + lane + 256 * hf + 64 * j) : (f32x4){1.f, 1.f, 1.f, 1.f};
        { float sv[2];
#pragma unroll
          for (int i = 0; i < 2; ++i) { const int mm = 2 * (gw + i * NGW) + (lane >> 5); sv[i] = mm < MP ? SS[(size_t)mm * 32 + (lane & 31)] : 0.f; }
#pragma unroll
          for (int i = 0; i < 2; ++i) { const int mm = 2 * (gw + i * NGW) + (lane >> 5); float s2 = sv[i];
#pragma unroll
              for (int o = 1; o < 32; o <<= 1) s2 += __shfl_xor(s2, o);
              if ((lane & 31) == 0 && mm < MP) R[mm] = __builtin_amdgcn_rsqf(s2 * (1.f / D) + EPS); } }
        float r = HALF ? 0.5f : 1.0f;
        if (NP > 0) { const float s3 = wave_sum(rpv); r *= __builtin_amdgcn_rsqf(s3 * (1.f / D) + EPS); }
        float sq = 0.f;
#pragma unroll
        for (int j = 0; j < 4; ++j) {
            f32x4 a = (f32x4){0.f, 0.f, 0.f, 0.f};
#pragma unroll
            for (int sp = 0; sp < 8; ++sp) a = a + (f32x4){bflo(pw[j][sp].x), bfhi(pw[j][sp].x), bflo(pw[j][sp].y), bfhi(pw[j][sp].y)};
            const f32x4 v = xv[j] + a * csv[j] * r;
            xr[64 * j] = v; u32x2 w; w.x = pk2(v.x, v.y); w.y = pk2(v.z, v.w); xb[64 * j] = w;
            sq += (v.x * v.x + v.y * v.y) + (v.z * v.z + v.w * v.w);
        }
        sq = wave_sum(sq);
        LAS float* red = (LAS float*)lds;
        lds_barrier();
        if (lane == 0) red[wave] = sq;
        lds_barrier();
        if (hf == 0) { const float tot = red[wave] + red[wave + 4];
            if (lane < 32) SS[(size_t)m * 32 + lane] = lane == 0 ? tot : 0.f;
            if (lane == 0) R[m] = __builtin_amdgcn_rsqf(tot * (1.f / D) + EPS); }
    }
}

template <int KT> struct LdBf;
template <> struct LdBf<4> { static __device__ __forceinline__ void ld(const bf16_t* p, float* o) { const u32x2 w = *(const u32x2*)p; o[0] = bflo(w.x); o[1] = bfhi(w.x); o[2] = bflo(w.y); o[3] = bfhi(w.y); } };
template <> struct LdBf<8> { static __device__ __forceinline__ void ld(const bf16_t* p, float* o) { const u32x4 w = *(const u32x4*)p; o[0] = bflo(w.x); o[1] = bfhi(w.x); o[2] = bflo(w.y); o[3] = bfhi(w.y); o[4] = bflo(w.z); o[5] = bfhi(w.z); o[6] = bflo(w.w); o[7] = bfhi(w.w); } };
template <int K, int VH, int NH>
__device__ __forceinline__ void scan_simple(const bf16_t* Q, const bf16_t* KK, const float* LF, const bf16_t* V, float* O,
                                            const float* S0, float* SPo, float* SSo, int tid, int G) {
    constexpr int KT = K / 32, NVB = VH / 16;
    const int vi = tid >> 5, kg = tid & 31;
    const int nunits = (PB + SB) * NH * NVB;
    for (int u = blockIdx.x; u < nunits; u += G) {
        const int seq = u / (NH * NVB), rem = u % (NH * NVB), h = rem / NVB, vb = rem % NVB;
        int row0, T; if (seq < PB) { row0 = seq * PT; T = PT; } else { row0 = MP + (seq - PB) * ST; T = ST; }
        float S[KT];
        const size_t sidx = ((size_t)h * K + kg * KT) * VH + vb * 16 + vi;
        if (seq >= PB) { const float* s0 = S0 + (size_t)(seq - PB) * NH * K * VH + sidx;
#pragma unroll
            for (int j = 0; j < KT; ++j) S[j] = s0[(size_t)j * VH]; }
        else {
#pragma unroll
            for (int j = 0; j < KT; ++j) S[j] = 0.f; }
        const int ccol = h * K + kg * KT, vcol = h * VH + vb * 16 + vi;
#pragma unroll 4
        for (int t = 0; t < T; ++t) {
            const size_t r = (size_t)(row0 + t) * D;
            float qf[KT], kf[KT], lf[KT];
            LdBf<KT>::ld(Q + r + ccol, qf); LdBf<KT>::ld(KK + r + ccol, kf);
#pragma unroll
            for (int j = 0; j < KT; j += 4) { const f32x4 l4 = *(const f32x4*)(LF + r + ccol + j); lf[j] = l4.x; lf[j + 1] = l4.y; lf[j + 2] = l4.z; lf[j + 3] = l4.w; }
            const float vv = bf2f(V[r + vcol]);
            float po = 0.f;
#pragma unroll
            for (int j = 0; j < KT; ++j) { S[j] = __expf(lf[j]) * S[j] + kf[j] * vv; po += qf[j] * S[j]; }
#pragma unroll
            for (int o = 1; o < 32; o <<= 1) po += __shfl_xor(po, o);
            if (kg == 0) O[r + vcol] = po;
        }
        float* so = (seq < PB ? SPo + (size_t)seq * NH * K * VH : SSo + (size_t)(seq - PB) * NH * K * VH) + sidx;
#pragma unroll
        for (int j = 0; j < KT; ++j) so[(size_t)j * VH] = S[j];
    }
}


__device__ __forceinline__ int permK(int c) { const int kk = c & 31; return (c & ~31) + 8 * ((kk & 15) >> 2) + 4 * (kk >> 4) + (kk & 3); }
template <int K, int VH, int NH>
__device__ __forceinline__ void scan_s1(const bf16_t* Q, const bf16_t* KK, const float* LF, const bf16_t* V, bf16_t* QI, bf16_t* KDT, bf16_t* AM, bf16_t* VT, float* DL,
                                        LAS unsigned char* lds, int tid, int G, int bx) {
    constexpr int KH = K / 2, RG = 512 / KH, RPT = 64 / RG, KS = K * 2 + 16, NHK = NH * K;
    constexpr int L_TOT = 0, L_QT = 4096, L_KT = L_QT + 64 * KS;
    static_assert(RG * K * 4 <= L_QT && L_KT + 64 * KS <= RING_BYTES && RPT % 8 == 0, "S1 LDS / shape");
    const int c = 2 * (tid % KH), rg = tid / KH, lane = tid & 63, wave = tid >> 6, l15 = lane & 15, g4 = lane >> 4;
    LAS float* TOT = (LAS float*)(lds + L_TOT);
    for (int u = bx; u < 144 * NH; u += G) {
        const int blk = u / NH, h = u % NH, r0 = blk * 64; const bool is_prompt = blk < 128;
        lds_barrier();
        f32x2 b[RPT]; unsigned lw[RPT], qw[RPT], kw[RPT];
        { const size_t ro = (size_t)(r0 + rg * RPT) * D + h * K + c;
#pragma unroll
          for (int i = 0; i < RPT; ++i) { lw[i] = *(const unsigned*)((const unsigned short*)LF + ro + (size_t)i * D); qw[i] = *(const unsigned*)(Q + ro + (size_t)i * D); kw[i] = *(const unsigned*)(KK + ro + (size_t)i * D); } }
#pragma unroll
        for (int i = 0; i < RPT; ++i) b[i] = (f32x2){hlo(lw[i]), hhi(lw[i])};
        f32x2 bref = (f32x2){0.f, 0.f}, blast = (f32x2){0.f, 0.f};
        if (is_prompt) {
#pragma unroll
            for (int i = 1; i < RPT; ++i) b[i] = b[i] + b[i - 1];
            *(LAS f32x2*)(TOT + rg * K + c) = b[RPT - 1];
            lds_barrier();
            f32x2 pre = (f32x2){0.f, 0.f}, tot = (f32x2){0.f, 0.f};
#pragma unroll
            for (int r = 0; r < RG; ++r) { const f32x2 t = *(const LAS f32x2*)(TOT + r * K + c); if (r < rg) pre = pre + t; if (r * RPT < 32) bref = bref + t; tot = tot + t; }
            blast = tot;
#pragma unroll
            for (int i = 0; i < RPT; ++i) b[i] = b[i] + pre;
        } else {
#pragma unroll
            for (int i = 0; i < RPT; ++i) if (i & 7) b[i] = b[i] + b[i - 1];
        }
        unsigned kd0[RPT / 2], kd1[RPT / 2];
#pragma unroll
        for (int i = 0; i < RPT; i += 2) {
            float k0v[2], k1v[2];
#pragma unroll
            for (int e = 0; e < 2; ++e) {
                const int t = rg * RPT + i + e;
                const f32x2 bb = b[i + e], bl = is_prompt ? blast : b[(i + e) | 7];
                const float q0 = bflo(qw[i + e]), q1 = bfhi(qw[i + e]), k0 = bflo(kw[i + e]), k1 = bfhi(kw[i + e]);
                const float qi0 = q0 * __expf(bb.x), qi1 = q1 * __expf(bb.y);
                k0v[e] = k0 * __expf(bl.x - bb.x); k1v[e] = k1 * __expf(bl.y - bb.y);
                const float qt0 = is_prompt ? q0 * __expf(fminf(bb.x - bref.x, 80.f)) : qi0, qt1 = is_prompt ? q1 * __expf(fminf(bb.y - bref.y, 80.f)) : qi1;
                const float kt0 = k0 * __expf(fminf(bref.x - bb.x, 80.f)), kt1 = k1 * __expf(fminf(bref.y - bb.y, 80.f));
                *(unsigned*)(QI + (size_t)(r0 + t) * NHK + h * K + permK(c)) = pk2(qi0, qi1);
                *(LAS unsigned*)(lds + L_QT + t * KS + c * 2) = pk2(qt0, qt1);
                *(LAS unsigned*)(lds + L_KT + t * KS + c * 2) = pk2(kt0, kt1);
                if (!is_prompt && ((i + e) & 7) == 7) *(f32x2*)(DL + (size_t)(128 + (blk - 128) * 8 + (t >> 3)) * NHK + h * K + c) = (f32x2){__expf(bb.x), __expf(bb.y)};
            }
            kd0[i / 2] = pk2(k0v[0], k0v[1]); kd1[i / 2] = pk2(k1v[0], k1v[1]);
        }
        if (is_prompt && rg == 0) *(f32x2*)(DL + (size_t)blk * NHK + h * K + c) = (f32x2){__expf(blast.x), __expf(blast.y)};
        { bf16_t* kp = KDT + ((size_t)(blk * NH + h) * K + c) * 64 + rg * RPT;
#pragma unroll
          for (int n = 0; n < RPT / 8; ++n) { u32x4 w; w.x = kd0[4 * n]; w.y = kd0[4 * n + 1]; w.z = kd0[4 * n + 2]; w.w = kd0[4 * n + 3]; *(u32x4*)(kp + 8 * n) = w;
              u32x4 w2; w2.x = kd1[4 * n]; w2.y = kd1[4 * n + 1]; w2.z = kd1[4 * n + 2]; w2.w = kd1[4 * n + 3]; *(u32x4*)(kp + 64 + 8 * n) = w2; } }
        lds_barrier();
        { const int tt = wave >> 1;
          bf16x8 bfr[K / 32];
#pragma unroll
          for (int ks = 0; ks < K / 32; ++ks) bfr[ks] = *(const LAS bf16x8*)(lds + L_QT + (16 * tt + l15) * KS + ks * 64 + g4 * 16);
#pragma unroll
          for (int e = 0; e < 2; ++e) {
              const int st = (wave & 1) * 2 + e;
              f32x4 acc = (f32x4){0.f, 0.f, 0.f, 0.f};
              if (st <= tt) {
                  bf16x8 af[K / 32];
#pragma unroll
                  for (int ks = 0; ks < K / 32; ++ks) af[ks] = *(const LAS bf16x8*)(lds + L_KT + (16 * st + l15) * KS + ks * 64 + g4 * 16);
                  __builtin_amdgcn_sched_barrier(0);
#pragma unroll
                  for (int ks = 0; ks < K / 32; ++ks) acc = __builtin_amdgcn_mfma_f32_16x16x32_bf16(af[ks], bfr[ks], acc, 0, 0, 0);
                  __builtin_amdgcn_sched_barrier(0);
              }
              const int t = 16 * tt + l15; float o[4];
#pragma unroll
              for (int r = 0; r < 4; ++r) { const int sidx = 16 * st + 4 * g4 + r; const bool keep = (sidx <= t) && (is_prompt || (sidx >> 3) == (t >> 3)); o[r] = keep ? acc[r] : 0.f; }
              u32x2 w; w.x = pk2(o[0], o[1]); w.y = pk2(o[2], o[3]);
              *(u32x2*)(AM + ((size_t)(blk * NH + h) * 64 + t) * 64 + 16 * st + 4 * g4) = w;
          } }
    }
}

template <int VS> __device__ __forceinline__ void v_frag_tr2(unsigned a, bf16x8& f0, bf16x8& f1) {
    u32x2 r0, r1, r2, r3;
    asm volatile("ds_read_b64_tr_b16 %0, %4\n\tds_read_b64_tr_b16 %1, %5\n\tds_read_b64_tr_b16 %2, %6\n\tds_read_b64_tr_b16 %3, %7\n\ts_waitcnt lgkmcnt(0)"
                 : "=&v"(r0), "=&v"(r1), "=&v"(r2), "=&v"(r3) : "v"(a), "v"(a + 4 * VS), "v"(a + 32 * VS), "v"(a + 36 * VS) : "memory");
    union { u32x4 u; bf16x8 v; } x, y; x.u = (u32x4){r0.x, r0.y, r1.x, r1.y}; y.u = (u32x4){r2.x, r2.y, r3.x, r3.y}; f0 = x.v; f1 = y.v;
}
template <int VS> __device__ __forceinline__ bf16x8 v_frag_tr1(unsigned a) {
    u32x2 r0, r1;
    asm volatile("ds_read_b64_tr_b16 %0, %2\n\tds_read_b64_tr_b16 %1, %3\n\ts_waitcnt lgkmcnt(0)" : "=&v"(r0), "=&v"(r1) : "v"(a), "v"(a + 4 * VS) : "memory");
    union { u32x4 u; bf16x8 v; } x; x.u = (u32x4){r0.x, r0.y, r1.x, r1.y}; return x.v;
}

template <int K, int VH, int NH, bool FUSE>
__device__ __forceinline__ void scan_s2_old(const bf16_t* QI, const bf16_t* KDT, const bf16_t* AM, const bf16_t* VT, const float* DL, const float* S0, float* SPo, float* SSo, float* O,
                                        const bf16_t* Gin, bf16_t* OG, float* SSO, LAS unsigned char* lds, unsigned* qhead, int tid, int G, int bx) {
    constexpr int NVQ = VH / 128, NKT = K / 16, NKS = K / 32, QS = K * 2 + 16, RS = 144, NHK = NH * K;
    constexpr int L_QI = 0, L_KDT = L_QI + 64 * QS, L_A = L_KDT + K * RS, L_VT = L_A + 64 * RS, L_DL = L_VT + 128 * RS, L_END = L_DL + 8 * K * 4;
    constexpr int L_O = L_END, OTS = 132;
    static_assert((FUSE ? L_O + 64 * OTS * 4 : L_END) <= RING_BYTES && (!FUSE || VH == 128), "S2 LDS");
    LAS float* OT = (LAS float*)(lds + L_O);
    u32x4 gpre0 = (u32x4){0u, 0u, 0u, 0u}, gpre1 = gpre0;
#define S2_G_LOAD(blk_, h_, rb, nr) do { if (FUSE && tid < (nr) * 8) { const size_t _go = (size_t)((blk_) * 64 + (rb) + (tid >> 3)) * D + (h_) * VH + (tid & 7) * 16; gpre0 = *(const u32x4*)(Gin + _go); gpre1 = *(const u32x4*)(Gin + _go + 8); } } while (0)
#define S2_OG_EPI(blk_, h_, rb, nr) do { if (tid < (nr) * 8) { const int _t = (rb) + (tid >> 3), _seg = tid & 7; const LAS float* _op = OT + _t * OTS + _seg * 16; \
        const f32x4 _o0 = *(const LAS f32x4*)_op, _o1 = *(const LAS f32x4*)(_op + 4), _o2 = *(const LAS f32x4*)(_op + 8), _o3 = *(const LAS f32x4*)(_op + 12); \
        const size_t _go = (size_t)((blk_) * 64 + _t) * D + (h_) * VH + _seg * 16; const u32x4 _g0 = gpre0, _g1 = gpre1; \
        float _ss = ((_o0.x * _o0.x + _o0.y * _o0.y) + (_o0.z * _o0.z + _o0.w * _o0.w)) + ((_o1.x * _o1.x + _o1.y * _o1.y) + (_o1.z * _o1.z + _o1.w * _o1.w)) \
                  + ((_o2.x * _o2.x + _o2.y * _o2.y) + (_o2.z * _o2.z + _o2.w * _o2.w)) + ((_o3.x * _o3.x + _o3.y * _o3.y) + (_o3.z * _o3.z + _o3.w * _o3.w)); \
        u32x4 _w0, _w1; _w0.x = cvt_pk_bf16(_o0.x * bflo(_g0.x), _o0.y * bfhi(_g0.x)); _w0.y = cvt_pk_bf16(_o0.z * bflo(_g0.y), _o0.w * bfhi(_g0.y)); \
        _w0.z = cvt_pk_bf16(_o1.x * bflo(_g0.z), _o1.y * bfhi(_g0.z)); _w0.w = cvt_pk_bf16(_o1.z * bflo(_g0.w), _o1.w * bfhi(_g0.w)); \
        _w1.x = cvt_pk_bf16(_o2.x * bflo(_g1.x), _o2.y * bfhi(_g1.x)); _w1.y = cvt_pk_bf16(_o2.z * bflo(_g1.y), _o2.w * bfhi(_g1.y)); \
        _w1.z = cvt_pk_bf16(_o3.x * bflo(_g1.z), _o3.y * bfhi(_g1.z)); _w1.w = cvt_pk_bf16(_o3.z * bflo(_g1.w), _o3.w * bfhi(_g1.w)); \
        *(u32x4*)(OG + _go) = _w0; *(u32x4*)(OG + _go + 8) = _w1; \
        _ss += __shfl_xor(_ss, 1); _ss += __shfl_xor(_ss, 2); _ss += __shfl_xor(_ss, 4); \
        if (_seg == 0) SSO[(size_t)((blk_) * 64 + _t) * 16 + (h_)] = _ss; } } while (0)
    constexpr int P_QI = 64 * (K / 8) / 512, P_KD = K * 8 / 512;
    const int lane = tid & 63, wave = tid >> 6, l15 = lane & 15, g4 = lane >> 4;
    volatile LAS unsigned* qslot = (volatile LAS unsigned*)(lds + MISC_OFF + 64);
    const unsigned vtr_a = (unsigned)(size_t)(lds + L_VT) + (8 * g4 + (l15 >> 2)) * 272 + (16 * wave + 4 * (lane & 3)) * 2, vtr_a128 = vtr_a;

    u32x4 rq[P_QI], rk[P_KD], ra, rv[2], rd;
#define S2_LOAD(blk_, h_, vq_, ndl_) do { const int _blk = (blk_), _h = (h_), _vq = (vq_); \
        _Pragma("unroll") for (int n = 0; n < P_QI; ++n) { const int p = tid + n * 512, row = p / (K / 8), pc = p % (K / 8); rq[n] = *(const u32x4*)(QI + (size_t)(_blk * 64 + row) * NHK + _h * K + pc * 8); } \
        _Pragma("unroll") for (int n = 0; n < P_KD; ++n) { const int p = tid + n * 512; rk[n] = *(const u32x4*)(KDT + (size_t)(_blk * NH + _h) * K * 64 + (size_t)p * 8); } \
        ra = *(const u32x4*)(AM + (size_t)(_blk * NH + _h) * 4096 + (size_t)tid * 8); \
        _Pragma("unroll") for (int n = 0; n < 2; ++n) { const int p = tid + n * 512; rv[n] = *(const u32x4*)(VT + (size_t)(_blk * 64 + (p >> 4)) * D + _h * VH + _vq * 128 + (p & 15) * 8); } \
        if ((ndl_) == 1) { if (tid < K / 4) rd = *(const u32x4*)(DL + (size_t)_blk * NHK + _h * K + tid * 4); } \
        else { if (tid < 2 * K) { const int sg = tid / (K / 4), pc = tid % (K / 4); rd = *(const u32x4*)(DL + (size_t)(128 + (_blk - 128) * 8 + sg) * NHK + _h * K + pc * 4); } } } while (0)
#define S2_STORE(ndl_) do { \
        _Pragma("unroll") for (int n = 0; n < P_QI; ++n) { const int p = tid + n * 512, row = p / (K / 8), pc = p % (K / 8); *(LAS u32x4*)(lds + L_QI + row * QS + pc * 16) = rq[n]; } \
        _Pragma("unroll") for (int n = 0; n < P_KD; ++n) { const int p = tid + n * 512; *(LAS u32x4*)(lds + L_KDT + (p >> 3) * RS + (p & 7) * 16) = rk[n]; } \
        *(LAS u32x4*)(lds + L_A + (tid >> 3) * RS + (tid & 7) * 16) = ra; \
        _Pragma("unroll") for (int n = 0; n < 2; ++n) { const int p = tid + n * 512; *(LAS u32x4*)(lds + L_VT + (p >> 4) * 272 + (p & 15) * 16) = rv[n]; } \
        if ((ndl_) == 1) { if (tid < K / 4) *(LAS u32x4*)(lds + L_DL + tid * 16) = rd; } \
        else { if (tid < 2 * K) *(LAS u32x4*)(lds + L_DL + tid * 16) = rd; } } while (0)

    f32x4 S[NKT];
    if (bx < PB * NH * NVQ) {
        const int b = bx / (NH * NVQ), h = (bx / NVQ) % NH, vq = bx % NVQ;
        const int col = h * VH + vq * 128 + wave * 16 + l15;
#pragma unroll
        for (int kt = 0; kt < NKT; ++kt) S[kt] = (f32x4){0.f, 0.f, 0.f, 0.f};
        lds_barrier();
        S2_LOAD(b * 32, h, vq, 1); S2_STORE(1);
        lds_barrier();
#pragma unroll 1
        for (int ch = 0; ch < 32; ++ch) {
            const int blk = b * 32 + ch;
            if (ch + 1 < 32) S2_LOAD(blk + 1, h, vq, 1);
            S2_G_LOAD(blk, h, 0, 64);
            bf16x8 vfr[2];
            v_frag_tr2<272>(vtr_a, vfr[0], vfr[1]);
            f32x4 oacc[4];
#pragma unroll
            for (int tt = 0; tt < 4; ++tt) oacc[tt] = (f32x4){0.f, 0.f, 0.f, 0.f};
#pragma unroll
            for (int ks = 0; ks < NKS; ++ks) {
                bf16x8 aq[4];
#pragma unroll
                for (int tt = 0; tt < 4; ++tt) aq[tt] = *(const LAS bf16x8*)(lds + L_QI + (16 * tt + l15) * QS + ks * 64 + g4 * 16);
                __builtin_amdgcn_sched_barrier(0);
                union { u32x4 u; bf16x8 v; } sb;
                sb.u.x = cvt_pk_bf16(S[2 * ks][0], S[2 * ks][1]); sb.u.y = cvt_pk_bf16(S[2 * ks][2], S[2 * ks][3]);
                sb.u.z = cvt_pk_bf16(S[2 * ks + 1][0], S[2 * ks + 1][1]); sb.u.w = cvt_pk_bf16(S[2 * ks + 1][2], S[2 * ks + 1][3]);
#pragma unroll
                for (int tt = 0; tt < 4; ++tt) oacc[tt] = __builtin_amdgcn_mfma_f32_16x16x32_bf16(aq[tt], sb.v, oacc[tt], 0, 0, 0);
                __builtin_amdgcn_sched_barrier(0);
            }
#pragma unroll
            for (int tp = 0; tp < 2; ++tp) { bf16x8 aa[2][2];
#pragma unroll
              for (int i = 0; i < 2; ++i)
#pragma unroll
                  for (int ss = 0; ss < 2; ++ss) aa[i][ss] = *(const LAS bf16x8*)(lds + L_A + (16 * (2 * tp + i) + l15) * RS + ss * 64 + g4 * 16);
              __builtin_amdgcn_sched_barrier(0);
#pragma unroll
              for (int i = 0; i < 2; ++i)
#pragma unroll
                  for (int ss = 0; ss < 2; ++ss) oacc[2 * tp + i] = __builtin_amdgcn_mfma_f32_16x16x32_bf16(aa[i][ss], vfr[ss], oacc[2 * tp + i], 0, 0, 0);
              __builtin_amdgcn_sched_barrier(0); }
#pragma unroll
            for (int kh = 0; kh < NKT / 2; ++kh) {
                bf16x8 ak[2][2]; f32x4 dlv[2];
#pragma unroll
                for (int k2 = 0; k2 < 2; ++k2) { dlv[k2] = *(const LAS f32x4*)(lds + L_DL + (16 * (kh * 2 + k2) + 4 * g4) * 4);
#pragma unroll
                    for (int ss = 0; ss < 2; ++ss) ak[k2][ss] = *(const LAS bf16x8*)(lds + L_KDT + (16 * (kh * 2 + k2) + l15) * RS + ss * 64 + g4 * 16); }
                __builtin_amdgcn_sched_barrier(0);
#pragma unroll
                for (int k2 = 0; k2 < 2; ++k2) { const int kt = kh * 2 + k2; S[kt] = S[kt] * dlv[k2];
#pragma unroll
                    for (int ss = 0; ss < 2; ++ss) S[kt] = __builtin_amdgcn_mfma_f32_16x16x32_bf16(ak[k2][ss], vfr[ss], S[kt], 0, 0, 0); }
                __builtin_amdgcn_sched_barrier(0);
            }
#pragma unroll
            for (int tt = 0; tt < 4; ++tt)
#pragma unroll
                for (int r = 0; r < 4; ++r) { if (FUSE) OT[(16 * tt + 4 * g4 + r) * OTS + wave * 16 + l15] = oacc[tt][r]; else ((bf16_t*)O)[(size_t)(blk * 64 + 16 * tt + 4 * g4 + r) * D + col] = (bf16_t)pk2(oacc[tt][r], 0.f); }
            lds_barrier();
            if (ch + 1 < 32) S2_STORE(1);
            if (FUSE) S2_OG_EPI(blk, h, 0, 64);
            lds_barrier();
        }
        float* so = SPo + ((size_t)(b * NH + h) * K) * VH + vq * 128 + wave * 16 + l15;
#pragma unroll
        for (int kt = 0; kt < NKT; ++kt)
#pragma unroll
            for (int r = 0; r < 4; ++r) __builtin_nontemporal_store(S[kt][r], so + (size_t)(16 * kt + 4 * g4 + r) * VH);
    }
    constexpr int NTASK = 16 * NH * NVQ * 2;
    for (;;) {
        lds_barrier();
        if (tid == 0) qslot[0] = __hip_atomic_fetch_add(qhead, 1u, __ATOMIC_RELAXED, __HIP_MEMORY_SCOPE_AGENT);
        lds_barrier();
        const int task = (int)qslot[0];
        if (task >= NTASK) break;
        const int half = task & 1, vq = (task >> 1) % NVQ, h = (task / (2 * NVQ)) % NH, sblk = task / (2 * NVQ * NH), blk = 128 + sblk;
        const int col = h * VH + vq * 128 + wave * 16 + l15;
        S2_LOAD(blk, h, vq, 8); S2_STORE(8);
        S2_G_LOAD(blk, h, 32 * half, 32);
        lds_barrier();
        const bf16x8 vfr0 = v_frag_tr1<272>(vtr_a128 + half * 32 * 272);
#pragma unroll 1
        for (int jj = 0; jj < 4; ++jj) {
            const int j = half * 4 + jj, bseq = sblk * 8 + j;
            const float* s0 = S0 + ((size_t)(bseq * NH + h) * K) * VH + vq * 128 + wave * 16 + l15;
#pragma unroll
            for (int kt = 0; kt < NKT; ++kt)
#pragma unroll
                for (int r = 0; r < 4; ++r) S[kt][r] = __builtin_nontemporal_load(s0 + (size_t)(16 * kt + 4 * g4 + r) * VH);
            const int arow = 8 * j + (l15 & 7);
            constexpr int BQ = 4, BK = (NKT > 8) ? 4 : 8;
            const bf16x8 aAs = *(const LAS bf16x8*)(lds + L_A + arow * RS + half * 64 + g4 * 16);
            f32x4 oacc = (f32x4){0.f, 0.f, 0.f, 0.f};
#pragma unroll
            for (int qb = 0; qb < NKS / BQ; ++qb) {
                bf16x8 aqs[BQ];
#pragma unroll
                for (int i = 0; i < BQ; ++i) aqs[i] = *(const LAS bf16x8*)(lds + L_QI + arow * QS + (qb * BQ + i) * 64 + g4 * 16);
                __builtin_amdgcn_sched_barrier(0);
#pragma unroll
                for (int i = 0; i < BQ; ++i) { const int ks = qb * BQ + i;
                    union { u32x4 u; bf16x8 v; } sb;
                    sb.u.x = cvt_pk_bf16(S[2 * ks][0], S[2 * ks][1]); sb.u.y = cvt_pk_bf16(S[2 * ks][2], S[2 * ks][3]);
                    sb.u.z = cvt_pk_bf16(S[2 * ks + 1][0], S[2 * ks + 1][1]); sb.u.w = cvt_pk_bf16(S[2 * ks + 1][2], S[2 * ks + 1][3]);
                    oacc = __builtin_amdgcn_mfma_f32_16x16x32_bf16(aqs[i], sb.v, oacc, 0, 0, 0); }
                __builtin_amdgcn_sched_barrier(0);
            }
            oacc = __builtin_amdgcn_mfma_f32_16x16x32_bf16(aAs, vfr0, oacc, 0, 0, 0);
#pragma unroll
            for (int kh = 0; kh < NKT / BK; ++kh) {
                u32x4 akd[BK]; f32x4 dls[BK];
#pragma unroll
                for (int k8 = 0; k8 < BK; ++k8) { akd[k8] = *(const LAS u32x4*)(lds + L_KDT + (16 * (kh * BK + k8) + l15) * RS + half * 64 + g4 * 16);
                    dls[k8] = *(const LAS f32x4*)(lds + L_DL + j * K * 4 + (16 * (kh * BK + k8) + 4 * g4) * 4); }
                __builtin_amdgcn_sched_barrier(0);
#pragma unroll
                for (int k8 = 0; k8 < BK; ++k8) { const int kt = kh * BK + k8;
                    S[kt] = S[kt] * dls[k8];
                    union { u32x4 u; bf16x8 v; } af; af.u = akd[k8];
                    if (g4 != jj) af.u = (u32x4){0u, 0u, 0u, 0u};
                    S[kt] = __builtin_amdgcn_mfma_f32_16x16x32_bf16(af.v, vfr0, S[kt], 0, 0, 0); }
                __builtin_amdgcn_sched_barrier(0);
            }
            if (g4 < 2) {
#pragma unroll
                for (int r = 0; r < 4; ++r) { if (FUSE) OT[(8 * j + 4 * g4 + r) * OTS + wave * 16 + l15] = oacc[r]; else ((bf16_t*)O)[(size_t)(blk * 64 + 8 * j + 4 * g4 + r) * D + col] = (bf16_t)pk2(oacc[r], 0.f); }
            }
            float* so = SSo + ((size_t)(bseq * NH + h) * K) * VH + vq * 128 + wave * 16 + l15;
#pragma unroll
            for (int kt = 0; kt < NKT; ++kt)
#pragma unroll
                for (int r = 0; r < 4; ++r) __builtin_nontemporal_store(S[kt][r], so + (size_t)(16 * kt + 4 * g4 + r) * VH);
        }
        if (FUSE) { lds_barrier(); S2_OG_EPI(blk, h, 32 * half, 32); }
    }
#undef S2_OG_EPI
#undef S2_G_LOAD
#undef S2_LOAD
#undef S2_STORE
}

template <int K, int VH, int NH, bool FUSE>
__device__ __forceinline__ void scan_s2(const bf16_t* QI, const bf16_t* KDT, const bf16_t* AM, const bf16_t* VT, const float* DL, const float* S0, float* SPo, float* SSo, float* O,
                                        const bf16_t* Gin, bf16_t* OG, float* SSO, LAS unsigned char* lds, unsigned* qhead, int tid, int G, int bx) {
    constexpr int NVQ = VH / 128, NVQ2 = VH / 64, NKT = K / 16, NKS = K / 32, QS = K * 2 + 16, RS = 144, NHK = NH * K;
    constexpr int L_QI = 0, L_KDT = L_QI + 64 * QS, L_A = L_KDT + K * RS, L_VT = L_A + 64 * RS, L_DL = L_VT + 128 * RS, L_END = L_DL + 8 * K * 4;
    constexpr int L_O = L_END, OTS = 132;
    static_assert((FUSE ? L_O + 64 * OTS * 4 : L_END) <= RING_BYTES && (!FUSE || VH == 128), "S2 LDS");
    LAS float* OT = (LAS float*)(lds + L_O);
    u32x4 gpre0 = (u32x4){0u, 0u, 0u, 0u}, gpre1 = gpre0;
#define S2_G_LOAD(blk_, h_, rb, nr) do { if (FUSE && tid < (nr) * 8) { const size_t _go = (size_t)((blk_) * 64 + (rb) + (tid >> 3)) * D + (h_) * VH + (tid & 7) * 16; gpre0 = *(const u32x4*)(Gin + _go); gpre1 = *(const u32x4*)(Gin + _go + 8); } } while (0)
#define S2_OG_EPI(blk_, h_, rb, nr) do { if (tid < (nr) * 8) { const int _t = (rb) + (tid >> 3), _seg = tid & 7; const LAS float* _op = OT + _t * OTS + _seg * 16; \
        const f32x4 _o0 = *(const LAS f32x4*)_op, _o1 = *(const LAS f32x4*)(_op + 4), _o2 = *(const LAS f32x4*)(_op + 8), _o3 = *(const LAS f32x4*)(_op + 12); \
        const size_t _go = (size_t)((blk_) * 64 + _t) * D + (h_) * VH + _seg * 16; const u32x4 _g0 = gpre0, _g1 = gpre1; \
        float _ss = ((_o0.x * _o0.x + _o0.y * _o0.y) + (_o0.z * _o0.z + _o0.w * _o0.w)) + ((_o1.x * _o1.x + _o1.y * _o1.y) + (_o1.z * _o1.z + _o1.w * _o1.w)) \
                  + ((_o2.x * _o2.x + _o2.y * _o2.y) + (_o2.z * _o2.z + _o2.w * _o2.w)) + ((_o3.x * _o3.x + _o3.y * _o3.y) + (_o3.z * _o3.z + _o3.w * _o3.w)); \
        u32x4 _w0, _w1; _w0.x = cvt_pk_bf16(_o0.x * bflo(_g0.x), _o0.y * bfhi(_g0.x)); _w0.y = cvt_pk_bf16(_o0.z * bflo(_g0.y), _o0.w * bfhi(_g0.y)); \
        _w0.z = cvt_pk_bf16(_o1.x * bflo(_g0.z), _o1.y * bfhi(_g0.z)); _w0.w = cvt_pk_bf16(_o1.z * bflo(_g0.w), _o1.w * bfhi(_g0.w)); \
        _w1.x = cvt_pk_bf16(_o2.x * bflo(_g1.x), _o2.y * bfhi(_g1.x)); _w1.y = cvt_pk_bf16(_o2.z * bflo(_g1.y), _o2.w * bfhi(_g1.y)); \
        _w1.z = cvt_pk_bf16(_o3.x * bflo(_g1.z), _o3.y * bfhi(_g1.z)); _w1.w = cvt_pk_bf16(_o3.z * bflo(_g1.w), _o3.w * bfhi(_g1.w)); \
        *(u32x4*)(OG + _go) = _w0; *(u32x4*)(OG + _go + 8) = _w1; \
        _ss += __shfl_xor(_ss, 1); _ss += __shfl_xor(_ss, 2); _ss += __shfl_xor(_ss, 4); \
        if (_seg == 0) { SSO[(size_t)((blk_) * 64 + _t) * 32 + 2 * (h_)] = _ss; SSO[(size_t)((blk_) * 64 + _t) * 32 + 2 * (h_) + 1] = 0.f; } } } while (0)
#define S2_G_LOADP(blk_, h_, vq2_) do { if (FUSE && tid < 256) { const size_t _go = (size_t)((blk_) * 64 + (tid >> 2)) * D + (h_) * VH + (vq2_) * 64 + (tid & 3) * 16; gpre0 = *(const u32x4*)(Gin + _go); gpre1 = *(const u32x4*)(Gin + _go + 8); } } while (0)
#define S2_OG_EPIP(blk_, h_, vq2_) do { if (tid < 256) { const int _t = tid >> 2, _seg = tid & 3; const LAS float* _op = OT + _t * OTS + _seg * 16; \
        const f32x4 _o0 = *(const LAS f32x4*)_op, _o1 = *(const LAS f32x4*)(_op + 4), _o2 = *(const LAS f32x4*)(_op + 8), _o3 = *(const LAS f32x4*)(_op + 12); \
        const size_t _go = (size_t)((blk_) * 64 + _t) * D + (h_) * VH + (vq2_) * 64 + _seg * 16; const u32x4 _g0 = gpre0, _g1 = gpre1; \
        float _ss = ((_o0.x * _o0.x + _o0.y * _o0.y) + (_o0.z * _o0.z + _o0.w * _o0.w)) + ((_o1.x * _o1.x + _o1.y * _o1.y) + (_o1.z * _o1.z + _o1.w * _o1.w)) \
                  + ((_o2.x * _o2.x + _o2.y * _o2.y) + (_o2.z * _o2.z + _o2.w * _o2.w)) + ((_o3.x * _o3.x + _o3.y * _o3.y) + (_o3.z * _o3.z + _o3.w * _o3.w)); \
        u32x4 _w0, _w1; _w0.x = cvt_pk_bf16(_o0.x * bflo(_g0.x), _o0.y * bfhi(_g0.x)); _w0.y = cvt_pk_bf16(_o0.z * bflo(_g0.y), _o0.w * bfhi(_g0.y)); \
        _w0.z = cvt_pk_bf16(_o1.x * bflo(_g0.z), _o1.y * bfhi(_g0.z)); _w0.w = cvt_pk_bf16(_o1.z * bflo(_g0.w), _o1.w * bfhi(_g0.w)); \
        _w1.x = cvt_pk_bf16(_o2.x * bflo(_g1.x), _o2.y * bfhi(_g1.x)); _w1.y = cvt_pk_bf16(_o2.z * bflo(_g1.y), _o2.w * bfhi(_g1.y)); \
        _w1.z = cvt_pk_bf16(_o3.x * bflo(_g1.z), _o3.y * bfhi(_g1.z)); _w1.w = cvt_pk_bf16(_o3.z * bflo(_g1.w), _o3.w * bfhi(_g1.w)); \
        *(u32x4*)(OG + _go) = _w0; *(u32x4*)(OG + _go + 8) = _w1; \
        _ss += __shfl_xor(_ss, 1); _ss += __shfl_xor(_ss, 2); \
        if (_seg == 0) SSO[(size_t)((blk_) * 64 + _t) * 32 + 2 * (h_) + (vq2_)] = _ss; } } while (0)
    constexpr int P_QI = 64 * (K / 8) / 512, P_KD = K * 8 / 512;
    const int lane = tid & 63, wave = tid >> 6, l15 = lane & 15, g4 = lane >> 4;
    volatile LAS unsigned* qslot = (volatile LAS unsigned*)(lds + MISC_OFF + 64);
    const unsigned vtr_a128 = (unsigned)(size_t)(lds + L_VT) + (8 * g4 + (l15 >> 2)) * 272 + (16 * wave + 4 * (lane & 3)) * 2;
    const unsigned vtr_a64 = (unsigned)(size_t)(lds + L_VT) + (8 * g4 + (l15 >> 2)) * 144 + (16 * (wave & 3) + 4 * (lane & 3)) * 2;

    u32x4 rq[P_QI], rk[P_KD], ra, rv[2], rd;
#define S2_LOAD(blk_, h_, vcol0_, nvrows_, ndl_) do { const int _blk = (blk_), _h = (h_), _vc0 = (vcol0_); \
        _Pragma("unroll") for (int n = 0; n < P_QI; ++n) { const int p = tid + n * 512, row = p / (K / 8), pc = p % (K / 8); rq[n] = *(const u32x4*)(QI + (size_t)(_blk * 64 + row) * NHK + _h * K + pc * 8); } \
        _Pragma("unroll") for (int n = 0; n < P_KD; ++n) { const int p = tid + n * 512; rk[n] = *(const u32x4*)(KDT + (size_t)(_blk * NH + _h) * K * 64 + (size_t)p * 8); } \
        ra = *(const u32x4*)(AM + (size_t)(_blk * NH + _h) * 4096 + (size_t)tid * 8); \
        _Pragma("unroll") for (int n = 0; n < 2; ++n) { const int p = tid + n * 512; constexpr int _pr = (nvrows_) / 8; if (p < (nvrows_) * 8) rv[n] = *(const u32x4*)(VT + (size_t)(_blk * 64 + p / _pr) * D + _h * VH + _vc0 + (p % _pr) * 8); } \
        if ((ndl_) == 1) { if (tid < K / 4) rd = *(const u32x4*)(DL + (size_t)_blk * NHK + _h * K + tid * 4); } \
        else { if (tid < 2 * K) { const int sg = tid / (K / 4), pc = tid % (K / 4); rd = *(const u32x4*)(DL + (size_t)(128 + (_blk - 128) * 8 + sg) * NHK + _h * K + pc * 4); } } } while (0)
#define S2_STORE(nvrows_, ndl_) do { \
        _Pragma("unroll") for (int n = 0; n < P_QI; ++n) { const int p = tid + n * 512, row = p / (K / 8), pc = p % (K / 8); *(LAS u32x4*)(lds + L_QI + row * QS + pc * 16) = rq[n]; } \
        _Pragma("unroll") for (int n = 0; n < P_KD; ++n) { const int p = tid + n * 512; *(LAS u32x4*)(lds + L_KDT + (p >> 3) * RS + (p & 7) * 16) = rk[n]; } \
        *(LAS u32x4*)(lds + L_A + (tid >> 3) * RS + (tid & 7) * 16) = ra; \
        _Pragma("unroll") for (int n = 0; n < 2; ++n) { const int p = tid + n * 512; constexpr int _pr = (nvrows_) / 8, _vs = (nvrows_) == 64 ? 144 : 272; if (p < (nvrows_) * 8) *(LAS u32x4*)(lds + L_VT + (p / _pr) * _vs + (p % _pr) * 16) = rv[n]; } \
        if ((ndl_) == 1) { if (tid < K / 4) *(LAS u32x4*)(lds + L_DL + tid * 16) = rd; } \
        else { if (tid < 2 * K) *(LAS u32x4*)(lds + L_DL + tid * 16) = rd; } } while (0)

    f32x4 S[NKT];
    if (FUSE && bx < PB * NH * NVQ2) {
        const int b = bx / (NH * NVQ2), h = (bx / NVQ2) % NH, vq2 = bx % NVQ2;
        const int col = h * VH + vq2 * 64 + (wave & 3) * 16 + l15;
        const bool act = wave < 4;
#pragma unroll
        for (int kt = 0; kt < NKT; ++kt) S[kt] = (f32x4){0.f, 0.f, 0.f, 0.f};
        lds_barrier();
        S2_LOAD(b * 32, h, vq2 * 64, 64, 1); S2_STORE(64, 1);
        lds_barrier();
#pragma unroll 1
        for (int ch = 0; ch < 32; ++ch) {
            const int blk = b * 32 + ch;
            if (ch + 1 < 32) S2_LOAD(blk + 1, h, vq2 * 64, 64, 1);
            S2_G_LOADP(blk, h, vq2);
            if (act) {
            bf16x8 vfr[2], aq[NKS][4];
#pragma unroll
            for (int ks = 0; ks < NKS; ++ks)
#pragma unroll
                for (int tt = 0; tt < 4; ++tt) aq[ks][tt] = *(const LAS bf16x8*)(lds + L_QI + (16 * tt + l15) * QS + ks * 64 + g4 * 16);
            v_frag_tr2<144>(vtr_a64, vfr[0], vfr[1]);
            __builtin_amdgcn_sched_barrier(0);
            f32x4 oacc[4];
#pragma unroll
            for (int tt = 0; tt < 4; ++tt) oacc[tt] = (f32x4){0.f, 0.f, 0.f, 0.f};
#pragma unroll
            for (int ks = 0; ks < NKS; ++ks) {
                union { u32x4 u; bf16x8 v; } sb;
                sb.u.x = cvt_pk_bf16(S[2 * ks][0], S[2 * ks][1]); sb.u.y = cvt_pk_bf16(S[2 * ks][2], S[2 * ks][3]);
                sb.u.z = cvt_pk_bf16(S[2 * ks + 1][0], S[2 * ks + 1][1]); sb.u.w = cvt_pk_bf16(S[2 * ks + 1][2], S[2 * ks + 1][3]);
#pragma unroll
                for (int tt = 0; tt < 4; ++tt) oacc[tt] = __builtin_amdgcn_mfma_f32_16x16x32_bf16(aq[ks][tt], sb.v, oacc[tt], 0, 0, 0);
            }
            __builtin_amdgcn_sched_barrier(0);
            { bf16x8 aa[4][2]; f32x4 dlv[NKT];
#pragma unroll
              for (int tt = 0; tt < 4; ++tt)
#pragma unroll
                  for (int ss = 0; ss < 2; ++ss) aa[tt][ss] = *(const LAS bf16x8*)(lds + L_A + (16 * tt + l15) * RS + ss * 64 + g4 * 16);
#pragma unroll
              for (int kt = 0; kt < NKT; ++kt) dlv[kt] = *(const LAS f32x4*)(lds + L_DL + (16 * kt + 4 * g4) * 4);
              __builtin_amdgcn_sched_barrier(0);
#pragma unroll
              for (int tt = 0; tt < 4; ++tt)
#pragma unroll
                  for (int ss = 0; ss < 2; ++ss) oacc[tt] = __builtin_amdgcn_mfma_f32_16x16x32_bf16(aa[tt][ss], vfr[ss], oacc[tt], 0, 0, 0);
#pragma unroll
              for (int kt = 0; kt < NKT; ++kt) S[kt] = S[kt] * dlv[kt];
            }
            __builtin_amdgcn_sched_barrier(0);
#pragma unroll
            for (int kh = 0; kh < NKT / 8; ++kh) {
                bf16x8 ak[8][2];
#pragma unroll
                for (int k8 = 0; k8 < 8; ++k8)
#pragma unroll
                    for (int ss = 0; ss < 2; ++ss) ak[k8][ss] = *(const LAS bf16x8*)(lds + L_KDT + (16 * (kh * 8 + k8) + l15) * RS + ss * 64 + g4 * 16);
                __builtin_amdgcn_sched_barrier(0);
#pragma unroll
                for (int k8 = 0; k8 < 8; ++k8)
#pragma unroll
                    for (int ss = 0; ss < 2; ++ss) S[kh * 8 + k8] = __builtin_amdgcn_mfma_f32_16x16x32_bf16(ak[k8][ss], vfr[ss], S[kh * 8 + k8], 0, 0, 0);
                __builtin_amdgcn_sched_barrier(0);
            }
#pragma unroll
            for (int tt = 0; tt < 4; ++tt)
#pragma unroll
                for (int r = 0; r < 4; ++r) { if (FUSE) OT[(16 * tt + 4 * g4 + r) * OTS + wave * 16 + l15] = oacc[tt][r]; else O[(size_t)(blk * 64 + 16 * tt + 4 * g4 + r) * D + col] = oacc[tt][r]; }
            }
            lds_barrier();
            if (ch + 1 < 32) S2_STORE(64, 1);
            if (FUSE) S2_OG_EPIP(blk, h, vq2);
            lds_barrier();
        }
        if (act) {
        float* so = SPo + ((size_t)(b * NH + h) * K) * VH + vq2 * 64 + wave * 16 + l15;
#pragma unroll
        for (int kt = 0; kt < NKT; ++kt)
#pragma unroll
            for (int r = 0; r < 4; ++r) __builtin_nontemporal_store(S[kt][r], so + (size_t)(16 * kt + 4 * g4 + r) * VH);
        }
    }
    constexpr int NTASK = 16 * NH * NVQ * 2;
    for (;;) {
        lds_barrier();
        if (tid == 0) qslot[0] = __hip_atomic_fetch_add(qhead, 1u, __ATOMIC_RELAXED, __HIP_MEMORY_SCOPE_AGENT);
        lds_barrier();
        const int task = (int)qslot[0];
        if (task >= NTASK) break;
        const int half = task & 1, vq = (task >> 1) % NVQ, h = (task / (2 * NVQ)) % NH, sblk = task / (2 * NVQ * NH), blk = 128 + sblk;
        const int col = h * VH + vq * 128 + wave * 16 + l15;
        S2_LOAD(blk, h, vq * 128, 128, 8); S2_STORE(128, 8);
        S2_G_LOAD(blk, h, 32 * half, 32);
        lds_barrier();
        const bf16x8 vfr0 = v_frag_tr1<272>(vtr_a128 + half * 32 * 272);
#pragma unroll 1
        for (int jj = 0; jj < 4; ++jj) {
            const int j = half * 4 + jj, bseq = sblk * 8 + j;
            const float* s0 = S0 + ((size_t)(bseq * NH + h) * K) * VH + vq * 128 + wave * 16 + l15;
#pragma unroll
            for (int kt = 0; kt < NKT; ++kt)
#pragma unroll
                for (int r = 0; r < 4; ++r) S[kt][r] = __builtin_nontemporal_load(s0 + (size_t)(16 * kt + 4 * g4 + r) * VH);
            const int arow = 8 * j + (l15 & 7);
            constexpr int BQ = 4, BK = (NKT > 8) ? 4 : 8;
            const bf16x8 aAs = *(const LAS bf16x8*)(lds + L_A + arow * RS + half * 64 + g4 * 16);
            f32x4 oacc = (f32x4){0.f, 0.f, 0.f, 0.f};
#pragma unroll
            for (int qb = 0; qb < NKS / BQ; ++qb) {
                bf16x8 aqs[BQ];
#pragma unroll
                for (int i = 0; i < BQ; ++i) aqs[i] = *(const LAS bf16x8*)(lds + L_QI + arow * QS + (qb * BQ + i) * 64 + g4 * 16);
                __builtin_amdgcn_sched_barrier(0);
#pragma unroll
                for (int i = 0; i < BQ; ++i) { const int ks = qb * BQ + i;
                    union { u32x4 u; bf16x8 v; } sb;
                    sb.u.x = cvt_pk_bf16(S[2 * ks][0], S[2 * ks][1]); sb.u.y = cvt_pk_bf16(S[2 * ks][2], S[2 * ks][3]);
                    sb.u.z = cvt_pk_bf16(S[2 * ks + 1][0], S[2 * ks + 1][1]); sb.u.w = cvt_pk_bf16(S[2 * ks + 1][2], S[2 * ks + 1][3]);
                    oacc = __builtin_amdgcn_mfma_f32_16x16x32_bf16(aqs[i], sb.v, oacc, 0, 0, 0); }
                __builtin_amdgcn_sched_barrier(0);
            }
            oacc = __builtin_amdgcn_mfma_f32_16x16x32_bf16(aAs, vfr0, oacc, 0, 0, 0);
#pragma unroll
            for (int kh = 0; kh < NKT / BK; ++kh) {
                u32x4 akd[BK]; f32x4 dls[BK];
#pragma unroll
                for (int k8 = 0; k8 < BK; ++k8) { akd[k8] = *(const LAS u32x4*)(lds + L_KDT + (16 * (kh * BK + k8) + l15) * RS + half * 64 + g4 * 16);
                    dls[k8] = *(const LAS f32x4*)(lds + L_DL + j * K * 4 + (16 * (kh * BK + k8) + 4 * g4) * 4); }
                __builtin_amdgcn_sched_barrier(0);
#pragma unroll
                for (int k8 = 0; k8 < BK; ++k8) { const int kt = kh * BK + k8;
                    S[kt] = S[kt] * dls[k8];
                    union { u32x4 u; bf16x8 v; } af; af.u = akd[k8];
                    if (g4 != jj) af.u = (u32x4){0u, 0u, 0u, 0u};
                    S[kt] = __builtin_amdgcn_mfma_f32_16x16x32_bf16(af.v, vfr0, S[kt], 0, 0, 0); }
                __builtin_amdgcn_sched_barrier(0);
            }
            if (g4 < 2) {
#pragma unroll
                for (int r = 0; r < 4; ++r) { if (FUSE) OT[(8 * j + 4 * g4 + r) * OTS + wave * 16 + l15] = oacc[r]; else O[(size_t)(blk * 64 + 8 * j + 4 * g4 + r) * D + col] = oacc[r]; }
            }
            float* so = SSo + ((size_t)(bseq * NH + h) * K) * VH + vq * 128 + wave * 16 + l15;
#pragma unroll
            for (int kt = 0; kt < NKT; ++kt)
#pragma unroll
                for (int r = 0; r < 4; ++r) __builtin_nontemporal_store(S[kt][r], so + (size_t)(16 * kt + 4 * g4 + r) * VH);
        }
        if (FUSE) { lds_barrier(); S2_OG_EPI(blk, h, 32 * half, 32); }
    }
#undef S2_OG_EPI
#undef S2_OG_EPIP
#undef S2_G_LOADP
#undef S2_G_LOAD
#undef S2_LOAD
#undef S2_STORE
}

template <int NR>
__device__ __forceinline__ void pool_segment(const float* X, int row0, int tabs0  , const float* hsrc, const LAS float* rs  ,
                                             const f32x4 gain, int w, bool is_prompt, bf16_t* Y, float* pstate  , float* sstate  , int c0) {
    f32x4 ring[16]; f32x4 wsum = (f32x4){0.f, 0.f, 0.f, 0.f};
#pragma unroll
    for (int i = 0; i < 16; ++i) ring[i] = (f32x4){0.f, 0.f, 0.f, 0.f};
#pragma unroll
    for (int i = 0; i < 15 + NR; ++i) {
        f32x4 val;
        if (i < 15) {
            if (hsrc) val = *(const f32x4*)(hsrc + (size_t)i * D + c0);
            else { const int t = tabs0 - 15 + i; val = (t >= 0) ? *(const f32x4*)(X + (size_t)(row0 - 15 + i) * D + c0) * rs[i] * gain : (f32x4){0.f, 0.f, 0.f, 0.f}; }
        } else val = *(const f32x4*)(X + (size_t)(row0 + i - 15) * D + c0) * rs[i] * gain;
        const f32x4 old = (w == 2) ? ring[(i - 2) & 15] : (w == 4) ? ring[(i - 4) & 15] : (w == 8) ? ring[(i - 8) & 15] : ring[i & 15];
        wsum = wsum + val - old;
        ring[i & 15] = val;
        if (i >= 15) {
            const int t = i - 15;
            float cnt = (float)w; if (is_prompt) { const int have = tabs0 + t + 1; cnt = (float)(have < w ? have : w); }
            const float ic = 1.f / cnt;
            const f32x4 y = wsum * ic - val;
            u32x2 o; o.x = pk2(y.x, y.y); o.y = pk2(y.z, y.w);
            *(u32x2*)(Y + (size_t)(row0 + t) * D + c0) = o;
            if (is_prompt) { if (pstate) { const int tt = tabs0 + t - (PT - POOLBUF); if (tt >= 0) *(f32x4*)(pstate + (size_t)tt * D + c0) = val; } }
            else *(f32x4*)(sstate + (size_t)(7 + t) * D + c0) = val;
        }
    }
    if (!is_prompt) {
#pragma unroll
        for (int i = 0; i < 7; ++i) *(f32x4*)(sstate + (size_t)i * D + c0) = *(const f32x4*)(hsrc + (size_t)(8 + i) * D + c0);
    }
}
__device__ __forceinline__ void pool_pre_phase(CParams* P, LAS unsigned char* lds, float* X, const float* gain, bf16_t* Y, int tid, int wave, int lane, int G) {
    LAS float* rs = (LAS float*)lds;
    const int c0 = tid * 4, w = 2 << (c0 >> 9);
    const f32x4 g4 = *(const f32x4*)(gain + c0);
    for (int u = blockIdx.x; u < M / 32; u += G) {
        const int r0 = u * 32; const bool is_prompt = r0 < MP;
        lds_barrier();
        for (int i = wave; i < 47; i += NWAVES) {
            const int row = r0 - 15 + i;
            const bool need = is_prompt ? ((r0 % PT) - 15 + i >= 0) : (i >= 15);
            float r = 0.f;
            if (need) { const f32x4* xr = (const f32x4*)(X + (size_t)row * D) + lane; float s = 0.f; f32x4 v[8];
#pragma unroll
                for (int j = 0; j < 8; ++j) v[j] = xr[64 * j];
#pragma unroll
                for (int j = 0; j < 8; ++j) s += (v[j].x * v[j].x + v[j].y * v[j].y) + (v[j].z * v[j].z + v[j].w * v[j].w);
                r = __builtin_amdgcn_rsqf(wave_sum(s) * (1.f / D) + EPS); }
            if (lane == 0) rs[i] = r;
        }
        lds_barrier();
        if (is_prompt) {
            const int b = r0 / PT, t0 = r0 % PT;
            float* pst = (t0 + 32 == PT) ? P->out + OUT_POOL_P + (size_t)b * POOLBUF * D : nullptr;
            pool_segment<32>(X, r0, t0, nullptr, rs, g4, w, true, Y, pst, nullptr, c0);
        } else {
            for (int sgi = 0; sgi < 4; ++sgi) {
                const int b = (r0 - MP) / ST + sgi;
                pool_segment<8>(X, r0 + sgi * 8, 0, P->in[I_SPOOL] + (size_t)b * POOLBUF * D, rs + sgi * 8, g4, w, false, Y, nullptr, P->out + OUT_POOL_S + (size_t)b * POOLBUF * D, c0);
            }
        }
    }
}

constexpr int NPHASE = 51;
__host__ __device__ inline bool phase_exists(int ph) { if (ph == 0 || ph == NPHASE - 1) return true; const int li = (ph - 1) / 12, k = (ph - 1) % 12, kind = li % 3;
    if (k == 0) return li > 0;
    if (li >= NLAYER) return false;
    if (k == 5 || k == 6) return kind != 2;
    if (k == 7) return kind == 1;
    return true; }

__device__ __forceinline__ CParams* fresh_params() { CParams* p = (CParams*)__builtin_amdgcn_kernarg_segment_ptr(); asm volatile("" : "+s"(p)); return p; }
__device__ __forceinline__ int fresh_tid(int wave0) { int l = __builtin_amdgcn_mbcnt_hi(~0u, __builtin_amdgcn_mbcnt_lo(~0u, 0u)); asm volatile("" : "+v"(l)); return wave0 * 64 + l; }
#define SITE_BEGIN CParams* pp = fresh_params(); unsigned char* ws = pp->ws; const int tid = fresh_tid(wave0), lane = tid & 63, wave = __builtin_amdgcn_readfirstlane(tid >> 6), G = gridDim.x, bx = blockIdx.x, gw = bx * NWAVES + wave, NGW = G * NWAVES, vbx = __builtin_amdgcn_readfirstlane((int)((volatile LAS unsigned*)(lds + MISC_OFF))[20]); \
    (void)vbx; (void)ws; (void)lane; (void)wave; (void)gw; (void)NGW; (void)tid; (void)G; (void)bx;
#define WSP(T, off) ((T*)(ws + (off)))

__global__ void __launch_bounds__(NTHREADS, 2) mega_fwd(Params P) {
    extern __shared__ __attribute__((aligned(16))) unsigned char lds_raw[];
    LAS unsigned char* lds = (LAS unsigned char*)lds_raw;
    volatile LAS unsigned* MISC = (volatile LAS unsigned*)(lds + MISC_OFF);
    const int wave0 = __builtin_amdgcn_readfirstlane(threadIdx.x >> 6);
    for (int u = threadIdx.x; u < (LDS_BYTES - LDSCTL_OFF) / 4; u += NTHREADS) ((LAS unsigned*)(lds + LDSCTL_OFF))[u] = 0u;
    __syncthreads();
    if (threadIdx.x == 0) { const unsigned x = xb_xcc_id() & 7u; const unsigned rk = __hip_atomic_fetch_add((unsigned*)(P.ws + WS_CTL) + CW_XRANK + 64 * x, 1u, __ATOMIC_RELAXED, __HIP_MEMORY_SCOPE_AGENT);
        ((volatile LAS unsigned*)(lds + MISC_OFF))[20] = rk < 32u ? rk * 8u + x : blockIdx.x; }
    __syncthreads();
    const int lo = P.ph_lo, hi = P.ph_hi;
    XcdBarrier bar; bar.bar = (unsigned*)(P.ws + WS_CTL) + CW_BAR; bar.x = 0; bar.st = nullptr;
    if (hi - lo > 1) bar = xcd_barrier_post((unsigned*)(P.ws + WS_CTL) + CW_BAR, MISC + 8);
    unsigned long long probe_acc = 0ull, probe_t0 = 0ull; (void)probe_acc; (void)probe_t0;
#define IN(k) ((probe_t0 = (PROBE_MASK != 0 && (((k) > 0 && (k) < NPHASE - 1 && ((PROBE_MASK >> (((k) - 1) % 12)) & 1)) || ((k) == 0 && ((PROBE_MASK >> 12) & 1)))) ? __builtin_amdgcn_s_memrealtime() : 0ull), (lo <= (k) && (k) < hi))
#define SEAM(k) do { if ((k) + 1 < hi) xcd_barrier(bar, fresh_tid(wave0) == 0); if (PROBE_MASK != 0 && probe_t0 != 0ull) { probe_acc += __builtin_amdgcn_s_memrealtime() - probe_t0; probe_t0 = 0ull; } } while (0)

    if (IN(0)) { for (int rep = 0; rep < REP_PRO; ++rep) { { SITE_BEGIN prologue_phase(pp, lds, gw, NGW, wave, lane); } SEAM(0); } }

#pragma unroll 1
    for (int li = 0; li < NLAYER; ++li) {
        const int pb = 1 + li * 12, kind = li % 3, j = li / 3;
#pragma unroll 1
        for (int which = 0; which < 2; ++which) {
            const int p0 = pb + (which ? 9 : 0), s = li * 2 + which;
            if (IN(p0 + 1)) {
#pragma unroll 1
                for (int rep = 0; rep < REP_GU; ++rep) {
                { SITE_BEGIN
                pg8::Gemm g{WSP(bf16_t, WS_XN), (const bf16_t*)(ws + WS_WGU + (size_t)s * SZ_WGU1), D, D, D, M / 256, 2 * FF / 256, 0};
                pg8::TailSplitOrder<M / 256, 2 * FF / 256, D / 64, 256> S; S.init(vbx);
                EpiGU E{WSP(bf16_t, WS_H), WSP(const float, WS_R), WSP(float, WS_PART), WSP(unsigned, WS_CTL) + CW_GUFLAG + 64 * s};
                pg8::gemm_phase(lds, g, S, E, tid); }
                SEAM(p0 + 1); }
            }
            if (IN(p0 + 2)) {
                { SITE_BEGIN
                pg8::Gemm g{WSP(bf16_t, WS_H), (const bf16_t*)(ws + WS_WDN + (size_t)s * SZ_WDN1), FF, FF, FF, M / 256, D / 256, 0};
                pg8::ResOrder S; S.init(vbx, g.K / 64);
                EpiRes<0, 1> E{WSP(float, WS_X), WSP(bf16_t, WS_XN), WSP(float, WS_SS), nullptr, nullptr, WSP(float, WS_PART)};
                pg8::gemm_phase(lds, g, S, E, tid); }
                SEAM(p0 + 2);
            }
            if (!(li == NLAYER - 1 && which == 1)   && IN(p0 + 3)) { { SITE_BEGIN fix_phase<0, 1>(WSP(float, WS_X), WSP(bf16_t, WS_XN), WSP(float, WS_SS), WSP(float, WS_R), WSP(const float, WS_PART), 8, nullptr, nullptr, lds, bx, wave, gw, NGW, lane); } SEAM(p0 + 3); }
            if (which == 1) continue;
            if (kind == 0) {
                if (IN(pb + 4)) {
                    { SITE_BEGIN
                    pg8::Gemm g{WSP(bf16_t, WS_XN), WSP(const bf16_t, WS_WHIN) + (size_t)j * 8192 * D, D, D, D, M / 256, 8192 / 256, 0};
                    pg8::StaticOrder S; S.init(g.nM, g.nN, G, vbx, g.K / 64);
                    EpiHG E{WSP(bf16_t, WS_Q), WSP(bf16_t, WS_KK), WSP(bf16_t, WS_V), WSP(bf16_t, WS_G), WSP(float, WS_LF), WSP(const float, WS_TAB) + (size_t)j * D, WSP(const float, WS_SS)};
                    pg8::gemm_phase(lds, g, S, E, tid); }
                    SEAM(pb + 4);
                }
#pragma unroll 1
                for (int rep = 0; rep < REP_SCAN; ++rep) {
                if (IN(pb + 5)) {
                    { SITE_BEGIN
                    scan_s1<HG_K, HG_V, HG_H>(WSP(bf16_t, WS_Q), WSP(bf16_t, WS_KK), WSP(float, WS_LF), WSP(bf16_t, WS_V), WSP(bf16_t, WS_QI), WSP(bf16_t, WS_KDT), WSP(bf16_t, WS_AM), WSP(bf16_t, WS_VT), WSP(float, WS_DL), lds, tid, G, bx); }
                    SEAM(pb + 5);
                }
                if (IN(pb + 6)) {
                    { SITE_BEGIN
                    scan_s2<HG_K, HG_V, HG_H, true>(WSP(bf16_t, WS_QI), WSP(bf16_t, WS_KDT), WSP(bf16_t, WS_AM), WSP(bf16_t, WS_V), WSP(float, WS_DL), pp->in[I_SHG] + (size_t)j * SB * HG_H * HG_K * HG_V,
                        pp->out + OUT_HG_P + (size_t)j * PB * HG_H * HG_K * HG_V, pp->out + OUT_HG_S + (size_t)j * SB * HG_H * HG_K * HG_V, nullptr,
                        WSP(const bf16_t, WS_G), WSP(bf16_t, WS_OG), WSP(float, WS_SSO), lds, WSP(unsigned, WS_CTL) + CW_QUEUE + 64 * li + 16 * rep, tid, G, bx); }
                    SEAM(pb + 6);
                }
                }
                if (IN(pb + 8)) {
                    { SITE_BEGIN
                    pg8::Gemm g{WSP(bf16_t, WS_OG), WSP(const bf16_t, WS_WHOUT) + (size_t)j * D * D, D, D, D, M / 256, D / 256, 0};
                    pg8::ResOrder S; S.init(vbx, g.K / 64);
                    EpiRes<32, 0> E{WSP(float, WS_X), WSP(bf16_t, WS_XN), WSP(float, WS_SS), nullptr, WSP(const float, WS_SSO), WSP(float, WS_PART)};
                    pg8::gemm_phase(lds, g, S, E, tid); }
                    SEAM(pb + 8);
                }
                if (IN(pb + 9)) { { SITE_BEGIN fix_phase<32, 0>(WSP(float, WS_X), WSP(bf16_t, WS_XN), WSP(float, WS_SS), WSP(float, WS_R), WSP(const float, WS_PART), 8, nullptr, WSP(const float, WS_SSO), lds, bx, wave, gw, NGW, lane); } SEAM(pb + 9); }
            } else if (kind == 1) {
                if (IN(pb + 4)) {
                    { SITE_BEGIN
                    pg8::Gemm g{WSP(bf16_t, WS_XN), WSP(const bf16_t, WS_WGIN), D, D, D, M / 256, GL_NIN / 256, 0};
                    pg8::StaticOrder S; S.init(g.nM, g.nN, G, vbx, g.K / 64);
                    EpiGLA E{WSP(bf16_t, WS_Q), WSP(bf16_t, WS_KK), WSP(bf16_t, WS_V), WSP(bf16_t, WS_G), WSP(float, WS_LF), pp->in[I_GBG] + (size_t)j * GL_DK, WSP(const float, WS_SS)};
                    pg8::gemm_phase(lds, g, S, E, tid); }
                    SEAM(pb + 4);
                }
#pragma unroll 1
                for (int rep = 0; rep < REP_SCAN; ++rep) {
                if (IN(pb + 5)) {
                    { SITE_BEGIN
                    scan_s1<GL_K, GL_V, GL_H>(WSP(bf16_t, WS_Q), WSP(bf16_t, WS_KK), WSP(float, WS_LF), WSP(bf16_t, WS_V), WSP(bf16_t, WS_QI), WSP(bf16_t, WS_KDT), WSP(bf16_t, WS_AM), WSP(bf16_t, WS_VT), WSP(float, WS_DL), lds, tid, G, bx); }
                    SEAM(pb + 5);
                }
                if (IN(pb + 6)) {
                    { SITE_BEGIN
                    scan_s2_old<GL_K, GL_V, GL_H, false>(WSP(bf16_t, WS_QI), WSP(bf16_t, WS_KDT), WSP(bf16_t, WS_AM), WSP(bf16_t, WS_V), WSP(float, WS_DL), pp->in[I_SGLA] + (size_t)j * SB * GL_H * GL_K * GL_V,
                        pp->out + OUT_GLA_P + (size_t)j * PB * GL_H * GL_K * GL_V, pp->out + OUT_GLA_S + (size_t)j * SB * GL_H * GL_K * GL_V, WSP(float, WS_O),
                        nullptr, nullptr, nullptr, lds, WSP(unsigned, WS_CTL) + CW_QUEUE + 64 * li + 16 * rep, tid, G, bx); }
                    SEAM(pb + 6);
                }
                if (IN(pb + 7)) { { SITE_BEGIN post_phase<4>(WSP(const bf16_t, WS_O), pp->in[I_GON] + (size_t)j * D, WSP(bf16_t, WS_G), WSP(bf16_t, WS_OG), gw, NGW, lane); } SEAM(pb + 7); }
                }
                if (IN(pb + 8)) {
                    { SITE_BEGIN
                    pg8::Gemm g{WSP(bf16_t, WS_OG), WSP(const bf16_t, WS_WGOUT), D, D, D, M / 256, D / 256, 0};
                    pg8::ResOrder S; S.init(vbx, g.K / 64);
                    EpiRes<0, 0> E{WSP(float, WS_X), WSP(bf16_t, WS_XN), WSP(float, WS_SS), nullptr, nullptr, WSP(float, WS_PART)};
                    pg8::gemm_phase(lds, g, S, E, tid); }
                    SEAM(pb + 8);
                }
                if (IN(pb + 9)) { { SITE_BEGIN fix_phase<0, 0>(WSP(float, WS_X), WSP(bf16_t, WS_XN), WSP(float, WS_SS), WSP(float, WS_R), WSP(const float, WS_PART), 8, nullptr, nullptr, lds, bx, wave, gw, NGW, lane); } SEAM(pb + 9); }
            } else {
                if (IN(pb + 4)) { { SITE_BEGIN pool_pre_phase(pp, lds, WSP(float, WS_X), pp->in[I_NMIX] + (size_t)li * D, WSP(bf16_t, WS_OG), tid, wave, lane, G); } SEAM(pb + 7); }
                if (IN(pb + 8)) {
                    { SITE_BEGIN
                    pg8::Gemm g{WSP(bf16_t, WS_OG), WSP(const bf16_t, WS_WPOOL), D, 512, 512, M / 256, D / 256, 1};
                    pg8::ResOrder S; S.init(vbx, g.K / 64);
                    EpiRes<0, 0> E{WSP(float, WS_X), WSP(bf16_t, WS_XN), WSP(float, WS_SS), pp->in[I_PSC] + (size_t)j * D, nullptr, WSP(float, WS_PART)};
                    pg8::gemm_phase(lds, g, S, E, tid); }
                    SEAM(pb + 8);
                }
                if (IN(pb + 9)) { { SITE_BEGIN fix_phase<0, 0>(WSP(float, WS_X), WSP(bf16_t, WS_XN), WSP(float, WS_SS), WSP(float, WS_R), WSP(const float, WS_PART), 4, pp->in[I_PSC] + (size_t)j * D, nullptr, lds, bx, wave, gw, NGW, lane); } SEAM(pb + 9); }
            }
        }
    }
    if (IN(NPHASE - 1)) { SITE_BEGIN final_phase(WSP(const float, WS_X), pp->in[I_FN], pp->out + OUT_Y, WSP(const float, WS_PART), gw, NGW, lane); }
    if (PROBE_MASK != 0 && blockIdx.x == 0) { const unsigned long long t1 = __builtin_amdgcn_s_memrealtime(); while (__builtin_amdgcn_s_memrealtime() - t1 < (unsigned long long)PROBE_MUL * probe_acc) __builtin_amdgcn_s_sleep(16); }
#undef IN
#undef SEAM
}

extern "C" void kernel_launch(void* const* d_in, const int* in_sizes, int n_in, void* d_out, int out_size, void* d_ws, size_t ws_size, hipStream_t stream) {
    static int grid = 0;
    if (grid == 0) {
        if (n_in != 26 || (size_t)out_size != OUT_TOTAL || ws_size < WS_END) { fprintf(stderr, "kernel_launch: unexpected sizes n_in %d out %d ws %zu (need %zu)\n", n_in, out_size, ws_size, (size_t)WS_END); grid = -1; return; }
        int dev = 0, cus = 0, per_cu = 0;
        if (hipGetDevice(&dev) != hipSuccess || hipDeviceGetAttribute(&cus, hipDeviceAttributeMultiprocessorCount, dev) != hipSuccess) { grid = -1; return; }
        if (hipFuncSetAttribute((const void*)mega_fwd, hipFuncAttributeMaxDynamicSharedMemorySize, LDS_BYTES) != hipSuccess) { fprintf(stderr, "kernel_launch: hipFuncSetAttribute failed\n"); grid = -1; return; }
        if (hipOccupancyMaxActiveBlocksPerMultiprocessor(&per_cu, (const void*)mega_fwd, NTHREADS, LDS_BYTES) != hipSuccess || per_cu < 1) fprintf(stderr, "kernel_launch: occupancy query reports %d\n", per_cu);
        (void)hipGetLastError();
        grid = cus;
        if (grid != 256) { fprintf(stderr, "kernel_launch: built for 256 CUs (got %d)\n", cus); grid = -1; return; }
    }
    if (grid < 0) return;
    if (hipMemsetAsync((char*)d_ws + WS_CTL, 0, CTL_ZERO_BYTES, stream) != hipSuccess) return;
    Params p{};
    for (int i = 0; i < 26; ++i) p.in[i] = (const float*)d_in[i];
    p.out = (float*)d_out; p.ws = (unsigned char*)d_ws;
#if MK_PER_PHASE_LAUNCH
    for (int ph = 0; ph < NPHASE; ++ph) {
        if (!phase_exists(ph)) continue;
        p.ph_lo = ph; p.ph_hi = ph + 1;
        hipLaunchKernelGGL(mega_fwd, dim3(grid), dim3(NTHREADS), LDS_BYTES, stream, p);
    }
#else
    p.ph_lo = 0; p.ph_hi = NPHASE;
    hipLaunchKernelGGL(mega_fwd, dim3(grid), dim3(NTHREADS), LDS_BYTES, stream, p);
#endif
    (void)in_sizes;
}
```

```cpp
#include <hip/hip_runtime.h>
#include <cstdio>
#include <cstdint>

#ifndef USE_SIMPLE_SCAN
#define USE_SIMPLE_SCAN 0
#endif
#ifndef REP_PRO
#define REP_PRO 1
#endif
#ifndef REP_GU
#define REP_GU 1
#endif
#ifndef REP_SCAN
#define REP_SCAN 1
#endif
#ifndef REP_NORM
#define REP_NORM 1
#endif
#ifndef PROBE_MASK
#define PROBE_MASK 0
#endif
#ifndef PROBE_MUL
#define PROBE_MUL 4
#endif
#ifndef MK_PER_PHASE_LAUNCH
#define MK_PER_PHASE_LAUNCH 0
#endif

#define LAS __attribute__((address_space(3)))
#define GAS __attribute__((address_space(1)))
typedef unsigned short bf16_t;
typedef short bf16x8 __attribute__((ext_vector_type(8)));
typedef float f32x4 __attribute__((ext_vector_type(4)));
typedef float f32x2 __attribute__((ext_vector_type(2)));
typedef unsigned u32x4 __attribute__((ext_vector_type(4)));
typedef unsigned u32x2 __attribute__((ext_vector_type(2)));

constexpr int D = 2048, FF = 5632, NLAYER = 4;
constexpr int PB = 4, PT = 2048, SB = 128, ST = 8;
constexpr int MP = PB * PT, MS = SB * ST, M = MP + MS;
constexpr int HG_H = 16, HG_K = 128, HG_V = 128;
constexpr int GL_H = 4, GL_K = 256, GL_V = 512, GL_DK = 1024, GL_NIN = 7168, GL_WIN_LD = 6160;
constexpr int POOLBUF = 15;
constexpr float EPS = 1e-6f;
constexpr int NWAVES = 8, NTHREADS = 512;

constexpr size_t OUT_Y = 0;
constexpr size_t OUT_HG_P = (size_t)M * D;
constexpr size_t OUT_GLA_P = OUT_HG_P + (size_t)2 * PB * HG_H * HG_K * HG_V;
constexpr size_t OUT_POOL_P = OUT_GLA_P + (size_t)PB * GL_H * GL_K * GL_V;
constexpr size_t OUT_HG_S = OUT_POOL_P + (size_t)PB * POOLBUF * D;
constexpr size_t OUT_GLA_S = OUT_HG_S + (size_t)2 * SB * HG_H * HG_K * HG_V;
constexpr size_t OUT_POOL_S = OUT_GLA_S + (size_t)SB * GL_H * GL_K * GL_V;
constexpr size_t OUT_TOTAL = OUT_POOL_S + (size_t)SB * POOLBUF * D;
static_assert(OUT_TOTAL == 161341440ull, "output size");

constexpr size_t MiB = 1u << 20;
constexpr size_t al(size_t x) { return (x + MiB - 1) / MiB * MiB; }
constexpr size_t WS_CTL = 0, CTL_ZERO_BYTES = 128 * 1024;
constexpr size_t WS_TAB = 1 * MiB;
constexpr size_t SZ_WGU1 = (size_t)2 * FF * D * 2, SZ_WDN1 = (size_t)D * FF * 2;
constexpr size_t WS_WGU = 2 * MiB;
constexpr size_t WS_WDN = WS_WGU + al(8 * SZ_WGU1);
constexpr size_t WS_WHIN = WS_WDN + al(8 * SZ_WDN1);
constexpr size_t WS_WHOUT = WS_WHIN + al((size_t)2 * 8192 * D * 2);
constexpr size_t WS_WGIN = WS_WHOUT + al((size_t)2 * D * D * 2);
constexpr size_t WS_WGOUT = WS_WGIN + al((size_t)GL_NIN * D * 2);
constexpr size_t WS_WPOOL = WS_WGOUT + al((size_t)D * D * 2);
constexpr size_t WS_X = WS_WPOOL + al((size_t)D * 512 * 2);
constexpr size_t WS_XN = WS_X + al((size_t)M * D * 4);
constexpr size_t WS_H = WS_XN + al((size_t)M * D * 2);
constexpr size_t WS_Q = WS_H + al((size_t)M * FF * 2);
constexpr size_t WS_KK = WS_Q + al((size_t)M * D * 2);
constexpr size_t WS_V = WS_KK + al((size_t)M * D * 2);
constexpr size_t WS_G = WS_V + al((size_t)M * D * 2);
constexpr size_t WS_LF = WS_G + al((size_t)M * D * 2);
constexpr size_t WS_O = WS_LF + al((size_t)M * D * 4);
constexpr size_t WS_VT = WS_O + al((size_t)M * D * 4);
constexpr size_t WS_DL = WS_VT + al((size_t)M * D * 2);
constexpr size_t WS_PART = WS_DL + al((size_t)256 * D * 4);
constexpr size_t WS_OG = WS_PART + al((size_t)8 * MS * D * 4);
constexpr size_t WS_SS = WS_OG + al((size_t)M * D * 2);
constexpr size_t WS_SSO = WS_SS + al((size_t)M * 32 * 4);
constexpr size_t WS_R = WS_SSO + al((size_t)M * 32 * 4);
constexpr size_t WS_END = WS_R + al((size_t)M * 4);
constexpr size_t WS_QI = WS_H, WS_KDT = WS_QI + al((size_t)M * D * 2), WS_AM = WS_KDT + al((size_t)M * D * 2);
static_assert(WS_AM + (size_t)144 * 16 * 64 * 64 * 2 <= WS_Q, "scan overlay fits in H");

constexpr int CW_XRANK = 3072  , CW_BAR = 4096, CW_QUEUE = 8192, CW_GUFLAG = 16384  ;

constexpr int RING_BYTES = 131072, LDSCTL_OFF = RING_BYTES, MISC_OFF = LDSCTL_OFF + 320, LDS_BYTES = 147456;

__device__ __forceinline__ unsigned f2bf(float f) { unsigned u = __builtin_bit_cast(unsigned, f); return (u + 0x7fffu + ((u >> 16) & 1u)) >> 16; }
typedef _Float16 f16x2_t __attribute__((ext_vector_type(2)));
__device__ __forceinline__ unsigned pkh2(float lo, float hi) { f16x2_t h; h.x = (_Float16)lo; h.y = (_Float16)hi; return __builtin_bit_cast(unsigned, h); }
__device__ __forceinline__ float hlo(unsigned w) { return (float)__builtin_bit_cast(f16x2_t, w).x; }
__device__ __forceinline__ float hhi(unsigned w) { return (float)__builtin_bit_cast(f16x2_t, w).y; }
__device__ __forceinline__ unsigned pk2(float lo, float hi) { unsigned r; asm("v_cvt_pk_bf16_f32 %0, %1, %2" : "=v"(r) : "v"(lo), "v"(hi)); return r; }
__device__ __forceinline__ float bf2f(unsigned short b) { return __builtin_bit_cast(float, ((unsigned)b) << 16); }
__device__ __forceinline__ float bflo(unsigned w) { return __builtin_bit_cast(float, w << 16); }
__device__ __forceinline__ float bfhi(unsigned w) { return __builtin_bit_cast(float, w & 0xffff0000u); }
__device__ __forceinline__ void lds_barrier() { asm volatile("s_waitcnt lgkmcnt(0)" ::: "memory"); __builtin_amdgcn_s_barrier(); asm volatile("" ::: "memory"); }

__device__ __forceinline__ float wave_sum(float v) {
#pragma unroll
    for (int o = 1; o < 64; o <<= 1) v += __shfl_xor(v, o);
    return v;
}
__device__ __forceinline__ float fsigmoid(float x) { return __builtin_amdgcn_rcpf(1.f + __expf(-x)); }
__device__ __forceinline__ float fsilu(float x) { return x * fsigmoid(x); }
#define LDS_WAIT() asm volatile("s_waitcnt lgkmcnt(0)" ::: "memory")

#define XB_TMO      128
#define XB_XCNT(j)  (256  + 64 * (j))
#define XB_XSUB(j)  (1280 + 64 * (j))
#define XB_XGEN(j)  (2304 + 64 * (j))
#define XB_TOP      3328
#define XB_TOPGEN   3392
#define XCD_BAR_WORDS 3456
#define XB_SPIN_CAP (1u << 22)

__device__ __forceinline__ unsigned xb_ld(unsigned* p)              { return __hip_atomic_load(p, __ATOMIC_RELAXED, __HIP_MEMORY_SCOPE_AGENT); }
__device__ __forceinline__ unsigned xb_add(unsigned* p, unsigned v) { return __hip_atomic_fetch_add(p, v, __ATOMIC_RELAXED, __HIP_MEMORY_SCOPE_AGENT); }
__device__ __forceinline__ unsigned xb_xcc_id() { return (unsigned)__builtin_amdgcn_s_getreg((3 << 11) | 20) & 0xFu; }
#define XB_SPIN(cond, bar) do { unsigned _sp = 0; while (cond) { __builtin_amdgcn_s_sleep(1); \
    if ((++_sp & 255u) == 0u) { if (xb_ld(&(bar)[XB_TMO])) break; if (_sp > XB_SPIN_CAP) { atomicAdd(&(bar)[XB_TMO], 1u); break; } } } } while (0)

struct XcdBarrier { unsigned* bar; unsigned x; volatile LAS unsigned* st; };

__device__ __forceinline__ XcdBarrier xcd_barrier_post(unsigned* bar, volatile LAS unsigned* st) {
    XcdBarrier b; b.bar = bar; b.x = xb_xcc_id(); b.st = st;
    if (threadIdx.x == 0) (void)xb_add(&bar[XB_XCNT(b.x)], 1u);
    return b;
}
__device__ __forceinline__ void xcd_barrier_complete(unsigned* bar, unsigned x, unsigned& nloc, unsigned& nx) {
    const unsigned G = gridDim.x * gridDim.y * gridDim.z;
    unsigned sum, cnt, mine, sp = 0u;
    for (;;) {
        sum = 0u; cnt = 0u; mine = 0u;
#pragma unroll
        for (unsigned j = 0; j < 16; ++j) { const unsigned c = xb_ld(&bar[XB_XCNT(j)]); sum += c; cnt += (c > 0u) ? 1u : 0u; mine = (j == x) ? c : mine; }
        if (sum == G) break;
        __builtin_amdgcn_s_sleep(1);
        if ((++sp & 255u) == 0u) { if (xb_ld(&bar[XB_TMO])) break; if (sp > XB_SPIN_CAP) { atomicAdd(&bar[XB_TMO], 1u); break; } }
    }
    nloc = mine > 0u ? mine : 1u; nx = cnt > 0u ? cnt : 1u;
}
__device__ __forceinline__ void xcd_barrier(const XcdBarrier& b, const bool leader  ) {
    asm volatile("s_waitcnt vmcnt(0)" ::: "memory");
    __syncthreads();
    if (leader) {
        unsigned* bar = b.bar;
        __builtin_amdgcn_s_waitcnt(0);
        unsigned nloc = b.st[0], nx = b.st[1];
        if (nloc == 0u) { xcd_barrier_complete(bar, b.x, nloc, nx); b.st[0] = nloc; b.st[1] = nx; }
        const unsigned old = xb_add(&bar[XB_XSUB(b.x)], 1u);
        const unsigned gen = old / nloc;
        if (old + 1u == (gen + 1u) * nloc) {
            __builtin_amdgcn_fence(__ATOMIC_RELEASE, "agent");
            asm volatile("s_waitcnt vmcnt(0)" ::: "memory");
            const unsigned og = xb_add(&bar[XB_TOP], 1u);
            const unsigned tg = og / nx;
            if (og + 1u == (tg + 1u) * nx) xb_add(&bar[XB_TOPGEN], 1u);
            else XB_SPIN(xb_ld(&bar[XB_TOPGEN]) == tg, bar);
            __builtin_amdgcn_fence(__ATOMIC_ACQUIRE, "agent");
            xb_add(&bar[XB_XGEN(b.x)], 1u);
            asm volatile("s_waitcnt vmcnt(0)" ::: "memory");
        } else {
            XB_SPIN(xb_ld(&bar[XB_XGEN(b.x)]) == gen, bar);
            __builtin_amdgcn_fence(__ATOMIC_ACQUIRE, "agent");
            asm volatile("s_waitcnt vmcnt(0)" ::: "memory");
        }
    }
    __syncthreads();
}

namespace pg8 {
constexpr int BM = 256, BK = 64, HALF = 128, HTB = HALF * BK * 2, STAGE_BYTES = 8 * HTB, NXCD = 8, WGM = 8;
__host__ __device__ __forceinline__ int lds_byte(int r, int c) { const int st = (r >> 4) * 2 + (c >> 5), rr = r & 15, cc = c & 31, ob = rr * 64 + cc * 2; return st * 1024 + (ob ^ (((ob >> 9) & 1) << 5)); }
__host__ __device__ __forceinline__ void stage_rc(int b, int& R, int& C) { const int st = b / 1024, sb = b % 1024, swz = sb ^ (((sb >> 9) & 1) << 5); R = (st >> 1) * 16 + swz / 64; C = (st & 1) * 32 + (swz % 64) / 2; }
__host__ __device__ __forceinline__ int perm32(int rho) { const int n = rho >> 4, i = rho & 15; return 8 * (i >> 2) + 4 * n + (i & 3); }

struct Unit { int pm, pn, kt0, nt, split; };
struct Gemm { const bf16_t* A; const bf16_t* Bt; int lda, ldb, K, nM, nN, grp; };

struct StaticOrder {
    int nM, nN, nwg, G, c, ntk;
    __device__ void init(int nM_, int nN_, int G_, int c_, int ntk_) { nM = nM_; nN = nN_; nwg = nM * nN; G = G_; c = c_; ntk = ntk_; }
    __device__ bool next(int i, Unit& u) const {
        const long L = (long)i * G + c; if (L >= nwg) return false;
        int wgid = (int)L; { const int q = nwg / NXCD, r = nwg % NXCD, xcd = wgid % NXCD, off = wgid / NXCD; wgid = (xcd < r ? xcd * (q + 1) : r * (q + 1) + (xcd - r) * q) + off; }
        const int nig = WGM * nN, gid = wgid / nig, fm = gid * WGM, gsz = (nM - fm) < WGM ? (nM - fm) : WGM;
        u.pm = fm + ((wgid % nig) % gsz); u.pn = (wgid % nig) / gsz; u.kt0 = 0; u.nt = ntk; u.split = -1; return true;
    }
};
template <int NM, int NN, int NTK, int NG> struct TailSplitOrder {
    static constexpr int nwg = NM * NN, nfull = (2 * (nwg % NG) > NG || (NTK & 3)) ? nwg : (nwg / NG) * NG, ntail = nwg - nfull;
    int c;
    __device__ void init(int c_) { c = c_; }
    __device__ bool next(int i, Unit& u) const {
        int L = i * NG + c; u.kt0 = 0; u.nt = NTK; u.split = -1;
        if (i * NG >= nfull) {
            if (ntail == 0) { if (L >= nwg) return false; }
            else { if (i * NG > nfull || c >= 2 * ntail) return false;
                   const int part = c >= ntail ? 1 : 0, tc = c - part * ntail; L = nfull + tc; constexpr int n0 = (NTK * 7 / 16) & ~1;
                   u.kt0 = part * n0; u.nt = part ? NTK - n0 : n0; u.split = part + 2 * tc; }
        }
        int wgid = L; { constexpr int q = nwg / NXCD, r = nwg % NXCD; const int xcd = wgid % NXCD, off = wgid / NXCD; wgid = (xcd < r ? xcd * (q + 1) : r * (q + 1) + (xcd - r) * q) + off; }
        constexpr int nig = WGM * NN; const int gid = wgid / nig, fm = gid * WGM, gsz = (NM - fm) < WGM ? (NM - fm) : WGM;
        u.pm = fm + ((wgid % nig) % gsz); u.pn = (wgid % nig) / gsz; return true;
    }
};
struct ResOrder {
    int c, ntk, nsplit;
    __device__ void init(int c_, int ntk_) { c = c_; ntk = ntk_; nsplit = ntk_ >= 16 ? 8 : ntk_ / 2; }
    __device__ bool next(int i, Unit& u) const {
        const int x = c & 7, r = c >> 3;
        if (i == 0) { u.pm = 4 * x + (r >> 3); u.pn = r & 7; u.kt0 = 0; u.nt = ntk; u.split = -1; return true; }
        if (i == 1 && x < nsplit) { const int pairs = ntk >> 1, p0 = x * pairs / nsplit, p1 = (x + 1) * pairs / nsplit;
            u.pm = 32 + (r >> 3); u.pn = r & 7; u.kt0 = 2 * p0; u.nt = 2 * (p1 - p0); u.split = x; return true; }
        return false;
    }
};

template <class Epi, class Sched>
__device__ __forceinline__ void gemm_phase(LAS unsigned char* lds, const Gemm g, const Sched& S, const Epi& E, const int tid) {
    const int wid = __builtin_amdgcn_readfirstlane(tid >> 6), lane = tid & 63, wr = wid >> 2, wc = wid & 3, fr = lane & 15, fq = lane >> 4;
    const int K = g.K;
    unsigned voffA[2], voffB[2];
#pragma unroll
    for (int i = 0; i < 2; ++i) { int R, C; stage_rc(tid * 16 + i * 8192, R, C); const int Rb = (R & ~31) + perm32(R & 31);
        voffA[i] = (unsigned)(R * g.lda + C) * 2u; voffB[i] = (unsigned)(Rb * g.ldb + C) * 2u; }
    const size_t kstep = (size_t)(BK * 2);
    const size_t hstepA = (size_t)HALF * g.lda * 2, hstepB = (size_t)HALF * g.ldb * 2;
    const size_t tstepA = 2 * hstepA, tstepB = 2 * hstepB;
    const unsigned ldsw = (unsigned)wid * 1024u;
    const int aoff = lds_byte(wr * 64 + fr, fq * 8), boff = lds_byte(wc * 32 + fr, fq * 8);
#define PG8_SA(b, h) (((b) * 2 + (h)) * HTB)
#define PG8_SB(b, h) ((4 + (b) * 2 + (h)) * HTB)
#define PG8_STAGE(bufoff, gbase, voff) do { _Pragma("unroll") for (int _i = 0; _i < 2; ++_i) \
        __builtin_amdgcn_global_load_lds((const unsigned*)((const char*)(gbase) + (voff)[_i]), (LAS unsigned*)(lds + (bufoff) + ldsw + _i * 8192), 16, 0, 0); } while (0)
#define PG8_LDA(dst, b, h) do { _Pragma("unroll") for (int m = 0; m < 4; ++m) _Pragma("unroll") for (int k = 0; k < 2; ++k) dst[m][k] = *(const LAS bf16x8*)(lds + PG8_SA(b, h) + aoff + m * 2048 + k * 1024); } while (0)
#define PG8_LDB(dst, b, h) do { _Pragma("unroll") for (int n = 0; n < 2; ++n) _Pragma("unroll") for (int k = 0; k < 2; ++k) dst[n][k] = *(const LAS bf16x8*)(lds + PG8_SB(b, h) + boff + n * 2048 + k * 1024); } while (0)
#define PG8_MMA(ai, bj, At, Bt) do { __builtin_amdgcn_s_setprio(1); _Pragma("unroll") for (int m = 0; m < 4; ++m) _Pragma("unroll") for (int n = 0; n < 2; ++n) _Pragma("unroll") for (int k = 0; k < 2; ++k) \
        acc[ai][bj][m][n] = __builtin_amdgcn_mfma_f32_16x16x32_bf16(Bt[n][k], At[m][k], acc[ai][bj][m][n], 0, 0, 0); __builtin_amdgcn_s_setprio(0); } while (0)
#define PG8_WAIT_V(n) asm volatile("s_waitcnt vmcnt(" #n ")" ::: "memory")
#define PG8_WAIT_L(n) asm volatile("s_waitcnt lgkmcnt(" #n ")" ::: "memory")
#define PG8_BAR __builtin_amdgcn_s_barrier()
#define PG8_SCHED __builtin_amdgcn_sched_barrier(0)
#define PG8_ABASE(u) ((const char*)g.A + (size_t)(u).pm * tstepA + (g.grp ? (size_t)((u).pn >> 1) * (size_t)K * 2 : (size_t)0) + (size_t)(u).kt0 * kstep)
#define PG8_BBASE(u) ((const char*)g.Bt + (size_t)(u).pn * tstepB + (size_t)(u).kt0 * kstep)
    Unit cur, nxt; int ui = 0;
    if (!S.next(0, cur)) return;
    f32x4 acc[2][2][4][2];
#pragma unroll
    for (int a = 0; a < 2; ++a)
#pragma unroll
        for (int b = 0; b < 2; ++b)
#pragma unroll
            for (int m = 0; m < 4; ++m)
#pragma unroll
                for (int n = 0; n < 2; ++n) acc[a][b][m][n] = (f32x4){0.f, 0.f, 0.f, 0.f};
    bf16x8 At[4][2], B0[2][2], B1[2][2];
    const char* cA = PG8_ABASE(cur); const char* cB = PG8_BBASE(cur);
    PG8_STAGE(PG8_SB(0, 0), cB, voffB); PG8_STAGE(PG8_SB(0, 1), cB + hstepB, voffB); PG8_STAGE(PG8_SA(0, 0), cA, voffA); PG8_STAGE(PG8_SA(0, 1), cA + hstepA, voffA);
    if (wr == 1) PG8_BAR;
    PG8_WAIT_V(2); PG8_BAR;
    PG8_STAGE(PG8_SB(1, 0), cB + kstep, voffB); PG8_STAGE(PG8_SA(1, 0), cA + kstep, voffA); PG8_STAGE(PG8_SB(1, 1), cB + hstepB + kstep, voffB);
    PG8_WAIT_V(6); PG8_BAR;
    for (;;) {
        const bool has_next = S.next(ui + 1, nxt);
        const char* nA = has_next ? PG8_ABASE(nxt) : cA; const char* nB = has_next ? PG8_BBASE(nxt) : cB;
        const int nt = cur.nt;
        E.prefetch(cur, tid, lds, ui & 1);
        for (int t = 0; t < nt; t += 2) {
            const bool last = (t == nt - 2);
            const char* a1 = cA + (size_t)(t + 1) * kstep;
            const char* a2 = last ? nA : cA + (size_t)(t + 2) * kstep; const char* b2 = last ? nB : cB + (size_t)(t + 2) * kstep;
            const char* a3 = a2 + kstep; const char* b3 = b2 + kstep;
            PG8_LDB(B0, 0, 0); PG8_LDB(B1, 0, 1); PG8_SCHED; PG8_LDA(At, 0, 0); PG8_STAGE(PG8_SA(1, 1), a1 + hstepA, voffA);
            PG8_WAIT_V(8); PG8_WAIT_L(0); PG8_BAR; PG8_MMA(0, 0, At, B0); PG8_MMA(0, 1, At, B1); PG8_BAR; PG8_SCHED;
            PG8_LDA(At, 0, 1); PG8_STAGE(PG8_SB(0, 0), b2, voffB); PG8_STAGE(PG8_SB(0, 1), b2 + hstepB, voffB); PG8_STAGE(PG8_SA(0, 0), a2, voffA);
            PG8_WAIT_V(8); PG8_WAIT_L(0); PG8_BAR; PG8_MMA(1, 0, At, B0); PG8_MMA(1, 1, At, B1); PG8_BAR; PG8_SCHED;
            PG8_LDB(B0, 1, 0); PG8_LDB(B1, 1, 1); PG8_SCHED; PG8_LDA(At, 1, 0); PG8_STAGE(PG8_SA(0, 1), a2 + hstepA, voffA);
            PG8_WAIT_V(8); PG8_WAIT_L(0); PG8_BAR; PG8_MMA(0, 0, At, B0); PG8_MMA(0, 1, At, B1); PG8_BAR; PG8_SCHED;
            PG8_LDA(At, 1, 1); PG8_STAGE(PG8_SB(1, 0), b3, voffB); PG8_STAGE(PG8_SB(1, 1), b3 + hstepB, voffB); PG8_STAGE(PG8_SA(1, 0), a3, voffA);
            PG8_WAIT_V(8); PG8_WAIT_L(0); PG8_BAR; PG8_MMA(1, 0, At, B0); PG8_MMA(1, 1, At, B1); PG8_BAR; PG8_SCHED;
        }
        if (wr == 0) PG8_BAR;
        E.combine(acc, cur, tid);
        E(acc, cur, wr, wc, fr, fq, lds, tid, ui & 1);
        if (!has_next) break;
#pragma unroll
        for (int a = 0; a < 2; ++a)
#pragma unroll
            for (int b = 0; b < 2; ++b)
#pragma unroll
                for (int m = 0; m < 4; ++m)
#pragma unroll
                    for (int n = 0; n < 2; ++n) acc[a][b][m][n] = (f32x4){0.f, 0.f, 0.f, 0.f};
        cur = nxt; cA = nA; cB = nB; ++ui;
        if (wr == 1) PG8_BAR;
    }
    PG8_WAIT_V(0);
    PG8_BAR;
#undef PG8_SA
#undef PG8_SB
#undef PG8_STAGE
#undef PG8_LDA
#undef PG8_LDB
#undef PG8_MMA
#undef PG8_WAIT_V
#undef PG8_WAIT_L
#undef PG8_BAR
#undef PG8_SCHED
#undef PG8_ABASE
#undef PG8_BBASE
}
}

__device__ __forceinline__ unsigned cvt_pk_bf16(float lo, float hi) { unsigned r; asm volatile("v_cvt_pk_bf16_f32 %0, %1, %2" : "=v"(r) : "v"(lo), "v"(hi)); return r; }
typedef f32x4 AccT[2][2][4][2];

template <int NP> __device__ __forceinline__ float row_scale(const float* P, int row, int fq) {
    const float* p = P + (size_t)row * NP + fq * (NP / 4); float s;
    if (NP == 32) { const f32x4 a = *(const f32x4*)p, b2 = *(const f32x4*)(p + 4); s = ((a.x + a.y) + (a.z + a.w)) + ((b2.x + b2.y) + (b2.z + b2.w)); }
    else { const f32x4 a = *(const f32x4*)p; s = (a.x + a.y) + (a.z + a.w); }
    s += __shfl_xor(s, 16); s += __shfl_xor(s, 32);
    return __builtin_amdgcn_rsqf(s * (1.f / D) + EPS);
}
constexpr int RSC_OFF = LDSCTL_OFF + 2048;
__device__ __forceinline__ void rs_dma(const float* R, int pm, int tid, LAS unsigned char* lds, int par) {
    const int wid = __builtin_amdgcn_readfirstlane(tid >> 6);
    if (wid < 4) {
        const float* gsrc = R + pm * 256 + wid * 64 + (tid & 63); const unsigned dst = (unsigned)__builtin_amdgcn_readfirstlane((int)(RSC_OFF + par * 1024 + wid * 256)); unsigned keep;
        asm volatile("s_mov_b32 %0, m0\n\ts_mov_b32 m0, %2\n\ts_nop 0\n\tglobal_load_lds_dword %1, off\n\ts_mov_b32 m0, %0" : "=&s"(keep) : "v"(gsrc), "s"(dst) : "memory");
    }
}
__device__ __forceinline__ void rs_read8(LAS unsigned char* lds, int wr, int fr, float (&r)[2][4], int par) {
    const LAS float* T = (const LAS float*)(lds + RSC_OFF + par * 1024);
#pragma unroll
    for (int ai = 0; ai < 2; ++ai)
#pragma unroll
        for (int m = 0; m < 4; ++m) r[ai][m] = T[ai * 128 + wr * 64 + m * 16 + fr];
}
template <int NP> __device__ __forceinline__ void row_scales8_direct(const float* P, int pm, int tid, LAS unsigned char* lds, int wr, int fr, float (&r)[2][4]) {
    LAS float* T = (LAS float*)(lds + RSC_OFF);
    { const float* p = P + (size_t)(pm * 256 + (tid >> 1)) * NP + (tid & 1) * (NP / 2); float s;
      if (NP == 32) { const f32x4 a = *(const f32x4*)p, b2 = *(const f32x4*)(p + 4), c = *(const f32x4*)(p + 8), d = *(const f32x4*)(p + 12);
          s = (((a.x + a.y) + (a.z + a.w)) + ((b2.x + b2.y) + (b2.z + b2.w))) + (((c.x + c.y) + (c.z + c.w)) + ((d.x + d.y) + (d.z + d.w))); }
      else { const f32x4 a = *(const f32x4*)p, b2 = *(const f32x4*)(p + 4); s = ((a.x + a.y) + (a.z + a.w)) + ((b2.x + b2.y) + (b2.z + b2.w)); }
      s += __shfl_xor(s, 1);
      if (!(tid & 1)) T[tid >> 1] = __builtin_amdgcn_rsqf(s * (1.f / D) + EPS); }
    asm volatile("s_waitcnt lgkmcnt(0)" ::: "memory"); __builtin_amdgcn_s_barrier(); asm volatile("" ::: "memory");
    rs_read8(lds, wr, fr, r, 0);
}
struct EpiGU {
    bf16_t* H; const float* SS; float* SLAB; unsigned* flags;
    __device__ __forceinline__ void prefetch(const pg8::Unit& u, int tid, LAS unsigned char* lds, int par) const { rs_dma(SS, u.pm, tid, lds, par); }
    __device__ __forceinline__ void combine(AccT& a, const pg8::Unit& u, int tid) const {
        if (u.split < 0 || !(u.split & 1)) return;
        unsigned* fl = flags + (u.split >> 1);
        if (tid == 0) { while (xb_ld(fl) == 0u) __builtin_amdgcn_s_sleep(1);
            __builtin_amdgcn_fence(__ATOMIC_ACQUIRE, "agent"); asm volatile("s_waitcnt vmcnt(0)" ::: "memory"); }
        __syncthreads();
        const u32x4* slab = (const u32x4*)SLAB + (size_t)(u.split >> 1) * (16 * 512); const unsigned ut = (unsigned)tid;
        u32x4 t[16];
#pragma unroll
        for (int i = 0; i < 16; ++i) t[i] = (slab + i * 512)[ut];
#pragma unroll
        for (int i = 0; i < 16; ++i) {
            f32x4& a0 = a[i >> 3][(i >> 2) & 1][i & 3][0]; f32x4& a1 = a[i >> 3][(i >> 2) & 1][i & 3][1];
            a0 = a0 + (f32x4){bflo(t[i].x), bfhi(t[i].x), bflo(t[i].y), bfhi(t[i].y)};
            a1 = a1 + (f32x4){bflo(t[i].z), bfhi(t[i].z), bflo(t[i].w), bfhi(t[i].w)};
        }
    }
    __device__ __forceinline__ void operator()(const AccT& acc, const pg8::Unit& u, int wr, int wc, int fr, int fq, LAS unsigned char* lds, int tid, int par) const {
        const int row0 = u.pm * 256 + wr * 64 + fr, col0 = u.pn * 128 + wc * 32 + 8 * fq;
        const bool tail = u.split >= 0;
        const unsigned ut = (unsigned)tid;
        if (tail) {
            unsigned* fl = flags + (u.split >> 1);
            if (!(u.split & 1)) {
                u32x4* sw = (u32x4*)SLAB + (size_t)(u.split >> 1) * (16 * 512);
#pragma unroll
                for (int ai = 0; ai < 2; ++ai)
#pragma unroll
                    for (int bj = 0; bj < 2; ++bj)
#pragma unroll
                        for (int m = 0; m < 4; ++m) { const f32x4 p0 = acc[ai][bj][m][0], p1 = acc[ai][bj][m][1];
                            u32x4 w; w.x = cvt_pk_bf16(p0.x, p0.y); w.y = cvt_pk_bf16(p0.z, p0.w); w.z = cvt_pk_bf16(p1.x, p1.y); w.w = cvt_pk_bf16(p1.z, p1.w);
                            (sw + ((ai * 2 + bj) * 4 + m) * 512)[ut] = w; }
                __syncthreads();
                if (tid == 0) { __builtin_amdgcn_fence(__ATOMIC_RELEASE, "agent"); asm volatile("s_waitcnt vmcnt(0)" ::: "memory"); (void)xb_add(fl, 1u); }
                return;
            }
        }
        float rs8[2][4]; rs_read8(lds, wr, fr, rs8, par);
#pragma unroll
        for (int ai = 0; ai < 2; ++ai)
#pragma unroll
            for (int m = 0; m < 4; ++m) {
                const int row = row0 + ai * 128 + m * 16;
                const float r = rs8[ai][m];
                bf16_t* rowp = H + (size_t)row * FF + col0;
                float hv[8];
#pragma unroll
                for (int n = 0; n < 2; ++n)
#pragma unroll
                    for (int j = 0; j < 4; ++j) { const float gv = acc[ai][0][m][n][j] * r, uv = acc[ai][1][m][n][j] * r; hv[n * 4 + j] = fsilu(gv) * uv; }
                u32x4 w; w.x = cvt_pk_bf16(hv[0], hv[1]); w.y = cvt_pk_bf16(hv[2], hv[3]); w.z = cvt_pk_bf16(hv[4], hv[5]); w.w = cvt_pk_bf16(hv[6], hv[7]);
                *(u32x4*)rowp = w;
            }
    }
};
template <int NP, int HALF> struct EpiRes {
    float* X; bf16_t* XB; float* SS; const float* colscale; const float* RP; float* PART;
    __device__ __forceinline__ void prefetch(const pg8::Unit&, int, LAS unsigned char*, int) const {}
    __device__ __forceinline__ void combine(AccT&, const pg8::Unit&, int) const {}
    __device__ __forceinline__ void operator()(const AccT& acc, const pg8::Unit& u, int wr, int wc, int fr, int fq, LAS unsigned char* lds, int tid, int par) const {
        const int row0 = u.pm * 256 + wr * 64 + fr, col0 = u.pn * 256 + wc * 32 + 8 * fq;
        if (u.split >= 0) {
#pragma unroll
            for (int ai = 0; ai < 2; ++ai)
#pragma unroll
                for (int m = 0; m < 4; ++m) {
                    bf16_t* rowp = (bf16_t*)PART + ((size_t)u.split * MS + (size_t)(row0 + ai * 128 + m * 16 - MP)) * D + col0;
#pragma unroll
                    for (int bj = 0; bj < 2; ++bj) { const f32x4 p0 = acc[ai][bj][m][0], p1 = acc[ai][bj][m][1];
                        u32x4 w; w.x = cvt_pk_bf16(p0.x, p0.y); w.y = cvt_pk_bf16(p0.z, p0.w); w.z = cvt_pk_bf16(p1.x, p1.y); w.w = cvt_pk_bf16(p1.z, p1.w);
                        *(u32x4*)(rowp + bj * 128) = w; }
                }
            return;
        }
        f32x4 cs[2][2];
#pragma unroll
        for (int bj = 0; bj < 2; ++bj)
#pragma unroll
            for (int n = 0; n < 2; ++n) { cs[bj][n] = colscale ? *(const f32x4*)(colscale + col0 + bj * 128 + 4 * n) : (f32x4){1.f, 1.f, 1.f, 1.f}; if (HALF) cs[bj][n] = cs[bj][n] * 0.5f; }
        float rs8[2][4];
        if (NP > 0) row_scales8_direct<NP == 0 ? 16 : NP>(RP, u.pm, tid, lds, wr, fr, rs8);
        constexpr bool PIPE = (NP == 0 && HALF == 1);
        f32x4 xo[PIPE ? 2 : 1][2][2][2];
#define RES_LD(buf, q_) do { _Pragma("unroll") for (int mm = 0; mm < 2; ++mm) _Pragma("unroll") for (int bj = 0; bj < 2; ++bj) _Pragma("unroll") for (int n = 0; n < 2; ++n) \
            xo[buf][mm][bj][n] = *(const f32x4*)(X + (size_t)(row0 + ((q_) >> 1) * 128 + (2 * ((q_) & 1) + mm) * 16) * D + col0 + bj * 128 + 4 * n); } while (0)
        if (PIPE) RES_LD(0, 0);
#pragma unroll
        for (int q = 0; q < 4; ++q) {
            const int ai = q >> 1, mp = q & 1;
            if (PIPE) { if (q + 1 < 4) RES_LD((q + 1) & 1, q + 1); } else RES_LD(0, q);
            __builtin_amdgcn_sched_barrier(0);
#pragma unroll
            for (int mm = 0; mm < 2; ++mm) {
                const int m = 2 * mp + mm, row = row0 + ai * 128 + m * 16;
                const float r = NP > 0 ? rs8[ai][m] : 1.f;
                float* rowp = X + (size_t)row * D + col0; bf16_t* rowb = XB + (size_t)row * D + col0;
                float ss = 0.f;
#pragma unroll
                for (int bj = 0; bj < 2; ++bj) {
                    const f32x4 x0 = xo[PIPE ? (q & 1) : 0][mm][bj][0] + cs[bj][0] * (acc[ai][bj][m][0] * r), x1 = xo[PIPE ? (q & 1) : 0][mm][bj][1] + cs[bj][1] * (acc[ai][bj][m][1] * r);
                    *(f32x4*)(rowp + bj * 128) = x0; *(f32x4*)(rowp + bj * 128 + 4) = x1;
                    ss += ((x0.x * x0.x + x0.y * x0.y) + (x0.z * x0.z + x0.w * x0.w)) + ((x1.x * x1.x + x1.y * x1.y) + (x1.z * x1.z + x1.w * x1.w));
                    u32x4 w; w.x = cvt_pk_bf16(x0.x, x0.y); w.y = cvt_pk_bf16(x0.z, x0.w); w.z = cvt_pk_bf16(x1.x, x1.y); w.w = cvt_pk_bf16(x1.z, x1.w);
                    *(u32x4*)(rowb + bj * 128) = w;
                }
                ss += __shfl_xor(ss, 16); ss += __shfl_xor(ss, 32);
                if (fq == 0) SS[(size_t)row * 32 + u.pn * 4 + wc] = ss;
            }
            __builtin_amdgcn_sched_barrier(0);
        }
#undef RES_LD
    }
};
struct EpiHG {
    bf16_t *Q, *KK, *V, *G; float* LF; const float* lb; const float* SS;
    __device__ __forceinline__ void prefetch(const pg8::Unit&, int, LAS unsigned char*, int) const {}
    __device__ __forceinline__ void combine(AccT&, const pg8::Unit&, int) const {}
    __device__ __forceinline__ void operator()(const AccT& acc, const pg8::Unit& u, int wr, int wc, int fr, int fq, LAS unsigned char* lds, int tid, int par) const {
        const int row0 = u.pm * 256 + wr * 64 + fr, reg = u.pn >> 3, col0 = (u.pn & 7) * 256 + wc * 32 + 8 * fq;
        float lbv[2][8];
#pragma unroll
        for (int bj = 0; bj < 2; ++bj)
#pragma unroll
            for (int j = 0; j < 8; ++j) lbv[bj][j] = (reg == 1) ? lb[col0 + bj * 128 + j] : 0.f;
        float rs8[2][4]; row_scales8_direct<32>(SS, u.pm, tid, lds, wr, fr, rs8);
#pragma unroll
        for (int ai = 0; ai < 2; ++ai)
#pragma unroll
            for (int m = 0; m < 4; ++m) {
                const size_t ro = (size_t)(row0 + ai * 128 + m * 16) * D + col0;
                const float rsc = rs8[ai][m];
#pragma unroll
                for (int bj = 0; bj < 2; ++bj) {
                    float a[8], o[8];
#pragma unroll
                    for (int n = 0; n < 2; ++n)
#pragma unroll
                        for (int j = 0; j < 4; ++j) a[n * 4 + j] = acc[ai][bj][m][n][j] * rsc;
                    bf16_t* dst;
                    if (reg == 0) { dst = Q;
#pragma unroll
                        for (int j = 0; j < 8; ++j) o[j] = fsilu(a[j]) * 0.08838834764831845f;
                    } else if (reg == 1) { dst = KK; float lf[8];
#pragma unroll
                        for (int j = 0; j < 8; ++j) { const float f = fminf(fmaxf(a[j], -80.f), 80.f), e = __expf(-f), sig = __builtin_amdgcn_rcpf(1.f + e), l = lbv[bj][j];
                            lf[j] = __logf(l + (1.f - l) * sig); o[j] = (1.f - l) * e * sig; }
                        u32x4 lw; lw.x = pkh2(lf[0], lf[1]); lw.y = pkh2(lf[2], lf[3]); lw.z = pkh2(lf[4], lf[5]); lw.w = pkh2(lf[6], lf[7]);
                        *(u32x4*)((unsigned short*)LF + ro + bj * 128) = lw;
                    } else if (reg == 2) { dst = V;
#pragma unroll
                        for (int j = 0; j < 8; ++j) o[j] = a[j];
                    } else { dst = G;
#pragma unroll
                        for (int j = 0; j < 8; ++j) o[j] = fsilu(a[j]);
                    }
                    u32x4 w; w.x = cvt_pk_bf16(o[0], o[1]); w.y = cvt_pk_bf16(o[2], o[3]); w.z = cvt_pk_bf16(o[4], o[5]); w.w = cvt_pk_bf16(o[6], o[7]);
                    *(u32x4*)(dst + ro + bj * 128) = w;
                }
            }
    }
};
struct EpiGLA {
    bf16_t *Q, *KK, *V, *G; float* LF; const float* bgate; const float* SS;
    __device__ __forceinline__ void prefetch(const pg8::Unit&, int, LAS unsigned char*, int) const {}
    __device__ __forceinline__ void combine(AccT&, const pg8::Unit&, int) const {}
    __device__ __forceinline__ void operator()(const AccT& acc, const pg8::Unit& u, int wr, int wc, int fr, int fq, LAS unsigned char* lds, int tid, int par) const {
        const int pn = u.pn; int reg, cbase;
        if (pn < 4) { reg = 0; cbase = pn * 256; } else if (pn < 8) { reg = 1; cbase = (pn - 4) * 256; } else if (pn < 16) { reg = 2; cbase = (pn - 8) * 256; }
        else if (pn < 24) { reg = 3; cbase = (pn - 16) * 256; } else { reg = 4; cbase = (pn - 24) * 256; }
        const int row0 = u.pm * 256 + wr * 64 + fr, col0 = cbase + wc * 32 + 8 * fq;
        float bg[2][8];
#pragma unroll
        for (int bj = 0; bj < 2; ++bj)
#pragma unroll
            for (int j = 0; j < 8; ++j) bg[bj][j] = (reg == 4) ? bgate[col0 + bj * 128 + j] : 0.f;
        float rs8[2][4]; row_scales8_direct<32>(SS, u.pm, tid, lds, wr, fr, rs8);
#pragma unroll
        for (int ai = 0; ai < 2; ++ai)
#pragma unroll
            for (int m = 0; m < 4; ++m) {
                const size_t ro = (size_t)(row0 + ai * 128 + m * 16) * D + col0;
                const float rsc = rs8[ai][m];
#pragma unroll
                for (int bj = 0; bj < 2; ++bj) {
                    float a[8], o[8];
#pragma unroll
                    for (int n = 0; n < 2; ++n)
#pragma unroll
                        for (int j = 0; j < 4; ++j) a[n * 4 + j] = acc[ai][bj][m][n][j] * rsc;
                    if (reg == 4) {
                        float lf[8];
#pragma unroll
                        for (int j = 0; j < 8; ++j) { const float z = a[j] + bg[bj][j]; lf[j] = (fminf(z, 0.f) - __logf(1.f + __expf(-fabsf(z)))) * 0.0625f; }
                        u32x4 lw; lw.x = pkh2(lf[0], lf[1]); lw.y = pkh2(lf[2], lf[3]); lw.z = pkh2(lf[4], lf[5]); lw.w = pkh2(lf[6], lf[7]);
                        *(u32x4*)((unsigned short*)LF + ro + bj * 128) = lw;
                    } else {
                        bf16_t* dst;
                        if (reg == 0) { dst = Q;
#pragma unroll
                            for (int j = 0; j < 8; ++j) o[j] = a[j] * 0.0625f;
                        } else if (reg == 1) { dst = KK;
#pragma unroll
                            for (int j = 0; j < 8; ++j) o[j] = a[j];
                        } else if (reg == 2) { dst = V;
#pragma unroll
                            for (int j = 0; j < 8; ++j) o[j] = a[j];
                        } else { dst = G;
#pragma unroll
                            for (int j = 0; j < 8; ++j) o[j] = fsilu(a[j]);
                        }
                        u32x4 w; w.x = cvt_pk_bf16(o[0], o[1]); w.y = cvt_pk_bf16(o[2], o[3]); w.z = cvt_pk_bf16(o[4], o[5]); w.w = cvt_pk_bf16(o[6], o[7]);
                        *(u32x4*)(dst + ro + bj * 128) = w;
                    }
                }
            }
    }
};

struct Params { const float* in[26]; float* out; unsigned char* ws; int ph_lo, ph_hi; };
typedef const Params __attribute__((address_space(4))) CParams;
enum { I_XP = 0, I_XS, I_SHG, I_SGLA, I_SPOOL, I_NF1, I_F1G, I_F1U, I_F1D, I_NMIX, I_NF2, I_F2G, I_F2U, I_F2D, I_LBL, I_HWIN, I_HON, I_HWOUT, I_GWIN, I_GWGU, I_GBG, I_GON, I_GWOUT, I_PWG, I_PSC, I_FN };

template <class Src>
__device__ __forceinline__ void transpose_item(const Src& src, int K, bf16_t* WT, int dst_row0, int k0, int n0, LAS float* scr, int lane, const float* gain) {
    const int c = lane & 7;
    f32x4 g0 = (f32x4){1.f, 1.f, 1.f, 1.f}, g1 = g0;
    if (gain) { g0 = *(const f32x4*)(gain + k0 + 8 * c); g1 = *(const f32x4*)(gain + k0 + 8 * c + 4); }
    float wv[32];
#pragma unroll
    for (int i = 0; i < 32; ++i) wv[i] = src(k0 + 2 * i + (lane >> 5), n0 + (lane & 31));
#pragma unroll
    for (int i = 0; i < 32; ++i) scr[(2 * i + (lane >> 5)) * 33 + (lane & 31)] = wv[i];
    LDS_WAIT(); asm volatile("" ::: "memory");
#pragma unroll
    for (int j = 0; j < 4; ++j) { const int n = (lane >> 3) + 8 * j; const LAS float* s = scr + (8 * c) * 33 + n;
        u32x4 o; o.x = pk2(s[0 * 33] * g0.x, s[1 * 33] * g0.y); o.y = pk2(s[2 * 33] * g0.z, s[3 * 33] * g0.w); o.z = pk2(s[4 * 33] * g1.x, s[5 * 33] * g1.y); o.w = pk2(s[6 * 33] * g1.z, s[7 * 33] * g1.w);
        *(u32x4*)(WT + (size_t)(dst_row0 + n) * K + k0 + 8 * c) = o; }
    LDS_WAIT(); asm volatile("" ::: "memory");
}
struct SrcPlain { const float* W; int ld; __device__ __forceinline__ float operator()(int k, int n) const { return __builtin_nontemporal_load(W + (size_t)k * ld + n); } };
struct SrcGlaGate { const float* win; const float* wgu;
    __device__ __forceinline__ float operator()(int k, int n) const { float s = 0.f;
#pragma unroll
        for (int r = 0; r < 16; ++r) s += win[(size_t)k * GL_WIN_LD + 6144 + r] * wgu[r * GL_DK + n];
        return s; } };

__device__ __forceinline__ void prologue_phase(CParams* P, LAS unsigned char* lds, int gw, int NGW, int wave, int lane) {
    unsigned char* ws = P->ws;
    LAS float* scr = (LAS float*)(lds + wave * 16384);
    constexpr int IT_FFN = (D / 64) * (FF / 32);
    constexpr int IT_HIN = (D / 64) * (8192 / 32), IT_DD = (D / 64) * (D / 32), IT_GIN = (D / 64) * (6144 / 32), IT_GG = (D / 64) * (GL_DK / 32), IT_PL = (512 / 64) * (512 / 32);
    constexpr int N_FFN = 24 * IT_FFN, N_H = 2 * IT_HIN + 2 * IT_DD, N_G = IT_GIN + IT_GG + IT_DD, N_P = 4 * IT_PL;
    constexpr int NITEMS = N_FFN + N_H + N_G + N_P;
    for (int it = gw; it < NITEMS; it += NGW) {
        int r = it;
        if (r < N_FFN) {
            const int mat = r / IT_FFN, item = r % IT_FFN, s = mat / 3, kind = mat % 3, li = s >> 1, which = s & 1;
            if (kind < 2) {
                const float* W = P->in[(which ? I_F2G : I_F1G) + kind] + (size_t)li * D * FF;
                const int nblk = FF / 32, kb = item / nblk, nb = item % nblk, n0 = nb * 32;
                SrcPlain src{W, FF};
                transpose_item(src, D, (bf16_t*)(ws + WS_WGU + (size_t)s * SZ_WGU1), (n0 >> 7) * 256 + (n0 & 127) + kind * 128, kb * 64, n0, scr, lane, P->in[which ? I_NF2 : I_NF1] + (size_t)li * D);
            } else {
                const float* W = P->in[which ? I_F2D : I_F1D] + (size_t)li * FF * D;
                const int nblk = D / 32, kb = item / nblk, nb = item % nblk;
                SrcPlain src{W, D};
                transpose_item(src, FF, (bf16_t*)(ws + WS_WDN + (size_t)s * SZ_WDN1), nb * 32, kb * 64, nb * 32, scr, lane, nullptr);
            }
            continue;
        }
        r -= N_FFN;
        if (r < N_H) {
            if (r < 2 * IT_HIN) { const int j = r / IT_HIN, item = r % IT_HIN, nblk = 8192 / 32, kb = item / nblk, nb = item % nblk;
                SrcPlain src{P->in[I_HWIN] + (size_t)j * D * 8192, 8192};
                transpose_item(src, D, (bf16_t*)(ws + WS_WHIN) + (size_t)j * 8192 * D, nb * 32, kb * 64, nb * 32, scr, lane, P->in[I_NMIX] + (size_t)(3 * j) * D);
            } else { r -= 2 * IT_HIN; const int j = r / IT_DD, item = r % IT_DD, nblk = D / 32, kb = item / nblk, nb = item % nblk;
                SrcPlain src{P->in[I_HWOUT] + (size_t)j * D * D, D};
                transpose_item(src, D, (bf16_t*)(ws + WS_WHOUT) + (size_t)j * D * D, nb * 32, kb * 64, nb * 32, scr, lane, P->in[I_HON] + (size_t)j * D);
            }
            continue;
        }
        r -= N_H;
        if (r < N_G) {
            if (r < IT_GIN) { const int nblk = 6144 / 32, kb = r / nblk, nb = r % nblk;
                SrcPlain src{P->in[I_GWIN], GL_WIN_LD};
                transpose_item(src, D, (bf16_t*)(ws + WS_WGIN), nb * 32, kb * 64, nb * 32, scr, lane, P->in[I_NMIX] + (size_t)1 * D);
            } else if (r < IT_GIN + IT_GG) { r -= IT_GIN; const int nblk = GL_DK / 32, kb = r / nblk, nb = r % nblk;
                SrcGlaGate src{P->in[I_GWIN], P->in[I_GWGU]};
                transpose_item(src, D, (bf16_t*)(ws + WS_WGIN), 6144 + nb * 32, kb * 64, nb * 32, scr, lane, P->in[I_NMIX] + (size_t)1 * D);
            } else { r -= IT_GIN + IT_GG; const int nblk = D / 32, kb = r / nblk, nb = r % nblk;
                SrcPlain src{P->in[I_GWOUT], D};
                transpose_item(src, D, (bf16_t*)(ws + WS_WGOUT), nb * 32, kb * 64, nb * 32, scr, lane, nullptr);
            }
            continue;
        }
        r -= N_G;
        { const int gi = r / IT_PL, item = r % IT_PL, nblk = 512 / 32, kb = item / nblk, nb = item % nblk;
          SrcPlain src{P->in[I_PWG] + (size_t)gi * 512 * 512, 512};
          transpose_item(src, 512, (bf16_t*)(ws + WS_WPOOL), gi * 512 + nb * 32, kb * 64, nb * 32, scr, lane, nullptr); }
    }
    {
        float* X = (float*)(ws + WS_X); bf16_t* XB = (bf16_t*)(ws + WS_XN); float* SS = (float*)(ws + WS_SS);
        for (int m = gw; m < M; m += NGW) {
            const f32x4* xr = (m < MP ? (const f32x4*)(P->in[I_XP] + (size_t)m * D) : (const f32x4*)(P->in[I_XS] + (size_t)(m - MP) * D)) + lane;
            f32x4* xo = (f32x4*)(X + (size_t)m * D) + lane; u32x2* xb = (u32x2*)(XB + (size_t)m * D) + lane;
            float sq = 0.f;
#pragma unroll
            for (int j = 0; j < 8; ++j) { const f32x4 v = xr[64 * j]; xo[64 * j] = v; u32x2 w; w.x = pk2(v.x, v.y); w.y = pk2(v.z, v.w); xb[64 * j] = w; sq += (v.x * v.x + v.y * v.y) + (v.z * v.z + v.w * v.w); }
            sq = wave_sum(sq);
            if (lane < 32) SS[(size_t)m * 32 + lane] = lane == 0 ? sq : 0.f;
            if (lane == 0) ((float*)(ws + WS_R))[m] = __builtin_amdgcn_rsqf(sq * (1.f / D) + EPS);
        }
    }
    {
        float* TAB = (float*)(ws + WS_TAB);
        for (int c = gw * 64 + lane; c < D; c += NGW * 64) {
            float l[4], mx = -1e30f;
#pragma unroll
            for (int i = 0; i < 4; ++i) { l[i] = P->in[I_LBL][i * D + c]; mx = fmaxf(mx, l[i]); }
            float e[4], s = 0.f;
#pragma unroll
            for (int i = 0; i < 4; ++i) { e[i] = __expf(l[i] - mx); s += e[i]; }
            TAB[c] = 0.f;
            TAB[D + c] = (e[1] + e[2] + e[3]) / s;
        }
    }
}

__device__ __forceinline__ void norm_phase(float* X, const float* gain, bf16_t* XN, int gw, int NGW, int lane) {
    for (int m = gw; m < M; m += NGW) {
        const f32x4* xr = (const f32x4*)(X + (size_t)m * D) + lane;
        f32x4 v[8]; float s = 0.f;
#pragma unroll
        for (int j = 0; j < 8; ++j) v[j] = xr[64 * j];
#pragma unroll
        for (int j = 0; j < 8; ++j) s += (v[j].x * v[j].x + v[j].y * v[j].y) + (v[j].z * v[j].z + v[j].w * v[j].w);
        const float r = __builtin_amdgcn_rsqf(wave_sum(s) * (1.f / D) + EPS);
        const f32x4* gr = (const f32x4*)gain + lane;
        u32x2* o = (u32x2*)(XN + (size_t)m * D) + lane;
#pragma unroll
        for (int j = 0; j < 8; ++j) { const f32x4 g = gr[64 * j]; u32x2 w; w.x = pk2(v[j].x * r * g.x, v[j].y * r * g.y); w.y = pk2(v[j].z * r * g.z, v[j].w * r * g.w); o[64 * j] = w; }
    }
}
__device__ __forceinline__ void final_phase(const float* X, const float* gain, float* Y, const float* PART, int gw, int NGW, int lane) {
    f32x4 gv[8];
#pragma unroll
    for (int j = 0; j < 8; ++j) gv[j] = *((const f32x4*)gain + lane + 64 * j);
    for (int m = gw; m < M; m += NGW) {
        const f32x4* xr = (const f32x4*)(X + (size_t)m * D) + lane;
        f32x4 v[8]; float s = 0.f;
#pragma unroll
        for (int j = 0; j < 8; ++j) v[j] = xr[64 * j];
        if (m >= MP) {
#pragma unroll
            for (int hh = 0; hh < 2; ++hh) {
                u32x2 pw[4][8];
#pragma unroll
                for (int j = 0; j < 4; ++j)
#pragma unroll
                    for (int sp = 0; sp < 8; ++sp) pw[j][sp] = *((const u32x2*)((const bf16_t*)PART + ((size_t)sp * MS + (m - MP)) * D) + lane + 64 * (4 * hh + j));
#pragma unroll
                for (int j = 0; j < 4; ++j) {
                    f32x4 a = (f32x4){0.f, 0.f, 0.f, 0.f};
#pragma unroll
                    for (int sp = 0; sp < 8; ++sp) a = a + (f32x4){bflo(pw[j][sp].x), bfhi(pw[j][sp].x), bflo(pw[j][sp].y), bfhi(pw[j][sp].y)};
                    v[4 * hh + j] = v[4 * hh + j] + a * 0.5f;
                }
            }
        }
#pragma unroll
        for (int j = 0; j < 8; ++j) s += (v[j].x * v[j].x + v[j].y * v[j].y) + (v[j].z * v[j].z + v[j].w * v[j].w);
        const float r = __builtin_amdgcn_rsqf(wave_sum(s) * (1.f / D) + EPS);
        f32x4* o = (f32x4*)(Y + (size_t)m * D) + lane;
#pragma unroll
        for (int j = 0; j < 8; ++j) { const f32x4 y = v[j] * r * gv[j]; __builtin_nontemporal_store(y, o + 64 * j); }
    }
}
template <int NG>
__device__ __forceinline__ void post_phase(const bf16_t* O  , const float* gain, const bf16_t* G, bf16_t* OG, int gw, int NGW, int lane) {
    f32x4 gv[8];
#pragma unroll
    for (int j = 0; j < 8; ++j) gv[j] = *((const f32x4*)gain + lane + 64 * j);
    for (int m = gw; m < M; m += NGW) {
        const u32x2* xr = (const u32x2*)(O + (size_t)m * D) + lane;
        const u32x2* gg = (const u32x2*)(G + (size_t)m * D) + lane;
        f32x4 v[8]; u32x2 vq[8], gq[8]; float s[NG];
#pragma unroll
        for (int j = 0; j < 8; ++j) { vq[j] = xr[64 * j]; gq[j] = gg[64 * j]; }
#pragma unroll
        for (int j = 0; j < 8; ++j) v[j] = (f32x4){bflo(vq[j].x), bfhi(vq[j].x), bflo(vq[j].y), bfhi(vq[j].y)};
#pragma unroll
        for (int g = 0; g < NG; ++g) s[g] = 0.f;
#pragma unroll
        for (int j = 0; j < 8; ++j) s[j * NG / 8] += (v[j].x * v[j].x + v[j].y * v[j].y) + (v[j].z * v[j].z + v[j].w * v[j].w);
        float r[NG];
#pragma unroll
        for (int g = 0; g < NG; ++g) r[g] = __builtin_amdgcn_rsqf(wave_sum(s[g]) * ((float)NG / D) + EPS);
        u32x2* o = (u32x2*)(OG + (size_t)m * D) + lane;
#pragma unroll
        for (int j = 0; j < 8; ++j) { const f32x4 g = gv[j]; const u32x2 gw2 = gq[j]; const float rr = r[j * NG / 8];
            u32x2 w; w.x = pk2(v[j].x * rr * g.x * bflo(gw2.x), v[j].y * rr * g.y * bfhi(gw2.x)); w.y = pk2(v[j].z * rr * g.z * bflo(gw2.y), v[j].w * rr * g.w * bfhi(gw2.y)); o[64 * j] = w; }
    }
}

template <int NP  , int HALF>
__device__ __forceinline__ void fix_phase(float* X, bf16_t* XB, float* SS, float* R, const float* PART, int nsplit, const float* colscale, const float* RP, LAS unsigned char* lds, int bx, int wave, int gw, int NGW, int lane) {
    {
        const int m = MP + 4 * bx + (wave & 3), hf = wave >> 2;
        f32x4* xr = (f32x4*)(X + (size_t)m * D) + lane + 256 * hf; u32x2* xb = (u32x2*)(XB + (size_t)m * D) + lane + 256 * hf;
        u32x2 pw[4][8]; f32x4 xv[4];
#pragma unroll
        for (int j = 0; j < 4; ++j) { xv[j] = xr[64 * j];
#pragma unroll
            for (int sp = 0; sp < 8; ++sp) pw[j][sp] = (sp < nsplit) ? *((const u32x2*)((const bf16_t*)PART + ((size_t)sp * MS + (m - MP)) * D) + lane + 256 * hf + 64 * j) : (u32x2){0u, 0u}; }
        float rpv = 0.f; if (NP > 0) rpv = lane < NP ? RP[(size_t)m * NP + lane] : 0.f;
        f32x4 csv[4];
#pragma unroll
        for (int j = 0; j < 4; ++j) csv[j] = colscale ? *((const f32x4*)colscale + lane + 256 * hf + 64 * j) : (f32x4){1.f, 1.f, 1.f, 1.f};
        { float sv[2];
#pragma unroll
          for (int i = 0; i < 2; ++i) { const int mm = 2 * (gw + i * NGW) + (lane >> 5); sv[i] = mm < MP ? SS[(size_t)mm * 32 + (lane & 31)] : 0.f; }
#pragma unroll
          for (int i = 0; i < 2; ++i) { const int mm = 2 * (gw + i * NGW) + (lane >> 5); float s2 = sv[i];
#pragma unroll
              for (int o = 1; o < 32; o <<= 1) s2 += __shfl_xor(s2, o);
              if ((lane & 31) == 0 && mm < MP) R[mm] = __builtin_amdgcn_rsqf(s2 * (1.f / D) + EPS); } }
        float r = HALF ? 0.5f : 1.0f;
        if (NP > 0) { const float s3 = wave_sum(rpv); r *= __builtin_amdgcn_rsqf(s3 * (1.f / D) + EPS); }
        float sq = 0.f;
#pragma unroll
        for (int j = 0; j < 4; ++j) {
            f32x4 a = (f32x4){0.f, 0.f, 0.f, 0.f};
#pragma unroll
            for (int sp = 0; sp < 8; ++sp) a = a + (f32x4){bflo(pw[j][sp].x), bfhi(pw[j][sp].x), bflo(pw[j][sp].y), bfhi(pw[j][sp].y)};
            const f32x4 v = xv[j] + a * csv[j] * r;
            xr[64 * j] = v; u32x2 w; w.x = pk2(v.x, v.y); w.y = pk2(v.z, v.w); xb[64 * j] = w;
            sq += (v.x * v.x + v.y * v.y) + (v.z * v.z + v.w * v.w);
        }
        sq = wave_sum(sq);
        LAS float* red = (LAS float*)lds;
        lds_barrier();
        if (lane == 0) red[wave] = sq;
        lds_barrier();
        if (hf == 0) { const float tot = red[wave] + red[wave + 4];
            if (lane < 32) SS[(size_t)m * 32 + lane] = lane == 0 ? tot : 0.f;
            if (lane == 0) R[m] = __builtin_amdgcn_rsqf(tot * (1.f / D) + EPS); }
    }
}

template <int KT> struct LdBf;
template <> struct LdBf<4> { static __device__ __forceinline__ void ld(const bf16_t* p, float* o) { const u32x2 w = *(const u32x2*)p; o[0] = bflo(w.x); o[1] = bfhi(w.x); o[2] = bflo(w.y); o[3] = bfhi(w.y); } };
template <> struct LdBf<8> { static __device__ __forceinline__ void ld(const bf16_t* p, float* o) { const u32x4 w = *(const u32x4*)p; o[0] = bflo(w.x); o[1] = bfhi(w.x); o[2] = bflo(w.y); o[3] = bfhi(w.y); o[4] = bflo(w.z); o[5] = bfhi(w.z); o[6] = bflo(w.w); o[7] = bfhi(w.w); } };
template <int K, int VH, int NH>
__device__ __forceinline__ void scan_simple(const bf16_t* Q, const bf16_t* KK, const float* LF, const bf16_t* V, float* O,
                                            const float* S0, float* SPo, float* SSo, int tid, int G) {
    constexpr int KT = K / 32, NVB = VH / 16;
    const int vi = tid >> 5, kg = tid & 31;
    const int nunits = (PB + SB) * NH * NVB;
    for (int u = blockIdx.x; u < nunits; u += G) {
        const int seq = u / (NH * NVB), rem = u % (NH * NVB), h = rem / NVB, vb = rem % NVB;
        int row0, T; if (seq < PB) { row0 = seq * PT; T = PT; } else { row0 = MP + (seq - PB) * ST; T = ST; }
        float S[KT];
        const size_t sidx = ((size_t)h * K + kg * KT) * VH + vb * 16 + vi;
        if (seq >= PB) { const float* s0 = S0 + (size_t)(seq - PB) * NH * K * VH + sidx;
#pragma unroll
            for (int j = 0; j < KT; ++j) S[j] = s0[(size_t)j * VH]; }
        else {
#pragma unroll
            for (int j = 0; j < KT; ++j) S[j] = 0.f; }
        const int ccol = h * K + kg * KT, vcol = h * VH + vb * 16 + vi;
#pragma unroll 4
        for (int t = 0; t < T; ++t) {
            const size_t r = (size_t)(row0 + t) * D;
            float qf[KT], kf[KT], lf[KT];
            LdBf<KT>::ld(Q + r + ccol, qf); LdBf<KT>::ld(KK + r + ccol, kf);
#pragma unroll
            for (int j = 0; j < KT; j += 4) { const f32x4 l4 = *(const f32x4*)(LF + r + ccol + j); lf[j] = l4.x; lf[j + 1] = l4.y; lf[j + 2] = l4.z; lf[j + 3] = l4.w; }
            const float vv = bf2f(V[r + vcol]);
            float po = 0.f;
#pragma unroll
            for (int j = 0; j < KT; ++j) { S[j] = __expf(lf[j]) * S[j] + kf[j] * vv; po += qf[j] * S[j]; }
#pragma unroll
            for (int o = 1; o < 32; o <<= 1) po += __shfl_xor(po, o);
            if (kg == 0) O[r + vcol] = po;
        }
        float* so = (seq < PB ? SPo + (size_t)seq * NH * K * VH : SSo + (size_t)(seq - PB) * NH * K * VH) + sidx;
#pragma unroll
        for (int j = 0; j < KT; ++j) so[(size_t)j * VH] = S[j];
    }
}


__device__ __forceinline__ int permK(int c) { const int kk = c & 31; return (c & ~31) + 8 * ((kk & 15) >> 2) + 4 * (kk >> 4) + (kk & 3); }
template <int K, int VH, int NH>
__device__ __forceinline__ void scan_s1(const bf16_t* Q, const bf16_t* KK, const float* LF, const bf16_t* V, bf16_t* QI, bf16_t* KDT, bf16_t* AM, bf16_t* VT, float* DL,
                                        LAS unsigned char* lds, int tid, int G, int bx) {
    constexpr int KH = K / 2, RG = 512 / KH, RPT = 64 / RG, KS = K * 2 + 16, NHK = NH * K;
    constexpr int L_TOT = 0, L_QT = 4096, L_KT = L_QT + 64 * KS;
    static_assert(RG * K * 4 <= L_QT && L_KT + 64 * KS <= RING_BYTES && RPT % 8 == 0, "S1 LDS / shape");
    const int c = 2 * (tid % KH), rg = tid / KH, lane = tid & 63, wave = tid >> 6, l15 = lane & 15, g4 = lane >> 4;
    LAS float* TOT = (LAS float*)(lds + L_TOT);
    for (int u = bx; u < 144 * NH; u += G) {
        const int blk = u / NH, h = u % NH, r0 = blk * 64; const bool is_prompt = blk < 128;
        lds_barrier();
        f32x2 b[RPT]; unsigned lw[RPT], qw[RPT], kw[RPT];
        { const size_t ro = (size_t)(r0 + rg * RPT) * D + h * K + c;
#pragma unroll
          for (int i = 0; i < RPT; ++i) { lw[i] = *(const unsigned*)((const unsigned short*)LF + ro + (size_t)i * D); qw[i] = *(const unsigned*)(Q + ro + (size_t)i * D); kw[i] = *(const unsigned*)(KK + ro + (size_t)i * D); } }
#pragma unroll
        for (int i = 0; i < RPT; ++i) b[i] = (f32x2){hlo(lw[i]), hhi(lw[i])};
        f32x2 bref = (f32x2){0.f, 0.f}, blast = (f32x2){0.f, 0.f};
        if (is_prompt) {
#pragma unroll
            for (int i = 1; i < RPT; ++i) b[i] = b[i] + b[i - 1];
            *(LAS f32x2*)(TOT + rg * K + c) = b[RPT - 1];
            lds_barrier();
            f32x2 pre = (f32x2){0.f, 0.f}, tot = (f32x2){0.f, 0.f};
#pragma unroll
            for (int r = 0; r < RG; ++r) { const f32x2 t = *(const LAS f32x2*)(TOT + r * K + c); if (r < rg) pre = pre + t; if (r * RPT < 32) bref = bref + t; tot = tot + t; }
            blast = tot;
#pragma unroll
            for (int i = 0; i < RPT; ++i) b[i] = b[i] + pre;
        } else {
#pragma unroll
            for (int i = 0; i < RPT; ++i) if (i & 7) b[i] = b[i] + b[i - 1];
        }
        unsigned kd0[RPT / 2], kd1[RPT / 2];
#pragma unroll
        for (int i = 0; i < RPT; i += 2) {
            float k0v[2], k1v[2];
#pragma unroll
            for (int e = 0; e < 2; ++e) {
                const int t = rg * RPT + i + e;
                const f32x2 bb = b[i + e], bl = is_prompt ? blast : b[(i + e) | 7];
                const float q0 = bflo(qw[i + e]), q1 = bfhi(qw[i + e]), k0 = bflo(kw[i + e]), k1 = bfhi(kw[i + e]);
                const float qi0 = q0 * __expf(bb.x), qi1 = q1 * __expf(bb.y);
                k0v[e] = k0 * __expf(bl.x - bb.x); k1v[e] = k1 * __expf(bl.y - bb.y);
                const float qt0 = is_prompt ? q0 * __expf(fminf(bb.x - bref.x, 80.f)) : qi0, qt1 = is_prompt ? q1 * __expf(fminf(bb.y - bref.y, 80.f)) : qi1;
                const float kt0 = k0 * __expf(fminf(bref.x - bb.x, 80.f)), kt1 = k1 * __expf(fminf(bref.y - bb.y, 80.f));
                *(unsigned*)(QI + (size_t)(r0 + t) * NHK + h * K + permK(c)) = pk2(qi0, qi1);
                *(LAS unsigned*)(lds + L_QT + t * KS + c * 2) = pk2(qt0, qt1);
                *(LAS unsigned*)(lds + L_KT + t * KS + c * 2) = pk2(kt0, kt1);
                if (!is_prompt && ((i + e) & 7) == 7) *(f32x2*)(DL + (size_t)(128 + (blk - 128) * 8 + (t >> 3)) * NHK + h * K + c) = (f32x2){__expf(bb.x), __expf(bb.y)};
            }
            kd0[i / 2] = pk2(k0v[0], k0v[1]); kd1[i / 2] = pk2(k1v[0], k1v[1]);
        }
        if (is_prompt && rg == 0) *(f32x2*)(DL + (size_t)blk * NHK + h * K + c) = (f32x2){__expf(blast.x), __expf(blast.y)};
        { bf16_t* kp = KDT + ((size_t)(blk * NH + h) * K + c) * 64 + rg * RPT;
#pragma unroll
          for (int n = 0; n < RPT / 8; ++n) { u32x4 w; w.x = kd0[4 * n]; w.y = kd0[4 * n + 1]; w.z = kd0[4 * n + 2]; w.w = kd0[4 * n + 3]; *(u32x4*)(kp + 8 * n) = w;
              u32x4 w2; w2.x = kd1[4 * n]; w2.y = kd1[4 * n + 1]; w2.z = kd1[4 * n + 2]; w2.w = kd1[4 * n + 3]; *(u32x4*)(kp + 64 + 8 * n) = w2; } }
        lds_barrier();
        { const int tt = wave >> 1;
          bf16x8 bfr[K / 32];
#pragma unroll
          for (int ks = 0; ks < K / 32; ++ks) bfr[ks] = *(const LAS bf16x8*)(lds + L_QT + (16 * tt + l15) * KS + ks * 64 + g4 * 16);
#pragma unroll
          for (int e = 0; e < 2; ++e) {
              const int st = (wave & 1) * 2 + e;
              f32x4 acc = (f32x4){0.f, 0.f, 0.f, 0.f};
              if (st <= tt) {
                  bf16x8 af[K / 32];
#pragma unroll
                  for (int ks = 0; ks < K / 32; ++ks) af[ks] = *(const LAS bf16x8*)(lds + L_KT + (16 * st + l15) * KS + ks * 64 + g4 * 16);
                  __builtin_amdgcn_sched_barrier(0);
#pragma unroll
                  for (int ks = 0; ks < K / 32; ++ks) acc = __builtin_amdgcn_mfma_f32_16x16x32_bf16(af[ks], bfr[ks], acc, 0, 0, 0);
                  __builtin_amdgcn_sched_barrier(0);
              }
              const int t = 16 * tt + l15; float o[4];
#pragma unroll
              for (int r = 0; r < 4; ++r) { const int sidx = 16 * st + 4 * g4 + r; const bool keep = (sidx <= t) && (is_prompt || (sidx >> 3) == (t >> 3)); o[r] = keep ? acc[r] : 0.f; }
              u32x2 w; w.x = pk2(o[0], o[1]); w.y = pk2(o[2], o[3]);
              *(u32x2*)(AM + ((size_t)(blk * NH + h) * 64 + t) * 64 + 16 * st + 4 * g4) = w;
          } }
    }
}

template <int VS> __device__ __forceinline__ void v_frag_tr2(unsigned a, bf16x8& f0, bf16x8& f1) {
    u32x2 r0, r1, r2, r3;
    asm volatile("ds_read_b64_tr_b16 %0, %4\n\tds_read_b64_tr_b16 %1, %5\n\tds_read_b64_tr_b16 %2, %6\n\tds_read_b64_tr_b16 %3, %7\n\ts_waitcnt lgkmcnt(0)"
                 : "=&v"(r0), "=&v"(r1), "=&v"(r2), "=&v"(r3) : "v"(a), "v"(a + 4 * VS), "v"(a + 32 * VS), "v"(a + 36 * VS) : "memory");
    union { u32x4 u; bf16x8 v; } x, y; x.u = (u32x4){r0.x, r0.y, r1.x, r1.y}; y.u = (u32x4){r2.x, r2.y, r3.x, r3.y}; f0 = x.v; f1 = y.v;
}
template <int VS> __device__ __forceinline__ bf16x8 v_frag_tr1(unsigned a) {
    u32x2 r0, r1;
    asm volatile("ds_read_b64_tr_b16 %0, %2\n\tds_read_b64_tr_b16 %1, %3\n\ts_waitcnt lgkmcnt(0)" : "=&v"(r0), "=&v"(r1) : "v"(a), "v"(a + 4 * VS) : "memory");
    union { u32x4 u; bf16x8 v; } x; x.u = (u32x4){r0.x, r0.y, r1.x, r1.y}; return x.v;
}

template <int K, int VH, int NH, bool FUSE>
__device__ __forceinline__ void scan_s2_old(const bf16_t* QI, const bf16_t* KDT, const bf16_t* AM, const bf16_t* VT, const float* DL, const float* S0, float* SPo, float* SSo, float* O,
                                        const bf16_t* Gin, bf16_t* OG, float* SSO, LAS unsigned char* lds, unsigned* qhead, int tid, int G, int bx) {
    constexpr int NVQ = VH / 128, NKT = K / 16, NKS = K / 32, QS = K * 2 + 16, RS = 144, NHK = NH * K;
    constexpr int L_QI = 0, L_KDT = L_QI + 64 * QS, L_A = L_KDT + K * RS, L_VT = L_A + 64 * RS, L_DL = L_VT + 128 * RS, L_END = L_DL + 8 * K * 4;
    constexpr int L_O = L_END, OTS = 132;
    static_assert((FUSE ? L_O + 64 * OTS * 4 : L_END) <= RING_BYTES && (!FUSE || VH == 128), "S2 LDS");
    LAS float* OT = (LAS float*)(lds + L_O);
    u32x4 gpre0 = (u32x4){0u, 0u, 0u, 0u}, gpre1 = gpre0;
#define S2_G_LOAD(blk_, h_, rb, nr) do { if (FUSE && tid < (nr) * 8) { const size_t _go = (size_t)((blk_) * 64 + (rb) + (tid >> 3)) * D + (h_) * VH + (tid & 7) * 16; gpre0 = *(const u32x4*)(Gin + _go); gpre1 = *(const u32x4*)(Gin + _go + 8); } } while (0)
#define S2_OG_EPI(blk_, h_, rb, nr) do { if (tid < (nr) * 8) { const int _t = (rb) + (tid >> 3), _seg = tid & 7; const LAS float* _op = OT + _t * OTS + _seg * 16; \
        const f32x4 _o0 = *(const LAS f32x4*)_op, _o1 = *(const LAS f32x4*)(_op + 4), _o2 = *(const LAS f32x4*)(_op + 8), _o3 = *(const LAS f32x4*)(_op + 12); \
        const size_t _go = (size_t)((blk_) * 64 + _t) * D + (h_) * VH + _seg * 16; const u32x4 _g0 = gpre0, _g1 = gpre1; \
        float _ss = ((_o0.x * _o0.x + _o0.y * _o0.y) + (_o0.z * _o0.z + _o0.w * _o0.w)) + ((_o1.x * _o1.x + _o1.y * _o1.y) + (_o1.z * _o1.z + _o1.w * _o1.w)) \
                  + ((_o2.x * _o2.x + _o2.y * _o2.y) + (_o2.z * _o2.z + _o2.w * _o2.w)) + ((_o3.x * _o3.x + _o3.y * _o3.y) + (_o3.z * _o3.z + _o3.w * _o3.w)); \
        u32x4 _w0, _w1; _w0.x = cvt_pk_bf16(_o0.x * bflo(_g0.x), _o0.y * bfhi(_g0.x)); _w0.y = cvt_pk_bf16(_o0.z * bflo(_g0.y), _o0.w * bfhi(_g0.y)); \
        _w0.z = cvt_pk_bf16(_o1.x * bflo(_g0.z), _o1.y * bfhi(_g0.z)); _w0.w = cvt_pk_bf16(_o1.z * bflo(_g0.w), _o1.w * bfhi(_g0.w)); \
        _w1.x = cvt_pk_bf16(_o2.x * bflo(_g1.x), _o2.y * bfhi(_g1.x)); _w1.y = cvt_pk_bf16(_o2.z * bflo(_g1.y), _o2.w * bfhi(_g1.y)); \
        _w1.z = cvt_pk_bf16(_o3.x * bflo(_g1.z), _o3.y * bfhi(_g1.z)); _w1.w = cvt_pk_bf16(_o3.z * bflo(_g1.w), _o3.w * bfhi(_g1.w)); \
        *(u32x4*)(OG + _go) = _w0; *(u32x4*)(OG + _go + 8) = _w1; \
        _ss += __shfl_xor(_ss, 1); _ss += __shfl_xor(_ss, 2); _ss += __shfl_xor(_ss, 4); \
        if (_seg == 0) SSO[(size_t)((blk_) * 64 + _t) * 16 + (h_)] = _ss; } } while (0)
    constexpr int P_QI = 64 * (K / 8) / 512, P_KD = K * 8 / 512;
    const int lane = tid & 63, wave = tid >> 6, l15 = lane & 15, g4 = lane >> 4;
    volatile LAS unsigned* qslot = (volatile LAS unsigned*)(lds + MISC_OFF + 64);
    const unsigned vtr_a = (unsigned)(size_t)(lds + L_VT) + (8 * g4 + (l15 >> 2)) * 272 + (16 * wave + 4 * (lane & 3)) * 2, vtr_a128 = vtr_a;

    u32x4 rq[P_QI], rk[P_KD], ra, rv[2], rd;
#define S2_LOAD(blk_, h_, vq_, ndl_) do { const int _blk = (blk_), _h = (h_), _vq = (vq_); \
        _Pragma("unroll") for (int n = 0; n < P_QI; ++n) { const int p = tid + n * 512, row = p / (K / 8), pc = p % (K / 8); rq[n] = *(const u32x4*)(QI + (size_t)(_blk * 64 + row) * NHK + _h * K + pc * 8); } \
        _Pragma("unroll") for (int n = 0; n < P_KD; ++n) { const int p = tid + n * 512; rk[n] = *(const u32x4*)(KDT + (size_t)(_blk * NH + _h) * K * 64 + (size_t)p * 8); } \
        ra = *(const u32x4*)(AM + (size_t)(_blk * NH + _h) * 4096 + (size_t)tid * 8); \
        _Pragma("unroll") for (int n = 0; n < 2; ++n) { const int p = tid + n * 512; rv[n] = *(const u32x4*)(VT + (size_t)(_blk * 64 + (p >> 4)) * D + _h * VH + _vq * 128 + (p & 15) * 8); } \
        if ((ndl_) == 1) { if (tid < K / 4) rd = *(const u32x4*)(DL + (size_t)_blk * NHK + _h * K + tid * 4); } \
        else { if (tid < 2 * K) { const int sg = tid / (K / 4), pc = tid % (K / 4); rd = *(const u32x4*)(DL + (size_t)(128 + (_blk - 128) * 8 + sg) * NHK + _h * K + pc * 4); } } } while (0)
#define S2_STORE(ndl_) do { \
        _Pragma("unroll") for (int n = 0; n < P_QI; ++n) { const int p = tid + n * 512, row = p / (K / 8), pc = p % (K / 8); *(LAS u32x4*)(lds + L_QI + row * QS + pc * 16) = rq[n]; } \
        _Pragma("unroll") for (int n = 0; n < P_KD; ++n) { const int p = tid + n * 512; *(LAS u32x4*)(lds + L_KDT + (p >> 3) * RS + (p & 7) * 16) = rk[n]; } \
        *(LAS u32x4*)(lds + L_A + (tid >> 3) * RS + (tid & 7) * 16) = ra; \
        _Pragma("unroll") for (int n = 0; n < 2; ++n) { const int p = tid + n * 512; *(LAS u32x4*)(lds + L_VT + (p >> 4) * 272 + (p & 15) * 16) = rv[n]; } \
        if ((ndl_) == 1) { if (tid < K / 4) *(LAS u32x4*)(lds + L_DL + tid * 16) = rd; } \
        else { if (tid < 2 * K) *(LAS u32x4*)(lds + L_DL + tid * 16) = rd; } } while (0)

    f32x4 S[NKT];
    if (bx < PB * NH * NVQ) {
        const int b = bx / (NH * NVQ), h = (bx / NVQ) % NH, vq = bx % NVQ;
        const int col = h * VH + vq * 128 + wave * 16 + l15;
#pragma unroll
        for (int kt = 0; kt < NKT; ++kt) S[kt] = (f32x4){0.f, 0.f, 0.f, 0.f};
        lds_barrier();
        S2_LOAD(b * 32, h, vq, 1); S2_STORE(1);
        lds_barrier();
#pragma unroll 1
        for (int ch = 0; ch < 32; ++ch) {
            const int blk = b * 32 + ch;
            if (ch + 1 < 32) S2_LOAD(blk + 1, h, vq, 1);
            S2_G_LOAD(blk, h, 0, 64);
            bf16x8 vfr[2];
            v_frag_tr2<272>(vtr_a, vfr[0], vfr[1]);
            f32x4 oacc[4];
#pragma unroll
            for (int tt = 0; tt < 4; ++tt) oacc[tt] = (f32x4){0.f, 0.f, 0.f, 0.f};
#pragma unroll
            for (int ks = 0; ks < NKS; ++ks) {
                bf16x8 aq[4];
#pragma unroll
                for (int tt = 0; tt < 4; ++tt) aq[tt] = *(const LAS bf16x8*)(lds + L_QI + (16 * tt + l15) * QS + ks * 64 + g4 * 16);
                __builtin_amdgcn_sched_barrier(0);
                union { u32x4 u; bf16x8 v; } sb;
                sb.u.x = cvt_pk_bf16(S[2 * ks][0], S[2 * ks][1]); sb.u.y = cvt_pk_bf16(S[2 * ks][2], S[2 * ks][3]);
                sb.u.z = cvt_pk_bf16(S[2 * ks + 1][0], S[2 * ks + 1][1]); sb.u.w = cvt_pk_bf16(S[2 * ks + 1][2], S[2 * ks + 1][3]);
#pragma unroll
                for (int tt = 0; tt < 4; ++tt) oacc[tt] = __builtin_amdgcn_mfma_f32_16x16x32_bf16(aq[tt], sb.v, oacc[tt], 0, 0, 0);
                __builtin_amdgcn_sched_barrier(0);
            }
#pragma unroll
            for (int tp = 0; tp < 2; ++tp) { bf16x8 aa[2][2];
#pragma unroll
              for (int i = 0; i < 2; ++i)
#pragma unroll
                  for (int ss = 0; ss < 2; ++ss) aa[i][ss] = *(const LAS bf16x8*)(lds + L_A + (16 * (2 * tp + i) + l15) * RS + ss * 64 + g4 * 16);
              __builtin_amdgcn_sched_barrier(0);
#pragma unroll
              for (int i = 0; i < 2; ++i)
#pragma unroll
                  for (int ss = 0; ss < 2; ++ss) oacc[2 * tp + i] = __builtin_amdgcn_mfma_f32_16x16x32_bf16(aa[i][ss], vfr[ss], oacc[2 * tp + i], 0, 0, 0);
              __builtin_amdgcn_sched_barrier(0); }
#pragma unroll
            for (int kh = 0; kh < NKT / 2; ++kh) {
                bf16x8 ak[2][2]; f32x4 dlv[2];
#pragma unroll
                for (int k2 = 0; k2 < 2; ++k2) { dlv[k2] = *(const LAS f32x4*)(lds + L_DL + (16 * (kh * 2 + k2) + 4 * g4) * 4);
#pragma unroll
                    for (int ss = 0; ss < 2; ++ss) ak[k2][ss] = *(const LAS bf16x8*)(lds + L_KDT + (16 * (kh * 2 + k2) + l15) * RS + ss * 64 + g4 * 16); }
                __builtin_amdgcn_sched_barrier(0);
#pragma unroll
                for (int k2 = 0; k2 < 2; ++k2) { const int kt = kh * 2 + k2; S[kt] = S[kt] * dlv[k2];
#pragma unroll
                    for (int ss = 0; ss < 2; ++ss) S[kt] = __builtin_amdgcn_mfma_f32_16x16x32_bf16(ak[k2][ss], vfr[ss], S[kt], 0, 0, 0); }
                __builtin_amdgcn_sched_barrier(0);
            }
#pragma unroll
            for (int tt = 0; tt < 4; ++tt)
#pragma unroll
                for (int r = 0; r < 4; ++r) { if (FUSE) OT[(16 * tt + 4 * g4 + r) * OTS + wave * 16 + l15] = oacc[tt][r]; else ((bf16_t*)O)[(size_t)(blk * 64 + 16 * tt + 4 * g4 + r) * D + col] = (bf16_t)pk2(oacc[tt][r], 0.f); }
            lds_barrier();
            if (ch + 1 < 32) S2_STORE(1);
            if (FUSE) S2_OG_EPI(blk, h, 0, 64);
            lds_barrier();
        }
        float* so = SPo + ((size_t)(b * NH + h) * K) * VH + vq * 128 + wave * 16 + l15;
#pragma unroll
        for (int kt = 0; kt < NKT; ++kt)
#pragma unroll
            for (int r = 0; r < 4; ++r) __builtin_nontemporal_store(S[kt][r], so + (size_t)(16 * kt + 4 * g4 + r) * VH);
    }
    constexpr int NTASK = 16 * NH * NVQ * 2;
    for (;;) {
        lds_barrier();
        if (tid == 0) qslot[0] = __hip_atomic_fetch_add(qhead, 1u, __ATOMIC_RELAXED, __HIP_MEMORY_SCOPE_AGENT);
        lds_barrier();
        const int task = (int)qslot[0];
        if (task >= NTASK) break;
        const int half = task & 1, vq = (task >> 1) % NVQ, h = (task / (2 * NVQ)) % NH, sblk = task / (2 * NVQ * NH), blk = 128 + sblk;
        const int col = h * VH + vq * 128 + wave * 16 + l15;
        S2_LOAD(blk, h, vq, 8); S2_STORE(8);
        S2_G_LOAD(blk, h, 32 * half, 32);
        lds_barrier();
        const bf16x8 vfr0 = v_frag_tr1<272>(vtr_a128 + half * 32 * 272);
#pragma unroll 1
        for (int jj = 0; jj < 4; ++jj) {
            const int j = half * 4 + jj, bseq = sblk * 8 + j;
            const float* s0 = S0 + ((size_t)(bseq * NH + h) * K) * VH + vq * 128 + wave * 16 + l15;
#pragma unroll
            for (int kt = 0; kt < NKT; ++kt)
#pragma unroll
                for (int r = 0; r < 4; ++r) S[kt][r] = __builtin_nontemporal_load(s0 + (size_t)(16 * kt + 4 * g4 + r) * VH);
            const int arow = 8 * j + (l15 & 7);
            constexpr int BQ = 4, BK = (NKT > 8) ? 4 : 8;
            const bf16x8 aAs = *(const LAS bf16x8*)(lds + L_A + arow * RS + half * 64 + g4 * 16);
            f32x4 oacc = (f32x4){0.f, 0.f, 0.f, 0.f};
#pragma unroll
            for (int qb = 0; qb < NKS / BQ; ++qb) {
                bf16x8 aqs[BQ];
#pragma unroll
                for (int i = 0; i < BQ; ++i) aqs[i] = *(const LAS bf16x8*)(lds + L_QI + arow * QS + (qb * BQ + i) * 64 + g4 * 16);
                __builtin_amdgcn_sched_barrier(0);
#pragma unroll
                for (int i = 0; i < BQ; ++i) { const int ks = qb * BQ + i;
                    union { u32x4 u; bf16x8 v; } sb;
                    sb.u.x = cvt_pk_bf16(S[2 * ks][0], S[2 * ks][1]); sb.u.y = cvt_pk_bf16(S[2 * ks][2], S[2 * ks][3]);
                    sb.u.z = cvt_pk_bf16(S[2 * ks + 1][0], S[2 * ks + 1][1]); sb.u.w = cvt_pk_bf16(S[2 * ks + 1][2], S[2 * ks + 1][3]);
                    oacc = __builtin_amdgcn_mfma_f32_16x16x32_bf16(aqs[i], sb.v, oacc, 0, 0, 0); }
                __builtin_amdgcn_sched_barrier(0);
            }
            oacc = __builtin_amdgcn_mfma_f32_16x16x32_bf16(aAs, vfr0, oacc, 0, 0, 0);
#pragma unroll
            for (int kh = 0; kh < NKT / BK; ++kh) {
                u32x4 akd[BK]; f32x4 dls[BK];
#pragma unroll
                for (int k8 = 0; k8 < BK; ++k8) { akd[k8] = *(const LAS u32x4*)(lds + L_KDT + (16 * (kh * BK + k8) + l15) * RS + half * 64 + g4 * 16);
                    dls[k8] = *(const LAS f32x4*)(lds + L_DL + j * K * 4 + (16 * (kh * BK + k8) + 4 * g4) * 4); }
                __builtin_amdgcn_sched_barrier(0);
#pragma unroll
                for (int k8 = 0; k8 < BK; ++k8) { const int kt = kh * BK + k8;
                    S[kt] = S[kt] * dls[k8];
                    union { u32x4 u; bf16x8 v; } af; af.u = akd[k8];
                    if (g4 != jj) af.u = (u32x4){0u, 0u, 0u, 0u};
                    S[kt] = __builtin_amdgcn_mfma_f32_16x16x32_bf16(af.v, vfr0, S[kt], 0, 0, 0); }
                __builtin_amdgcn_sched_barrier(0);
            }
            if (g4 < 2) {
#pragma unroll
                for (int r = 0; r < 4; ++r) { if (FUSE) OT[(8 * j + 4 * g4 + r) * OTS + wave * 16 + l15] = oacc[r]; else ((bf16_t*)O)[(size_t)(blk * 64 + 8 * j + 4 * g4 + r) * D + col] = (bf16_t)pk2(oacc[r], 0.f); }
            }
            float* so = SSo + ((size_t)(bseq * NH + h) * K) * VH + vq * 128 + wave * 16 + l15;
#pragma unroll
            for (int kt = 0; kt < NKT; ++kt)
#pragma unroll
                for (int r = 0; r < 4; ++r) __builtin_nontemporal_store(S[kt][r], so + (size_t)(16 * kt + 4 * g4 + r) * VH);
        }
        if (FUSE) { lds_barrier(); S2_OG_EPI(blk, h, 32 * half, 32); }
    }
#undef S2_OG_EPI
#undef S2_G_LOAD
#undef S2_LOAD
#undef S2_STORE
}

template <int K, int VH, int NH, bool FUSE>
__device__ __forceinline__ void scan_s2(const bf16_t* QI, const bf16_t* KDT, const bf16_t* AM, const bf16_t* VT, const float* DL, const float* S0, float* SPo, float* SSo, float* O,
                                        const bf16_t* Gin, bf16_t* OG, float* SSO, LAS unsigned char* lds, unsigned* qhead, int tid, int G, int bx) {
    constexpr int NVQ = VH / 128, NVQ2 = VH / 64, NKT = K / 16, NKS = K / 32, QS = K * 2 + 16, RS = 144, NHK = NH * K;
    constexpr int L_QI = 0, L_KDT = L_QI + 64 * QS, L_A = L_KDT + K * RS, L_VT = L_A + 64 * RS, L_DL = L_VT + 128 * RS, L_END = L_DL + 8 * K * 4;
    constexpr int L_O = L_END, OTS = 132;
    static_assert((FUSE ? L_O + 64 * OTS * 4 : L_END) <= RING_BYTES && (!FUSE || VH == 128), "S2 LDS");
    LAS float* OT = (LAS float*)(lds + L_O);
    u32x4 gpre0 = (u32x4){0u, 0u, 0u, 0u}, gpre1 = gpre0;
#define S2_G_LOAD(blk_, h_, rb, nr) do { if (FUSE && tid < (nr) * 8) { const size_t _go = (size_t)((blk_) * 64 + (rb) + (tid >> 3)) * D + (h_) * VH + (tid & 7) * 16; gpre0 = *(const u32x4*)(Gin + _go); gpre1 = *(const u32x4*)(Gin + _go + 8); } } while (0)
#define S2_OG_EPI(blk_, h_, rb, nr) do { if (tid < (nr) * 8) { const int _t = (rb) + (tid >> 3), _seg = tid & 7; const LAS float* _op = OT + _t * OTS + _seg * 16; \
        const f32x4 _o0 = *(const LAS f32x4*)_op, _o1 = *(const LAS f32x4*)(_op + 4), _o2 = *(const LAS f32x4*)(_op + 8), _o3 = *(const LAS f32x4*)(_op + 12); \
        const size_t _go = (size_t)((blk_) * 64 + _t) * D + (h_) * VH + _seg * 16; const u32x4 _g0 = gpre0, _g1 = gpre1; \
        float _ss = ((_o0.x * _o0.x + _o0.y * _o0.y) + (_o0.z * _o0.z + _o0.w * _o0.w)) + ((_o1.x * _o1.x + _o1.y * _o1.y) + (_o1.z * _o1.z + _o1.w * _o1.w)) \
                  + ((_o2.x * _o2.x + _o2.y * _o2.y) + (_o2.z * _o2.z + _o2.w * _o2.w)) + ((_o3.x * _o3.x + _o3.y * _o3.y) + (_o3.z * _o3.z + _o3.w * _o3.w)); \
        u32x4 _w0, _w1; _w0.x = cvt_pk_bf16(_o0.x * bflo(_g0.x), _o0.y * bfhi(_g0.x)); _w0.y = cvt_pk_bf16(_o0.z * bflo(_g0.y), _o0.w * bfhi(_g0.y)); \
        _w0.z = cvt_pk_bf16(_o1.x * bflo(_g0.z), _o1.y * bfhi(_g0.z)); _w0.w = cvt_pk_bf16(_o1.z * bflo(_g0.w), _o1.w * bfhi(_g0.w)); \
        _w1.x = cvt_pk_bf16(_o2.x * bflo(_g1.x), _o2.y * bfhi(_g1.x)); _w1.y = cvt_pk_bf16(_o2.z * bflo(_g1.y), _o2.w * bfhi(_g1.y)); \
        _w1.z = cvt_pk_bf16(_o3.x * bflo(_g1.z), _o3.y * bfhi(_g1.z)); _w1.w = cvt_pk_bf16(_o3.z * bflo(_g1.w), _o3.w * bfhi(_g1.w)); \
        *(u32x4*)(OG + _go) = _w0; *(u32x4*)(OG + _go + 8) = _w1; \
        _ss += __shfl_xor(_ss, 1); _ss += __shfl_xor(_ss, 2); _ss += __shfl_xor(_ss, 4); \
        if (_seg == 0) { SSO[(size_t)((blk_) * 64 + _t) * 32 + 2 * (h_)] = _ss; SSO[(size_t)((blk_) * 64 + _t) * 32 + 2 * (h_) + 1] = 0.f; } } } while (0)
#define S2_G_LOADP(blk_, h_, vq2_) do { if (FUSE && tid < 256) { const size_t _go = (size_t)((blk_) * 64 + (tid >> 2)) * D + (h_) * VH + (vq2_) * 64 + (tid & 3) * 16; gpre0 = *(const u32x4*)(Gin + _go); gpre1 = *(const u32x4*)(Gin + _go + 8); } } while (0)
#define S2_OG_EPIP(blk_, h_, vq2_) do { if (tid < 256) { const int _t = tid >> 2, _seg = tid & 3; const LAS float* _op = OT + _t * OTS + _seg * 16; \
        const f32x4 _o0 = *(const LAS f32x4*)_op, _o1 = *(const LAS f32x4*)(_op + 4), _o2 = *(const LAS f32x4*)(_op + 8), _o3 = *(const LAS f32x4*)(_op + 12); \
        const size_t _go = (size_t)((blk_) * 64 + _t) * D + (h_) * VH + (vq2_) * 64 + _seg * 16; const u32x4 _g0 = gpre0, _g1 = gpre1; \
        float _ss = ((_o0.x * _o0.x + _o0.y * _o0.y) + (_o0.z * _o0.z + _o0.w * _o0.w)) + ((_o1.x * _o1.x + _o1.y * _o1.y) + (_o1.z * _o1.z + _o1.w * _o1.w)) \
                  + ((_o2.x * _o2.x + _o2.y * _o2.y) + (_o2.z * _o2.z + _o2.w * _o2.w)) + ((_o3.x * _o3.x + _o3.y * _o3.y) + (_o3.z * _o3.z + _o3.w * _o3.w)); \
        u32x4 _w0, _w1; _w0.x = cvt_pk_bf16(_o0.x * bflo(_g0.x), _o0.y * bfhi(_g0.x)); _w0.y = cvt_pk_bf16(_o0.z * bflo(_g0.y), _o0.w * bfhi(_g0.y)); \
        _w0.z = cvt_pk_bf16(_o1.x * bflo(_g0.z), _o1.y * bfhi(_g0.z)); _w0.w = cvt_pk_bf16(_o1.z * bflo(_g0.w), _o1.w * bfhi(_g0.w)); \
        _w1.x = cvt_pk_bf16(_o2.x * bflo(_g1.x), _o2.y * bfhi(_g1.x)); _w1.y = cvt_pk_bf16(_o2.z * bflo(_g1.y), _o2.w * bfhi(_g1.y)); \
        _w1.z = cvt_pk_bf16(_o3.x * bflo(_g1.z), _o3.y * bfhi(_g1.z)); _w1.w = cvt_pk_bf16(_o3.z * bflo(_g1.w), _o3.w * bfhi(_g1.w)); \
        *(u32x4*)(OG + _go) = _w0; *(u32x4*)(OG + _go + 8) = _w1; \
        _ss += __shfl_xor(_ss, 1); _ss += __shfl_xor(_ss, 2); \
        if (_seg == 0) SSO[(size_t)((blk_) * 64 + _t) * 32 + 2 * (h_) + (vq2_)] = _ss; } } while (0)
    constexpr int P_QI = 64 * (K / 8) / 512, P_KD = K * 8 / 512;
    const int lane = tid & 63, wave = tid >> 6, l15 = lane & 15, g4 = lane >> 4;
    volatile LAS unsigned* qslot = (volatile LAS unsigned*)(lds + MISC_OFF + 64);
    const unsigned vtr_a128 = (unsigned)(size_t)(lds + L_VT) + (8 * g4 + (l15 >> 2)) * 272 + (16 * wave + 4 * (lane & 3)) * 2;
    const unsigned vtr_a64 = (unsigned)(size_t)(lds + L_VT) + (8 * g4 + (l15 >> 2)) * 144 + (16 * (wave & 3) + 4 * (lane & 3)) * 2;

    u32x4 rq[P_QI], rk[P_KD], ra, rv[2], rd;
#define S2_LOAD(blk_, h_, vcol0_, nvrows_, ndl_) do { const int _blk = (blk_), _h = (h_), _vc0 = (vcol0_); \
        _Pragma("unroll") for (int n = 0; n < P_QI; ++n) { const int p = tid + n * 512, row = p / (K / 8), pc = p % (K / 8); rq[n] = *(const u32x4*)(QI + (size_t)(_blk * 64 + row) * NHK + _h * K + pc * 8); } \
        _Pragma("unroll") for (int n = 0; n < P_KD; ++n) { const int p = tid + n * 512; rk[n] = *(const u32x4*)(KDT + (size_t)(_blk * NH + _h) * K * 64 + (size_t)p * 8); } \
        ra = *(const u32x4*)(AM + (size_t)(_blk * NH + _h) * 4096 + (size_t)tid * 8); \
        _Pragma("unroll") for (int n = 0; n < 2; ++n) { const int p = tid + n * 512; constexpr int _pr = (nvrows_) / 8; if (p < (nvrows_) * 8) rv[n] = *(const u32x4*)(VT + (size_t)(_blk * 64 + p / _pr) * D + _h * VH + _vc0 + (p % _pr) * 8); } \
        if ((ndl_) == 1) { if (tid < K / 4) rd = *(const u32x4*)(DL + (size_t)_blk * NHK + _h * K + tid * 4); } \
        else { if (tid < 2 * K) { const int sg = tid / (K / 4), pc = tid % (K / 4); rd = *(const u32x4*)(DL + (size_t)(128 + (_blk - 128) * 8 + sg) * NHK + _h * K + pc * 4); } } } while (0)
#define S2_STORE(nvrows_, ndl_) do { \
        _Pragma("unroll") for (int n = 0; n < P_QI; ++n) { const int p = tid + n * 512, row = p / (K / 8), pc = p % (K / 8); *(LAS u32x4*)(lds + L_QI + row * QS + pc * 16) = rq[n]; } \
        _Pragma("unroll") for (int n = 0; n < P_KD; ++n) { const int p = tid + n * 512; *(LAS u32x4*)(lds + L_KDT + (p >> 3) * RS + (p & 7) * 16) = rk[n]; } \
        *(LAS u32x4*)(lds + L_A + (tid >> 3) * RS + (tid & 7) * 16) = ra; \
        _Pragma("unroll") for (int n = 0; n < 2; ++n) { const int p = tid + n * 512; constexpr int _pr = (nvrows_) / 8, _vs = (nvrows_) == 64 ? 144 : 272; if (p < (nvrows_) * 8) *(LAS u32x4*)(lds + L_VT + (p / _pr) * _vs + (p % _pr) * 16) = rv[n]; } \
        if ((ndl_) == 1) { if (tid < K / 4) *(LAS u32x4*)(lds + L_DL + tid * 16) = rd; } \
        else { if (tid < 2 * K) *(LAS u32x4*)(lds + L_DL + tid * 16) = rd; } } while (0)

    f32x4 S[NKT];
    if (FUSE && bx < PB * NH * NVQ2) {
        const int vq2 = bx / (PB * NH), b = (bx % (PB * NH)) / NH, h = bx % NH;
        const int col = h * VH + vq2 * 64 + (wave & 3) * 16 + l15;
        const bool act = wave < 4;
#pragma unroll
        for (int kt = 0; kt < NKT; ++kt) S[kt] = (f32x4){0.f, 0.f, 0.f, 0.f};
        lds_barrier();
        S2_LOAD(b * 32, h, vq2 * 64, 64, 1); S2_STORE(64, 1);
        lds_barrier();
#pragma unroll 1
        for (int ch = 0; ch < 32; ++ch) {
            const int blk = b * 32 + ch;
            if (ch + 1 < 32) S2_LOAD(blk + 1, h, vq2 * 64, 64, 1);
            S2_G_LOADP(blk, h, vq2);
            if (act) {
            bf16x8 vfr[2], aq[NKS][4];
#pragma unroll
            for (int ks = 0; ks < NKS; ++ks)
#pragma unroll
                for (int tt = 0; tt < 4; ++tt) aq[ks][tt] = *(const LAS bf16x8*)(lds + L_QI + (16 * tt + l15) * QS + ks * 64 + g4 * 16);
            v_frag_tr2<144>(vtr_a64, vfr[0], vfr[1]);
            __builtin_amdgcn_sched_barrier(0);
            f32x4 oacc[4];
#pragma unroll
            for (int tt = 0; tt < 4; ++tt) oacc[tt] = (f32x4){0.f, 0.f, 0.f, 0.f};
#pragma unroll
            for (int ks = 0; ks < NKS; ++ks) {
                union { u32x4 u; bf16x8 v; } sb;
                sb.u.x = cvt_pk_bf16(S[2 * ks][0], S[2 * ks][1]); sb.u.y = cvt_pk_bf16(S[2 * ks][2], S[2 * ks][3]);
                sb.u.z = cvt_pk_bf16(S[2 * ks + 1][0], S[2 * ks + 1][1]); sb.u.w = cvt_pk_bf16(S[2 * ks + 1][2], S[2 * ks + 1][3]);
#pragma unroll
                for (int tt = 0; tt < 4; ++tt) oacc[tt] = __builtin_amdgcn_mfma_f32_16x16x32_bf16(aq[ks][tt], sb.v, oacc[tt], 0, 0, 0);
            }
            __builtin_amdgcn_sched_barrier(0);
            { bf16x8 aa[4][2]; f32x4 dlv[NKT];
#pragma unroll
              for (int tt = 0; tt < 4; ++tt)
#pragma unroll
                  for (int ss = 0; ss < 2; ++ss) aa[tt][ss] = *(const LAS bf16x8*)(lds + L_A + (16 * tt + l15) * RS + ss * 64 + g4 * 16);
#pragma unroll
              for (int kt = 0; kt < NKT; ++kt) dlv[kt] = *(const LAS f32x4*)(lds + L_DL + (16 * kt + 4 * g4) * 4);
              __builtin_amdgcn_sched_barrier(0);
#pragma unroll
              for (int tt = 0; tt < 4; ++tt)
#pragma unroll
                  for (int ss = 0; ss < 2; ++ss) oacc[tt] = __builtin_amdgcn_mfma_f32_16x16x32_bf16(aa[tt][ss], vfr[ss], oacc[tt], 0, 0, 0);
#pragma unroll
              for (int kt = 0; kt < NKT; ++kt) S[kt] = S[kt] * dlv[kt];
            }
            __builtin_amdgcn_sched_barrier(0);
#pragma unroll
            for (int kh = 0; kh < NKT / 8; ++kh) {
                bf16x8 ak[8][2];
#pragma unroll
                for (int k8 = 0; k8 < 8; ++k8)
#pragma unroll
                    for (int ss = 0; ss < 2; ++ss) ak[k8][ss] = *(const LAS bf16x8*)(lds + L_KDT + (16 * (kh * 8 + k8) + l15) * RS + ss * 64 + g4 * 16);
                __builtin_amdgcn_sched_barrier(0);
#pragma unroll
                for (int k8 = 0; k8 < 8; ++k8)
#pragma unroll
                    for (int ss = 0; ss < 2; ++ss) S[kh * 8 + k8] = __builtin_amdgcn_mfma_f32_16x16x32_bf16(ak[k8][ss], vfr[ss], S[kh * 8 + k8], 0, 0, 0);
                __builtin_amdgcn_sched_barrier(0);
            }
#pragma unroll
            for (int tt = 0; tt < 4; ++tt)
#pragma unroll
                for (int r = 0; r < 4; ++r) { if (FUSE) OT[(16 * tt + 4 * g4 + r) * OTS + wave * 16 + l15] = oacc[tt][r]; else O[(size_t)(blk * 64 + 16 * tt + 4 * g4 + r) * D + col] = oacc[tt][r]; }
            }
            lds_barrier();
            if (ch + 1 < 32) S2_STORE(64, 1);
            if (FUSE) S2_OG_EPIP(blk, h, vq2);
            lds_barrier();
        }
        if (act) {
        float* so = SPo + ((size_t)(b * NH + h) * K) * VH + vq2 * 64 + wave * 16 + l15;
#pragma unroll
        for (int kt = 0; kt < NKT; ++kt)
#pragma unroll
            for (int r = 0; r < 4; ++r) __builtin_nontemporal_store(S[kt][r], so + (size_t)(16 * kt + 4 * g4 + r) * VH);
        }
    }
    constexpr int NTASK = 16 * NH * NVQ * 2;
    for (;;) {
        lds_barrier();
        if (tid == 0) qslot[0] = __hip_atomic_fetch_add(qhead, 1u, __ATOMIC_RELAXED, __HIP_MEMORY_SCOPE_AGENT);
        lds_barrier();
        const int task = (int)qslot[0];
        if (task >= NTASK) break;
        const int half = task & 1, vq = (task >> 1) % NVQ, h = (task / (2 * NVQ)) % NH, sblk = task / (2 * NVQ * NH), blk = 128 + sblk;
        const int col = h * VH + vq * 128 + wave * 16 + l15;
        S2_LOAD(blk, h, vq * 128, 128, 8); S2_STORE(128, 8);
        S2_G_LOAD(blk, h, 32 * half, 32);
        lds_barrier();
        const bf16x8 vfr0 = v_frag_tr1<272>(vtr_a128 + half * 32 * 272);
#pragma unroll 1
        for (int jj = 0; jj < 4; ++jj) {
            const int j = half * 4 + jj, bseq = sblk * 8 + j;
            const float* s0 = S0 + ((size_t)(bseq * NH + h) * K) * VH + vq * 128 + wave * 16 + l15;
#pragma unroll
            for (int kt = 0; kt < NKT; ++kt)
#pragma unroll
                for (int r = 0; r < 4; ++r) S[kt][r] = __builtin_nontemporal_load(s0 + (size_t)(16 * kt + 4 * g4 + r) * VH);
            const int arow = 8 * j + (l15 & 7);
            constexpr int BQ = 4, BK = (NKT > 8) ? 4 : 8;
            const bf16x8 aAs = *(const LAS bf16x8*)(lds + L_A + arow * RS + half * 64 + g4 * 16);
            f32x4 oacc = (f32x4){0.f, 0.f, 0.f, 0.f};
#pragma unroll
            for (int qb = 0; qb < NKS / BQ; ++qb) {
                bf16x8 aqs[BQ];
#pragma unroll
                for (int i = 0; i < BQ; ++i) aqs[i] = *(const LAS bf16x8*)(lds + L_QI + arow * QS + (qb * BQ + i) * 64 + g4 * 16);
                __builtin_amdgcn_sched_barrier(0);
#pragma unroll
                for (int i = 0; i < BQ; ++i) { const int ks = qb * BQ + i;
                    union { u32x4 u; bf16x8 v; } sb;
                    sb.u.x = cvt_pk_bf16(S[2 * ks][0], S[2 * ks][1]); sb.u.y = cvt_pk_bf16(S[2 * ks][2], S[2 * ks][3]);
                    sb.u.z = cvt_pk_bf16(S[2 * ks + 1][0], S[2 * ks + 1][1]); sb.u.w = cvt_pk_bf16(S[2 * ks + 1][2], S[2 * ks + 1][3]);
                    oacc = __builtin_amdgcn_mfma_f32_16x16x32_bf16(aqs[i], sb.v, oacc, 0, 0, 0); }
                __builtin_amdgcn_sched_barrier(0);
            }
            oacc = __builtin_amdgcn_mfma_f32_16x16x32_bf16(aAs, vfr0, oacc, 0, 0, 0);
#pragma unroll
            for (int kh = 0; kh < NKT / BK; ++kh) {
                u32x4 akd[BK]; f32x4 dls[BK];
#pragma unroll
                for (int k8 = 0; k8 < BK; ++k8) { akd[k8] = *(const LAS u32x4*)(lds + L_KDT + (16 * (kh * BK + k8) + l15) * RS + half * 64 + g4 * 16);
                    dls[k8] = *(const LAS f32x4*)(lds + L_DL + j * K * 4 + (16 * (kh * BK + k8) + 4 * g4) * 4); }
                __builtin_amdgcn_sched_barrier(0);
#pragma unroll
                for (int k8 = 0; k8 < BK; ++k8) { const int kt = kh * BK + k8;
                    S[kt] = S[kt] * dls[k8];
                    union { u32x4 u; bf16x8 v; } af; af.u = akd[k8];
                    if (g4 != jj) af.u = (u32x4){0u, 0u, 0u, 0u};
                    S[kt] = __builtin_amdgcn_mfma_f32_16x16x32_bf16(af.v, vfr0, S[kt], 0, 0, 0); }
                __builtin_amdgcn_sched_barrier(0);
            }
            if (g4 < 2) {
#pragma unroll
                for (int r = 0; r < 4; ++r) { if (FUSE) OT[(8 * j + 4 * g4 + r) * OTS + wave * 16 + l15] = oacc[r]; else O[(size_t)(blk * 64 + 8 * j + 4 * g4 + r) * D + col] = oacc[r]; }
            }
            float* so = SSo + ((size_t)(bseq * NH + h) * K) * VH + vq * 128 + wave * 16 + l15;
#pragma unroll
            for (int kt = 0; kt < NKT; ++kt)
#pragma unroll
                for (int r = 0; r < 4; ++r) __builtin_nontemporal_store(S[kt][r], so + (size_t)(16 * kt + 4 * g4 + r) * VH);
        }
        if (FUSE) { lds_barrier(); S2_OG_EPI(blk, h, 32 * half, 32); }
    }
#undef S2_OG_EPI
#undef S2_OG_EPIP
#undef S2_G_LOADP
#undef S2_G_LOAD
#undef S2_LOAD
#undef S2_STORE
}

template <int NR>
__device__ __forceinline__ void pool_segment(const float* X, int row0, int tabs0  , const float* hsrc, const LAS float* rs  ,
                                             const f32x4 gain, int w, bool is_prompt, bf16_t* Y, float* pstate  , float* sstate  , int c0) {
    f32x4 ring[16]; f32x4 wsum = (f32x4){0.f, 0.f, 0.f, 0.f};
#pragma unroll
    for (int i = 0; i < 16; ++i) ring[i] = (f32x4){0.f, 0.f, 0.f, 0.f};
#pragma unroll
    for (int i = 0; i < 15 + NR; ++i) {
        f32x4 val;
        if (i < 15) {
            if (hsrc) val = *(const f32x4*)(hsrc + (size_t)i * D + c0);
            else { const int t = tabs0 - 15 + i; val = (t >= 0) ? *(const f32x4*)(X + (size_t)(row0 - 15 + i) * D + c0) * rs[i] * gain : (f32x4){0.f, 0.f, 0.f, 0.f}; }
        } else val = *(const f32x4*)(X + (size_t)(row0 + i - 15) * D + c0) * rs[i] * gain;
        const f32x4 old = (w == 2) ? ring[(i - 2) & 15] : (w == 4) ? ring[(i - 4) & 15] : (w == 8) ? ring[(i - 8) & 15] : ring[i & 15];
        wsum = wsum + val - old;
        ring[i & 15] = val;
        if (i >= 15) {
            const int t = i - 15;
            float cnt = (float)w; if (is_prompt) { const int have = tabs0 + t + 1; cnt = (float)(have < w ? have : w); }
            const float ic = 1.f / cnt;
            const f32x4 y = wsum * ic - val;
            u32x2 o; o.x = pk2(y.x, y.y); o.y = pk2(y.z, y.w);
            *(u32x2*)(Y + (size_t)(row0 + t) * D + c0) = o;
            if (is_prompt) { if (pstate) { const int tt = tabs0 + t - (PT - POOLBUF); if (tt >= 0) *(f32x4*)(pstate + (size_t)tt * D + c0) = val; } }
            else *(f32x4*)(sstate + (size_t)(7 + t) * D + c0) = val;
        }
    }
    if (!is_prompt) {
#pragma unroll
        for (int i = 0; i < 7; ++i) *(f32x4*)(sstate + (size_t)i * D + c0) = *(const f32x4*)(hsrc + (size_t)(8 + i) * D + c0);
    }
}
__device__ __forceinline__ void pool_pre_phase(CParams* P, LAS unsigned char* lds, float* X, const float* gain, bf16_t* Y, int tid, int wave, int lane, int G) {
    LAS float* rs = (LAS float*)lds;
    const int c0 = tid * 4, w = 2 << (c0 >> 9);
    const f32x4 g4 = *(const f32x4*)(gain + c0);
    for (int u = blockIdx.x; u < M / 32; u += G) {
        const int r0 = u * 32; const bool is_prompt = r0 < MP;
        __syncthreads();
        for (int i = wave; i < 47; i += NWAVES) {
            const int row = r0 - 15 + i;
            const bool need = is_prompt ? ((r0 % PT) - 15 + i >= 0) : (i >= 15);
            float r = 0.f;
            if (need) { const f32x4* xr = (const f32x4*)(X + (size_t)row * D) + lane; float s = 0.f; f32x4 v[8];
#pragma unroll
                for (int j = 0; j < 8; ++j) v[j] = xr[64 * j];
#pragma unroll
                for (int j = 0; j < 8; ++j) s += (v[j].x * v[j].x + v[j].y * v[j].y) + (v[j].z * v[j].z + v[j].w * v[j].w);
                r = __builtin_amdgcn_rsqf(wave_sum(s) * (1.f / D) + EPS); }
            if (lane == 0) rs[i] = r;
        }
        __syncthreads();
        if (is_prompt) {
            const int b = r0 / PT, t0 = r0 % PT;
            float* pst = (t0 + 32 == PT) ? P->out + OUT_POOL_P + (size_t)b * POOLBUF * D : nullptr;
            pool_segment<32>(X, r0, t0, nullptr, rs, g4, w, true, Y, pst, nullptr, c0);
        } else {
            for (int sgi = 0; sgi < 4; ++sgi) {
                const int b = (r0 - MP) / ST + sgi;
                pool_segment<8>(X, r0 + sgi * 8, 0, P->in[I_SPOOL] + (size_t)b * POOLBUF * D, rs + sgi * 8, g4, w, false, Y, nullptr, P->out + OUT_POOL_S + (size_t)b * POOLBUF * D, c0);
            }
        }
    }
}

constexpr int NPHASE = 51;
__host__ __device__ inline bool phase_exists(int ph) { if (ph == 0 || ph == NPHASE - 1) return true; const int li = (ph - 1) / 12, k = (ph - 1) % 12, kind = li % 3;
    if (k == 0) return li > 0;
    if (li >= NLAYER) return false;
    if (k == 5 || k == 6) return kind != 2;
    if (k == 7) return kind == 1;
    return true; }

__device__ __forceinline__ CParams* fresh_params() { CParams* p = (CParams*)__builtin_amdgcn_kernarg_segment_ptr(); asm volatile("" : "+s"(p)); return p; }
__device__ __forceinline__ int fresh_tid(int wave0) { int l = __builtin_amdgcn_mbcnt_hi(~0u, __builtin_amdgcn_mbcnt_lo(~0u, 0u)); asm volatile("" : "+v"(l)); return wave0 * 64 + l; }
#define SITE_BEGIN CParams* pp = fresh_params(); unsigned char* ws = pp->ws; const int tid = fresh_tid(wave0), lane = tid & 63, wave = __builtin_amdgcn_readfirstlane(tid >> 6), G = gridDim.x, bx = blockIdx.x, gw = bx * NWAVES + wave, NGW = G * NWAVES, vbx = __builtin_amdgcn_readfirstlane((int)((volatile LAS unsigned*)(lds + MISC_OFF))[20]); \
    (void)vbx; (void)ws; (void)lane; (void)wave; (void)gw; (void)NGW; (void)tid; (void)G; (void)bx;
#define WSP(T, off) ((T*)(ws + (off)))

__global__ void __launch_bounds__(NTHREADS, 2) mega_fwd(Params P) {
    extern __shared__ __attribute__((aligned(16))) unsigned char lds_raw[];
    LAS unsigned char* lds = (LAS unsigned char*)lds_raw;
    volatile LAS unsigned* MISC = (volatile LAS unsigned*)(lds + MISC_OFF);
    const int wave0 = __builtin_amdgcn_readfirstlane(threadIdx.x >> 6);
    for (int u = threadIdx.x; u < (LDS_BYTES - LDSCTL_OFF) / 4; u += NTHREADS) ((LAS unsigned*)(lds + LDSCTL_OFF))[u] = 0u;
    __syncthreads();
    if (threadIdx.x == 0) { const unsigned x = xb_xcc_id() & 7u; const unsigned rk = __hip_atomic_fetch_add((unsigned*)(P.ws + WS_CTL) + CW_XRANK + 64 * x, 1u, __ATOMIC_RELAXED, __HIP_MEMORY_SCOPE_AGENT);
        ((volatile LAS unsigned*)(lds + MISC_OFF))[20] = rk < 32u ? rk * 8u + x : blockIdx.x; }
    __syncthreads();
    const int lo = P.ph_lo, hi = P.ph_hi;
    XcdBarrier bar; bar.bar = (unsigned*)(P.ws + WS_CTL) + CW_BAR; bar.x = 0; bar.st = nullptr;
    if (hi - lo > 1) bar = xcd_barrier_post((unsigned*)(P.ws + WS_CTL) + CW_BAR, MISC + 8);
    unsigned long long probe_acc = 0ull, probe_t0 = 0ull; (void)probe_acc; (void)probe_t0;
#define IN(k) ((probe_t0 = (PROBE_MASK != 0 && (((k) > 0 && (k) < NPHASE - 1 && ((PROBE_MASK >> (((k) - 1) % 12)) & 1)) || ((k) == 0 && ((PROBE_MASK >> 12) & 1)))) ? __builtin_amdgcn_s_memrealtime() : 0ull), (lo <= (k) && (k) < hi))
#define SEAM(k) do { if ((k) + 1 < hi) xcd_barrier(bar, fresh_tid(wave0) == 0); if (PROBE_MASK != 0 && probe_t0 != 0ull) { probe_acc += __builtin_amdgcn_s_memrealtime() - probe_t0; probe_t0 = 0ull; } } while (0)

    if (IN(0)) { for (int rep = 0; rep < REP_PRO; ++rep) { { SITE_BEGIN prologue_phase(pp, lds, gw, NGW, wave, lane); } SEAM(0); } }

#pragma unroll 1
    for (int li = 0; li < NLAYER; ++li) {
        const int pb = 1 + li * 12, kind = li % 3, j = li / 3;
#pragma unroll 1
        for (int which = 0; which < 2; ++which) {
            const int p0 = pb + (which ? 9 : 0), s = li * 2 + which;
            if (IN(p0 + 1)) {
#pragma unroll 1
                for (int rep = 0; rep < REP_GU; ++rep) {
                { SITE_BEGIN
                pg8::Gemm g{WSP(bf16_t, WS_XN), (const bf16_t*)(ws + WS_WGU + (size_t)s * SZ_WGU1), D, D, D, M / 256, 2 * FF / 256, 0};
                pg8::TailSplitOrder<M / 256, 2 * FF / 256, D / 64, 256> S; S.init(vbx);
                EpiGU E{WSP(bf16_t, WS_H), WSP(const float, WS_R), WSP(float, WS_PART), WSP(unsigned, WS_CTL) + CW_GUFLAG + 64 * s};
                pg8::gemm_phase(lds, g, S, E, tid); }
                SEAM(p0 + 1); }
            }
            if (IN(p0 + 2)) {
                { SITE_BEGIN
                pg8::Gemm g{WSP(bf16_t, WS_H), (const bf16_t*)(ws + WS_WDN + (size_t)s * SZ_WDN1), FF, FF, FF, M / 256, D / 256, 0};
                pg8::ResOrder S; S.init(vbx, g.K / 64);
                EpiRes<0, 1> E{WSP(float, WS_X), WSP(bf16_t, WS_XN), WSP(float, WS_SS), nullptr, nullptr, WSP(float, WS_PART)};
                pg8::gemm_phase(lds, g, S, E, tid); }
                SEAM(p0 + 2);
            }
            if (!(li == NLAYER - 1 && which == 1)   && IN(p0 + 3)) { { SITE_BEGIN fix_phase<0, 1>(WSP(float, WS_X), WSP(bf16_t, WS_XN), WSP(float, WS_SS), WSP(float, WS_R), WSP(const float, WS_PART), 8, nullptr, nullptr, lds, bx, wave, gw, NGW, lane); } SEAM(p0 + 3); }
            if (which == 1) continue;
            if (kind == 0) {
                if (IN(pb + 4)) {
                    { SITE_BEGIN
                    pg8::Gemm g{WSP(bf16_t, WS_XN), WSP(const bf16_t, WS_WHIN) + (size_t)j * 8192 * D, D, D, D, M / 256, 8192 / 256, 0};
                    pg8::StaticOrder S; S.init(g.nM, g.nN, G, vbx, g.K / 64);
                    EpiHG E{WSP(bf16_t, WS_Q), WSP(bf16_t, WS_KK), WSP(bf16_t, WS_V), WSP(bf16_t, WS_G), WSP(float, WS_LF), WSP(const float, WS_TAB) + (size_t)j * D, WSP(const float, WS_SS)};
                    pg8::gemm_phase(lds, g, S, E, tid); }
                    SEAM(pb + 4);
                }
#pragma unroll 1
                for (int rep = 0; rep < REP_SCAN; ++rep) {
                if (IN(pb + 5)) {
                    { SITE_BEGIN
                    scan_s1<HG_K, HG_V, HG_H>(WSP(bf16_t, WS_Q), WSP(bf16_t, WS_KK), WSP(float, WS_LF), WSP(bf16_t, WS_V), WSP(bf16_t, WS_QI), WSP(bf16_t, WS_KDT), WSP(bf16_t, WS_AM), WSP(bf16_t, WS_VT), WSP(float, WS_DL), lds, tid, G, bx); }
                    SEAM(pb + 5);
                }
                if (IN(pb + 6)) {
                    { SITE_BEGIN
                    scan_s2<HG_K, HG_V, HG_H, true>(WSP(bf16_t, WS_QI), WSP(bf16_t, WS_KDT), WSP(bf16_t, WS_AM), WSP(bf16_t, WS_V), WSP(float, WS_DL), pp->in[I_SHG] + (size_t)j * SB * HG_H * HG_K * HG_V,
                        pp->out + OUT_HG_P + (size_t)j * PB * HG_H * HG_K * HG_V, pp->out + OUT_HG_S + (size_t)j * SB * HG_H * HG_K * HG_V, nullptr,
                        WSP(const bf16_t, WS_G), WSP(bf16_t, WS_OG), WSP(float, WS_SSO), lds, WSP(unsigned, WS_CTL) + CW_QUEUE + 64 * li + 16 * rep, tid, G, bx); }
                    SEAM(pb + 6);
                }
                }
                if (IN(pb + 8)) {
                    { SITE_BEGIN
                    pg8::Gemm g{WSP(bf16_t, WS_OG), WSP(const bf16_t, WS_WHOUT) + (size_t)j * D * D, D, D, D, M / 256, D / 256, 0};
                    pg8::ResOrder S; S.init(vbx, g.K / 64);
                    EpiRes<32, 0> E{WSP(float, WS_X), WSP(bf16_t, WS_XN), WSP(float, WS_SS), nullptr, WSP(const float, WS_SSO), WSP(float, WS_PART)};
                    pg8::gemm_phase(lds, g, S, E, tid); }
                    SEAM(pb + 8);
                }
                if (IN(pb + 9)) { { SITE_BEGIN fix_phase<32, 0>(WSP(float, WS_X), WSP(bf16_t, WS_XN), WSP(float, WS_SS), WSP(float, WS_R), WSP(const float, WS_PART), 8, nullptr, WSP(const float, WS_SSO), lds, bx, wave, gw, NGW, lane); } SEAM(pb + 9); }
            } else if (kind == 1) {
                if (IN(pb + 4)) {
                    { SITE_BEGIN
                    pg8::Gemm g{WSP(bf16_t, WS_XN), WSP(const bf16_t, WS_WGIN), D, D, D, M / 256, GL_NIN / 256, 0};
                    pg8::StaticOrder S; S.init(g.nM, g.nN, G, vbx, g.K / 64);
                    EpiGLA E{WSP(bf16_t, WS_Q), WSP(bf16_t, WS_KK), WSP(bf16_t, WS_V), WSP(bf16_t, WS_G), WSP(float, WS_LF), pp->in[I_GBG] + (size_t)j * GL_DK, WSP(const float, WS_SS)};
                    pg8::gemm_phase(lds, g, S, E, tid); }
                    SEAM(pb + 4);
                }
#pragma unroll 1
                for (int rep = 0; rep < REP_SCAN; ++rep) {
                if (IN(pb + 5)) {
                    { SITE_BEGIN
                    scan_s1<GL_K, GL_V, GL_H>(WSP(bf16_t, WS_Q), WSP(bf16_t, WS_KK), WSP(float, WS_LF), WSP(bf16_t, WS_V), WSP(bf16_t, WS_QI), WSP(bf16_t, WS_KDT), WSP(bf16_t, WS_AM), WSP(bf16_t, WS_VT), WSP(float, WS_DL), lds, tid, G, bx); }
                    SEAM(pb + 5);
                }
                if (IN(pb + 6)) {
                    { SITE_BEGIN
                    scan_s2_old<GL_K, GL_V, GL_H, false>(WSP(bf16_t, WS_QI), WSP(bf16_t, WS_KDT), WSP(bf16_t, WS_AM), WSP(bf16_t, WS_V), WSP(float, WS_DL), pp->in[I_SGLA] + (size_t)j * SB * GL_H * GL_K * GL_V,
                        pp->out + OUT_GLA_P + (size_t)j * PB * GL_H * GL_K * GL_V, pp->out + OUT_GLA_S + (size_t)j * SB * GL_H * GL_K * GL_V, WSP(float, WS_O),
                        nullptr, nullptr, nullptr, lds, WSP(unsigned, WS_CTL) + CW_QUEUE + 64 * li + 16 * rep, tid, G, bx); }
                    SEAM(pb + 6);
                }
                if (IN(pb + 7)) { { SITE_BEGIN post_phase<4>(WSP(const bf16_t, WS_O), pp->in[I_GON] + (size_t)j * D, WSP(bf16_t, WS_G), WSP(bf16_t, WS_OG), gw, NGW, lane); } SEAM(pb + 7); }
                }
                if (IN(pb + 8)) {
                    { SITE_BEGIN
                    pg8::Gemm g{WSP(bf16_t, WS_OG), WSP(const bf16_t, WS_WGOUT), D, D, D, M / 256, D / 256, 0};
                    pg8::ResOrder S; S.init(vbx, g.K / 64);
                    EpiRes<0, 0> E{WSP(float, WS_X), WSP(bf16_t, WS_XN), WSP(float, WS_SS), nullptr, nullptr, WSP(float, WS_PART)};
                    pg8::gemm_phase(lds, g, S, E, tid); }
                    SEAM(pb + 8);
                }
                if (IN(pb + 9)) { { SITE_BEGIN fix_phase<0, 0>(WSP(float, WS_X), WSP(bf16_t, WS_XN), WSP(float, WS_SS), WSP(float, WS_R), WSP(const float, WS_PART), 8, nullptr, nullptr, lds, bx, wave, gw, NGW, lane); } SEAM(pb + 9); }
            } else {
                if (IN(pb + 4)) { { SITE_BEGIN pool_pre_phase(pp, lds, WSP(float, WS_X), pp->in[I_NMIX] + (size_t)li * D, WSP(bf16_t, WS_OG), tid, wave, lane, G); } SEAM(pb + 7); }
                if (IN(pb + 8)) {
                    { SITE_BEGIN
                    pg8::Gemm g{WSP(bf16_t, WS_OG), WSP(const bf16_t, WS_WPOOL), D, 512, 512, M / 256, D / 256, 1};
                    pg8::ResOrder S; S.init(vbx, g.K / 64);
                    EpiRes<0, 0> E{WSP(float, WS_X), WSP(bf16_t, WS_XN), WSP(float, WS_SS), pp->in[I_PSC] + (size_t)j * D, nullptr, WSP(float, WS_PART)};
                    pg8::gemm_phase(lds, g, S, E, tid); }
                    SEAM(pb + 8);
                }
                if (IN(pb + 9)) { { SITE_BEGIN fix_phase<0, 0>(WSP(float, WS_X), WSP(bf16_t, WS_XN), WSP(float, WS_SS), WSP(float, WS_R), WSP(const float, WS_PART), 4, pp->in[I_PSC] + (size_t)j * D, nullptr, lds, bx, wave, gw, NGW, lane); } SEAM(pb + 9); }
            }
        }
    }
    if (IN(NPHASE - 1)) { SITE_BEGIN final_phase(WSP(const float, WS_X), pp->in[I_FN], pp->out + OUT_Y, WSP(const float, WS_PART), gw, NGW, lane); }
    if (PROBE_MASK != 0 && blockIdx.x == 0) { const unsigned long long t1 = __builtin_amdgcn_s_memrealtime(); while (__builtin_amdgcn_s_memrealtime() - t1 < (unsigned long long)PROBE_MUL * probe_acc) __builtin_amdgcn_s_sleep(16); }
#undef IN
#undef SEAM
}

extern "C" void kernel_launch(void* const* d_in, const int* in_sizes, int n_in, void* d_out, int out_size, void* d_ws, size_t ws_size, hipStream_t stream) {
    static int grid = 0;
    if (grid == 0) {
        if (n_in != 26 || (size_t)out_size != OUT_TOTAL || ws_size < WS_END) { fprintf(stderr, "kernel_launch: unexpected sizes n_in %d out %d ws %zu (need %zu)\n", n_in, out_size, ws_size, (size_t)WS_END); grid = -1; return; }
        int dev = 0, cus = 0, per_cu = 0;
        if (hipGetDevice(&dev) != hipSuccess || hipDeviceGetAttribute(&cus, hipDeviceAttributeMultiprocessorCount, dev) != hipSuccess) { grid = -1; return; }
        if (hipFuncSetAttribute((const void*)mega_fwd, hipFuncAttributeMaxDynamicSharedMemorySize, LDS_BYTES) != hipSuccess) { fprintf(stderr, "kernel_launch: hipFuncSetAttribute failed\n"); grid = -1; return; }
        if (hipOccupancyMaxActiveBlocksPerMultiprocessor(&per_cu, (const void*)mega_fwd, NTHREADS, LDS_BYTES) != hipSuccess || per_cu < 1) fprintf(stderr, "kernel_launch: occupancy query reports %d\n", per_cu);
        (void)hipGetLastError();
        grid = cus;
        if (grid != 256) { fprintf(stderr, "kernel_launch: built for 256 CUs (got %d)\n", cus); grid = -1; return; }
    }
    if (grid < 0) return;
    if (hipMemsetAsync((char*)d_ws + WS_CTL, 0, CTL_ZERO_BYTES, stream) != hipSuccess) return;
    Params p{};
    for (int i = 0; i < 26; ++i) p.in[i] = (const float*)d_in[i];
    p.out = (float*)d_out; p.ws = (unsigned char*)d_ws;
#if MK_PER_PHASE_LAUNCH
    for (int ph = 0; ph < NPHASE; ++ph) {
        if (!phase_exists(ph)) continue;
        p.ph_lo = ph; p.ph_hi = ph + 1;
        hipLaunchKernelGGL(mega_fwd, dim3(grid), dim3(NTHREADS), LDS_BYTES, stream, p);
    }
#else
    p.ph_lo = 0; p.ph_hi = NPHASE;
    hipLaunchKernelGGL(mega_fwd, dim3(grid), dim3(NTHREADS), LDS_BYTES, stream, p);
#endif
    (void)in_sizes;
}
```

```cpp
#include <hip/hip_runtime.h>
#include <cstdio>
#include <cstdint>

#ifndef USE_SIMPLE_SCAN
#define USE_SIMPLE_SCAN 0
#endif
#ifndef REP_PRO
#define REP_PRO 1
#endif
#ifndef REP_GU
#define REP_GU 1
#endif
#ifndef REP_SCAN
#define REP_SCAN 1
#endif
#ifndef REP_NORM
#define REP_NORM 1
#endif
#ifndef PROBE_MASK
#define PROBE_MASK 0
#endif
#ifndef PROBE_MUL
#define PROBE_MUL 4
#endif
#ifndef MK_PER_PHASE_LAUNCH
#define MK_PER_PHASE_LAUNCH 0
#endif

#define LAS __attribute__((address_space(3)))
#define GAS __attribute__((address_space(1)))
typedef unsigned short bf16_t;
typedef short bf16x8 __attribute__((ext_vector_type(8)));
typedef float f32x4 __attribute__((ext_vector_type(4)));
typedef float f32x2 __attribute__((ext_vector_type(2)));
typedef unsigned u32x4 __attribute__((ext_vector_type(4)));
typedef unsigned u32x2 __attribute__((ext_vector_type(2)));

constexpr int D = 2048, FF = 5632, NLAYER = 4;
constexpr int PB = 4, PT = 2048, SB = 128, ST = 8;
constexpr int MP = PB * PT, MS = SB * ST, M = MP + MS;
constexpr int HG_H = 16, HG_K = 128, HG_V = 128;
constexpr int GL_H = 4, GL_K = 256, GL_V = 512, GL_DK = 1024, GL_NIN = 7168, GL_WIN_LD = 6160;
constexpr int POOLBUF = 15;
constexpr float EPS = 1e-6f;
constexpr int NWAVES = 8, NTHREADS = 512;

constexpr size_t OUT_Y = 0;
constexpr size_t OUT_HG_P = (size_t)M * D;
constexpr size_t OUT_GLA_P = OUT_HG_P + (size_t)2 * PB * HG_H * HG_K * HG_V;
constexpr size_t OUT_POOL_P = OUT_GLA_P + (size_t)PB * GL_H * GL_K * GL_V;
constexpr size_t OUT_HG_S = OUT_POOL_P + (size_t)PB * POOLBUF * D;
constexpr size_t OUT_GLA_S = OUT_HG_S + (size_t)2 * SB * HG_H * HG_K * HG_V;
constexpr size_t OUT_POOL_S = OUT_GLA_S + (size_t)SB * GL_H * GL_K * GL_V;
constexpr size_t OUT_TOTAL = OUT_POOL_S + (size_t)SB * POOLBUF * D;
static_assert(OUT_TOTAL == 161341440ull, "output size");

constexpr size_t MiB = 1u << 20;
constexpr size_t al(size_t x) { return (x + MiB - 1) / MiB * MiB; }
constexpr size_t WS_CTL = 0, CTL_ZERO_BYTES = 128 * 1024;
constexpr size_t WS_TAB = 1 * MiB;
constexpr size_t SZ_WGU1 = (size_t)2 * FF * D * 2, SZ_WDN1 = (size_t)D * FF * 2;
constexpr size_t WS_WGU = 2 * MiB;
constexpr size_t WS_WDN = WS_WGU + al(8 * SZ_WGU1);
constexpr size_t WS_WHIN = WS_WDN + al(8 * SZ_WDN1);
constexpr size_t WS_WHOUT = WS_WHIN + al((size_t)2 * 8192 * D * 2);
constexpr size_t WS_WGIN = WS_WHOUT + al((size_t)2 * D * D * 2);
constexpr size_t WS_WGOUT = WS_WGIN + al((size_t)GL_NIN * D * 2);
constexpr size_t WS_WPOOL = WS_WGOUT + al((size_t)D * D * 2);
constexpr size_t WS_X = WS_WPOOL + al((size_t)D * 512 * 2);
constexpr size_t WS_XN = WS_X + al((size_t)M * D * 4);
constexpr size_t WS_H = WS_XN + al((size_t)M * D * 2);
constexpr size_t WS_Q = WS_H + al((size_t)M * FF * 2);
constexpr size_t WS_KK = WS_Q + al((size_t)M * D * 2);
constexpr size_t WS_V = WS_KK + al((size_t)M * D * 2);
constexpr size_t WS_G = WS_V + al((size_t)M * D * 2);
constexpr size_t WS_LF = WS_G + al((size_t)M * D * 2);
constexpr size_t WS_O = WS_LF + al((size_t)M * D * 4);
constexpr size_t WS_VT = WS_O + al((size_t)M * D * 4);
constexpr size_t WS_DL = WS_VT + al((size_t)M * D * 2);
constexpr size_t WS_PART = WS_DL + al((size_t)256 * D * 4);
constexpr size_t WS_OG = WS_PART + al((size_t)8 * MS * D * 4);
constexpr size_t WS_SS = WS_OG + al((size_t)M * D * 2);
constexpr size_t WS_SSO = WS_SS + al((size_t)M * 32 * 4);
constexpr size_t WS_R = WS_SSO + al((size_t)M * 32 * 4);
constexpr size_t WS_END = WS_R + al((size_t)M * 4);
constexpr size_t WS_QI = WS_H, WS_KDT = WS_QI + al((size_t)M * D * 2), WS_AM = WS_KDT + al((size_t)M * D * 2);
static_assert(WS_AM + (size_t)144 * 16 * 64 * 64 * 2 <= WS_Q, "scan overlay fits in H");

constexpr int CW_XRANK = 3072  , CW_BAR = 4096, CW_QUEUE = 8192, CW_GUFLAG = 16384  ;

constexpr int RING_BYTES = 131072, LDSCTL_OFF = RING_BYTES, MISC_OFF = LDSCTL_OFF + 320, LDS_BYTES = 147456;

__device__ __forceinline__ unsigned f2bf(float f) { unsigned u = __builtin_bit_cast(unsigned, f); return (u + 0x7fffu + ((u >> 16) & 1u)) >> 16; }
typedef _Float16 f16x2_t __attribute__((ext_vector_type(2)));
__device__ __forceinline__ unsigned pkh2(float lo, float hi) { f16x2_t h; h.x = (_Float16)lo; h.y = (_Float16)hi; return __builtin_bit_cast(unsigned, h); }
__device__ __forceinline__ float hlo(unsigned w) { return (float)__builtin_bit_cast(f16x2_t, w).x; }
__device__ __forceinline__ float hhi(unsigned w) { return (float)__builtin_bit_cast(f16x2_t, w).y; }
__device__ __forceinline__ unsigned pk2(float lo, float hi) { unsigned r; asm("v_cvt_pk_bf16_f32 %0, %1, %2" : "=v"(r) : "v"(lo), "v"(hi)); return r; }
__device__ __forceinline__ float bf2f(unsigned short b) { return __builtin_bit_cast(float, ((unsigned)b) << 16); }
__device__ __forceinline__ float bflo(unsigned w) { return __builtin_bit_cast(float, w << 16); }
__device__ __forceinline__ float bfhi(unsigned w) { return __builtin_bit_cast(float, w & 0xffff0000u); }
__device__ __forceinline__ void lds_barrier() { asm volatile("s_waitcnt lgkmcnt(0)" ::: "memory"); __builtin_amdgcn_s_barrier(); asm volatile("" ::: "memory"); }

__device__ __forceinline__ float wave_sum(float v) {
#pragma unroll
    for (int o = 1; o < 64; o <<= 1) v += __shfl_xor(v, o);
    return v;
}
__device__ __forceinline__ float fsigmoid(float x) { return __builtin_amdgcn_rcpf(1.f + __expf(-x)); }
__device__ __forceinline__ float fsilu(float x) { return x * fsigmoid(x); }
#define LDS_WAIT() asm volatile("s_waitcnt lgkmcnt(0)" ::: "memory")

#define XB_TMO      128
#define XB_XCNT(j)  (256  + 64 * (j))
#define XB_XSUB(j)  (1280 + 64 * (j))
#define XB_XGEN(j)  (2304 + 64 * (j))
#define XB_TOP      3328
#define XB_TOPGEN   3392
#define XCD_BAR_WORDS 3456
#define XB_SPIN_CAP (1u << 22)

__device__ __forceinline__ unsigned xb_ld(unsigned* p)              { return __hip_atomic_load(p, __ATOMIC_RELAXED, __HIP_MEMORY_SCOPE_AGENT); }
__device__ __forceinline__ unsigned xb_add(unsigned* p, unsigned v) { return __hip_atomic_fetch_add(p, v, __ATOMIC_RELAXED, __HIP_MEMORY_SCOPE_AGENT); }
__device__ __forceinline__ unsigned xb_xcc_id() { return (unsigned)__builtin_amdgcn_s_getreg((3 << 11) | 20) & 0xFu; }
#define XB_SPIN(cond, bar) do { unsigned _sp = 0; while (cond) { __builtin_amdgcn_s_sleep(1); \
    if ((++_sp & 255u) == 0u) { if (xb_ld(&(bar)[XB_TMO])) break; if (_sp > XB_SPIN_CAP) { atomicAdd(&(bar)[XB_TMO], 1u); break; } } } } while (0)

struct XcdBarrier { unsigned* bar; unsigned x; volatile LAS unsigned* st; };

__device__ __forceinline__ XcdBarrier xcd_barrier_post(unsigned* bar, volatile LAS unsigned* st) {
    XcdBarrier b; b.bar = bar; b.x = xb_xcc_id(); b.st = st;
    if (threadIdx.x == 0) (void)xb_add(&bar[XB_XCNT(b.x)], 1u);
    return b;
}
__device__ __forceinline__ void xcd_barrier_complete(unsigned* bar, unsigned x, unsigned& nloc, unsigned& nx) {
    const unsigned G = gridDim.x * gridDim.y * gridDim.z;
    unsigned sum, cnt, mine, sp = 0u;
    for (;;) {
        sum = 0u; cnt = 0u; mine = 0u;
#pragma unroll
        for (unsigned j = 0; j < 16; ++j) { const unsigned c = xb_ld(&bar[XB_XCNT(j)]); sum += c; cnt += (c > 0u) ? 1u : 0u; mine = (j == x) ? c : mine; }
        if (sum == G) break;
        __builtin_amdgcn_s_sleep(1);
        if ((++sp & 255u) == 0u) { if (xb_ld(&bar[XB_TMO])) break; if (sp > XB_SPIN_CAP) { atomicAdd(&bar[XB_TMO], 1u); break; } }
    }
    nloc = mine > 0u ? mine : 1u; nx = cnt > 0u ? cnt : 1u;
}
__device__ __forceinline__ void xcd_barrier(const XcdBarrier& b, const bool leader  ) {
    asm volatile("s_waitcnt vmcnt(0)" ::: "memory");
    __syncthreads();
    if (leader) {
        unsigned* bar = b.bar;
        __builtin_amdgcn_s_waitcnt(0);
        unsigned nloc = b.st[0], nx = b.st[1];
        if (nloc == 0u) { xcd_barrier_complete(bar, b.x, nloc, nx); b.st[0] = nloc; b.st[1] = nx; }
        const unsigned old = xb_add(&bar[XB_XSUB(b.x)], 1u);
        const unsigned gen = old / nloc;
        if (old + 1u == (gen + 1u) * nloc) {
            __builtin_amdgcn_fence(__ATOMIC_RELEASE, "agent");
            asm volatile("s_waitcnt vmcnt(0)" ::: "memory");
            const unsigned og = xb_add(&bar[XB_TOP], 1u);
            const unsigned tg = og / nx;
            if (og + 1u == (tg + 1u) * nx) xb_add(&bar[XB_TOPGEN], 1u);
            else XB_SPIN(xb_ld(&bar[XB_TOPGEN]) == tg, bar);
            __builtin_amdgcn_fence(__ATOMIC_ACQUIRE, "agent");
            xb_add(&bar[XB_XGEN(b.x)], 1u);
            asm volatile("s_waitcnt vmcnt(0)" ::: "memory");
        } else {
            XB_SPIN(xb_ld(&bar[XB_XGEN(b.x)]) == gen, bar);
            __builtin_amdgcn_fence(__ATOMIC_ACQUIRE, "agent");
            asm volatile("s_waitcnt vmcnt(0)" ::: "memory");
        }
    }
    __syncthreads();
}

namespace pg8 {
constexpr int BM = 256, BK = 64, HALF = 128, HTB = HALF * BK * 2, STAGE_BYTES = 8 * HTB, NXCD = 8, WGM = 8;
__host__ __device__ __forceinline__ int lds_byte(int r, int c) { const int st = (r >> 4) * 2 + (c >> 5), rr = r & 15, cc = c & 31, ob = rr * 64 + cc * 2; return st * 1024 + (ob ^ (((ob >> 9) & 1) << 5)); }
__host__ __device__ __forceinline__ void stage_rc(int b, int& R, int& C) { const int st = b / 1024, sb = b % 1024, swz = sb ^ (((sb >> 9) & 1) << 5); R = (st >> 1) * 16 + swz / 64; C = (st & 1) * 32 + (swz % 64) / 2; }
__host__ __device__ __forceinline__ int perm32(int rho) { const int n = rho >> 4, i = rho & 15; return 8 * (i >> 2) + 4 * n + (i & 3); }

struct Unit { int pm, pn, kt0, nt, split; };
struct Gemm { const bf16_t* A; const bf16_t* Bt; int lda, ldb, K, nM, nN, grp; };

struct StaticOrder {
    int nM, nN, nwg, G, c, ntk;
    __device__ void init(int nM_, int nN_, int G_, int c_, int ntk_) { nM = nM_; nN = nN_; nwg = nM * nN; G = G_; c = c_; ntk = ntk_; }
    __device__ bool next(int i, Unit& u) const {
        const long L = (long)i * G + c; if (L >= nwg) return false;
        int wgid = (int)L; { const int q = nwg / NXCD, r = nwg % NXCD, xcd = wgid % NXCD, off = wgid / NXCD; wgid = (xcd < r ? xcd * (q + 1) : r * (q + 1) + (xcd - r) * q) + off; }
        const int nig = WGM * nN, gid = wgid / nig, fm = gid * WGM, gsz = (nM - fm) < WGM ? (nM - fm) : WGM;
        u.pm = fm + ((wgid % nig) % gsz); u.pn = (wgid % nig) / gsz; u.kt0 = 0; u.nt = ntk; u.split = -1; return true;
    }
};
template <int NM, int NN, int NTK, int NG> struct TailSplitOrder {
    static constexpr int nwg = NM * NN, nfull = (2 * (nwg % NG) > NG || (NTK & 3)) ? nwg : (nwg / NG) * NG, ntail = nwg - nfull;
    int c;
    __device__ void init(int c_) { c = c_; }
    __device__ bool next(int i, Unit& u) const {
        int L = i * NG + c; u.kt0 = 0; u.nt = NTK; u.split = -1;
        if (i * NG >= nfull) {
            if (ntail == 0) { if (L >= nwg) return false; }
            else { if (i * NG > nfull || c >= 2 * ntail) return false;
                   const int part = c >= ntail ? 1 : 0, tc = c - part * ntail; L = nfull + tc; constexpr int n0 = (NTK * 7 / 16) & ~1;
                   u.kt0 = part * n0; u.nt = part ? NTK - n0 : n0; u.split = part + 2 * tc; }
        }
        int wgid = L; { constexpr int q = nwg / NXCD, r = nwg % NXCD; const int xcd = wgid % NXCD, off = wgid / NXCD; wgid = (xcd < r ? xcd * (q + 1) : r * (q + 1) + (xcd - r) * q) + off; }
        constexpr int nig = WGM * NN; const int gid = wgid / nig, fm = gid * WGM, gsz = (NM - fm) < WGM ? (NM - fm) : WGM;
        u.pm = fm + ((wgid % nig) % gsz); u.pn = (wgid % nig) / gsz; return true;
    }
};
struct ResOrder {
    int c, ntk, nsplit;
    __device__ void init(int c_, int ntk_) { c = c_; ntk = ntk_; nsplit = ntk_ >= 16 ? 8 : ntk_ / 2; }
    __device__ bool next(int i, Unit& u) const {
        const int x = c & 7, r = c >> 3;
        if (i == 0) { u.pm = 4 * x + (r >> 3); u.pn = r & 7; u.kt0 = 0; u.nt = ntk; u.split = -1; return true; }
        if (i == 1 && x < nsplit) { const int pairs = ntk >> 1, p0 = x * pairs / nsplit, p1 = (x + 1) * pairs / nsplit;
            u.pm = 32 + (r >> 3); u.pn = r & 7; u.kt0 = 2 * p0; u.nt = 2 * (p1 - p0); u.split = x; return true; }
        return false;
    }
};

template <class Epi, class Sched>
__device__ __forceinline__ void gemm_phase(LAS unsigned char* lds, const Gemm g, const Sched& S, const Epi& E, const int tid) {
    const int wid = __builtin_amdgcn_readfirstlane(tid >> 6), lane = tid & 63, wr = wid >> 2, wc = wid & 3, fr = lane & 15, fq = lane >> 4;
    const int K = g.K;
    unsigned voffA[2], voffB[2];
#pragma unroll
    for (int i = 0; i < 2; ++i) { int R, C; stage_rc(tid * 16 + i * 8192, R, C); const int Rb = (R & ~31) + perm32(R & 31);
        voffA[i] = (unsigned)(R * g.lda + C) * 2u; voffB[i] = (unsigned)(Rb * g.ldb + C) * 2u; }
    const size_t kstep = (size_t)(BK * 2);
    const size_t hstepA = (size_t)HALF * g.lda * 2, hstepB = (size_t)HALF * g.ldb * 2;
    const size_t tstepA = 2 * hstepA, tstepB = 2 * hstepB;
    const unsigned ldsw = (unsigned)wid * 1024u;
    const int aoff = lds_byte(wr * 64 + fr, fq * 8), boff = lds_byte(wc * 32 + fr, fq * 8);
#define PG8_SA(b, h) (((b) * 2 + (h)) * HTB)
#define PG8_SB(b, h) ((4 + (b) * 2 + (h)) * HTB)
#define PG8_STAGE(bufoff, gbase, voff) do { _Pragma("unroll") for (int _i = 0; _i < 2; ++_i) \
        __builtin_amdgcn_global_load_lds((const unsigned*)((const char*)(gbase) + (voff)[_i]), (LAS unsigned*)(lds + (bufoff) + ldsw + _i * 8192), 16, 0, 0); } while (0)
#define PG8_LDA(dst, b, h) do { _Pragma("unroll") for (int m = 0; m < 4; ++m) _Pragma("unroll") for (int k = 0; k < 2; ++k) dst[m][k] = *(const LAS bf16x8*)(lds + PG8_SA(b, h) + aoff + m * 2048 + k * 1024); } while (0)
#define PG8_LDB(dst, b, h) do { _Pragma("unroll") for (int n = 0; n < 2; ++n) _Pragma("unroll") for (int k = 0; k < 2; ++k) dst[n][k] = *(const LAS bf16x8*)(lds + PG8_SB(b, h) + boff + n * 2048 + k * 1024); } while (0)
#define PG8_MMA(ai, bj, At, Bt) do { __builtin_amdgcn_s_setprio(1); _Pragma("unroll") for (int m = 0; m < 4; ++m) _Pragma("unroll") for (int n = 0; n < 2; ++n) _Pragma("unroll") for (int k = 0; k < 2; ++k) \
        acc[ai][bj][m][n] = __builtin_amdgcn_mfma_f32_16x16x32_bf16(Bt[n][k], At[m][k], acc[ai][bj][m][n], 0, 0, 0); __builtin_amdgcn_s_setprio(0); } while (0)
#define PG8_WAIT_V(n) asm volatile("s_waitcnt vmcnt(" #n ")" ::: "memory")
#define PG8_WAIT_L(n) asm volatile("s_waitcnt lgkmcnt(" #n ")" ::: "memory")
#define PG8_BAR __builtin_amdgcn_s_barrier()
#define PG8_SCHED __builtin_amdgcn_sched_barrier(0)
#define PG8_ABASE(u) ((const char*)g.A + (size_t)(u).pm * tstepA + (g.grp ? (size_t)((u).pn >> 1) * (size_t)K * 2 : (size_t)0) + (size_t)(u).kt0 * kstep)
#define PG8_BBASE(u) ((const char*)g.Bt + (size_t)(u).pn * tstepB + (size_t)(u).kt0 * kstep)
    Unit cur, nxt; int ui = 0;
    if (!S.next(0, cur)) return;
    f32x4 acc[2][2][4][2];
#pragma unroll
    for (int a = 0; a < 2; ++a)
#pragma unroll
        for (int b = 0; b < 2; ++b)
#pragma unroll
            for (int m = 0; m < 4; ++m)
#pragma unroll
                for (int n = 0; n < 2; ++n) acc[a][b][m][n] = (f32x4){0.f, 0.f, 0.f, 0.f};
    bf16x8 At[4][2], B0[2][2], B1[2][2];
    const char* cA = PG8_ABASE(cur); const char* cB = PG8_BBASE(cur);
    PG8_STAGE(PG8_SB(0, 0), cB, voffB); PG8_STAGE(PG8_SB(0, 1), cB + hstepB, voffB); PG8_STAGE(PG8_SA(0, 0), cA, voffA); PG8_STAGE(PG8_SA(0, 1), cA + hstepA, voffA);
    if (wr == 1) PG8_BAR;
    PG8_WAIT_V(2); PG8_BAR;
    PG8_STAGE(PG8_SB(1, 0), cB + kstep, voffB); PG8_STAGE(PG8_SA(1, 0), cA + kstep, voffA); PG8_STAGE(PG8_SB(1, 1), cB + hstepB + kstep, voffB);
    PG8_WAIT_V(6); PG8_BAR;
    for (;;) {
        const bool has_next = S.next(ui + 1, nxt);
        const char* nA = has_next ? PG8_ABASE(nxt) : cA; const char* nB = has_next ? PG8_BBASE(nxt) : cB;
        const int nt = cur.nt;
        E.prefetch(cur, tid, lds, ui & 1);
        for (int t = 0; t < nt; t += 2) {
            const bool last = (t == nt - 2);
            const char* a1 = cA + (size_t)(t + 1) * kstep;
            const char* a2 = last ? nA : cA + (size_t)(t + 2) * kstep; const char* b2 = last ? nB : cB + (size_t)(t + 2) * kstep;
            const char* a3 = a2 + kstep; const char* b3 = b2 + kstep;
            PG8_LDB(B0, 0, 0); PG8_LDB(B1, 0, 1); PG8_SCHED; PG8_LDA(At, 0, 0); PG8_STAGE(PG8_SA(1, 1), a1 + hstepA, voffA);
            PG8_WAIT_V(8); PG8_WAIT_L(0); PG8_BAR; PG8_MMA(0, 0, At, B0); PG8_MMA(0, 1, At, B1); PG8_BAR; PG8_SCHED;
            PG8_LDA(At, 0, 1); PG8_STAGE(PG8_SB(0, 0), b2, voffB); PG8_STAGE(PG8_SB(0, 1), b2 + hstepB, voffB); PG8_STAGE(PG8_SA(0, 0), a2, voffA);
            PG8_WAIT_V(8); PG8_WAIT_L(0); PG8_BAR; PG8_MMA(1, 0, At, B0); PG8_MMA(1, 1, At, B1); PG8_BAR; PG8_SCHED;
            PG8_LDB(B0, 1, 0); PG8_LDB(B1, 1, 1); PG8_SCHED; PG8_LDA(At, 1, 0); PG8_STAGE(PG8_SA(0, 1), a2 + hstepA, voffA);
            PG8_WAIT_V(8); PG8_WAIT_L(0); PG8_BAR; PG8_MMA(0, 0, At, B0); PG8_MMA(0, 1, At, B1); PG8_BAR; PG8_SCHED;
            PG8_LDA(At, 1, 1); PG8_STAGE(PG8_SB(1, 0), b3, voffB); PG8_STAGE(PG8_SB(1, 1), b3 + hstepB, voffB); PG8_STAGE(PG8_SA(1, 0), a3, voffA);
            PG8_WAIT_V(8); PG8_WAIT_L(0); PG8_BAR; PG8_MMA(1, 0, At, B0); PG8_MMA(1, 1, At, B1); PG8_BAR; PG8_SCHED;
        }
        if (wr == 0) PG8_BAR;
        E.combine(acc, cur, tid);
        E(acc, cur, wr, wc, fr, fq, lds, tid, ui & 1);
        if (!has_next) break;
#pragma unroll
        for (int a = 0; a < 2; ++a)
#pragma unroll
            for (int b = 0; b < 2; ++b)
#pragma unroll
                for (int m = 0; m < 4; ++m)
#pragma unroll
                    for (int n = 0; n < 2; ++n) acc[a][b][m][n] = (f32x4){0.f, 0.f, 0.f, 0.f};
        cur = nxt; cA = nA; cB = nB; ++ui;
        if (wr == 1) PG8_BAR;
    }
    PG8_WAIT_V(0);
    PG8_BAR;
#undef PG8_SA
#undef PG8_SB
#undef PG8_STAGE
#undef PG8_LDA
#undef PG8_LDB
#undef PG8_MMA
#undef PG8_WAIT_V
#undef PG8_WAIT_L
#undef PG8_BAR
#undef PG8_SCHED
#undef PG8_ABASE
#undef PG8_BBASE
}
}

__device__ __forceinline__ unsigned cvt_pk_bf16(float lo, float hi) { unsigned r; asm volatile("v_cvt_pk_bf16_f32 %0, %1, %2" : "=v"(r) : "v"(lo), "v"(hi)); return r; }
typedef f32x4 AccT[2][2][4][2];

template <int NP> __device__ __forceinline__ float row_scale(const float* P, int row, int fq) {
    const float* p = P + (size_t)row * NP + fq * (NP / 4); float s;
    if (NP == 32) { const f32x4 a = *(const f32x4*)p, b2 = *(const f32x4*)(p + 4); s = ((a.x + a.y) + (a.z + a.w)) + ((b2.x + b2.y) + (b2.z + b2.w)); }
    else { const f32x4 a = *(const f32x4*)p; s = (a.x + a.y) + (a.z + a.w); }
    s += __shfl_xor(s, 16); s += __shfl_xor(s, 32);
    return __builtin_amdgcn_rsqf(s * (1.f / D) + EPS);
}
constexpr int RSC_OFF = LDSCTL_OFF + 2048;
__device__ __forceinline__ void rs_dma(const float* R, int pm, int tid, LAS unsigned char* lds, int par) {
    const int wid = __builtin_amdgcn_readfirstlane(tid >> 6);
    if (wid < 4) {
        const float* gsrc = R + pm * 256 + wid * 64 + (tid & 63); const unsigned dst = (unsigned)__builtin_amdgcn_readfirstlane((int)(RSC_OFF + par * 1024 + wid * 256)); unsigned keep;
        asm volatile("s_mov_b32 %0, m0\n\ts_mov_b32 m0, %2\n\ts_nop 0\n\tglobal_load_lds_dword %1, off\n\ts_mov_b32 m0, %0" : "=&s"(keep) : "v"(gsrc), "s"(dst) : "memory");
    }
}
__device__ __forceinline__ void rs_read8(LAS unsigned char* lds, int wr, int fr, float (&r)[2][4], int par) {
    const LAS float* T = (const LAS float*)(lds + RSC_OFF + par * 1024);
#pragma unroll
    for (int ai = 0; ai < 2; ++ai)
#pragma unroll
        for (int m = 0; m < 4; ++m) r[ai][m] = T[ai * 128 + wr * 64 + m * 16 + fr];
}
template <int NP> __device__ __forceinline__ void row_scales8_direct(const float* P, int pm, int tid, LAS unsigned char* lds, int wr, int fr, float (&r)[2][4]) {
    LAS float* T = (LAS float*)(lds + RSC_OFF);
    { const float* p = P + (size_t)(pm * 256 + (tid >> 1)) * NP + (tid & 1) * (NP / 2); float s;
      if (NP == 32) { const f32x4 a = *(const f32x4*)p, b2 = *(const f32x4*)(p + 4), c = *(const f32x4*)(p + 8), d = *(const f32x4*)(p + 12);
          s = (((a.x + a.y) + (a.z + a.w)) + ((b2.x + b2.y) + (b2.z + b2.w))) + (((c.x + c.y) + (c.z + c.w)) + ((d.x + d.y) + (d.z + d.w))); }
      else { const f32x4 a = *(const f32x4*)p, b2 = *(const f32x4*)(p + 4); s = ((a.x + a.y) + (a.z + a.w)) + ((b2.x + b2.y) + (b2.z + b2.w)); }
      s += __shfl_xor(s, 1);
      if (!(tid & 1)) T[tid >> 1] = __builtin_amdgcn_rsqf(s * (1.f / D) + EPS); }
    asm volatile("s_waitcnt lgkmcnt(0)" ::: "memory"); __builtin_amdgcn_s_barrier(); asm volatile("" ::: "memory");
    rs_read8(lds, wr, fr, r, 0);
}
struct EpiGU {
    bf16_t* H; const float* SS; float* SLAB; unsigned* flags;
    __device__ __forceinline__ void prefetch(const pg8::Unit& u, int tid, LAS unsigned char* lds, int par) const { rs_dma(SS, u.pm, tid, lds, par); }
    __device__ __forceinline__ void combine(AccT& a, const pg8::Unit& u, int tid) const {
        if (u.split < 0 || !(u.split & 1)) return;
        unsigned* fl = flags + (u.split >> 1);
        if (tid == 0) { while (xb_ld(fl) == 0u) __builtin_amdgcn_s_sleep(1);
            __builtin_amdgcn_fence(__ATOMIC_ACQUIRE, "agent"); asm volatile("s_waitcnt vmcnt(0)" ::: "memory"); }
        __syncthreads();
        const u32x4* slab = (const u32x4*)SLAB + (size_t)(u.split >> 1) * (16 * 512); const unsigned ut = (unsigned)tid;
        u32x4 t[16];
#pragma unroll
        for (int i = 0; i < 16; ++i) t[i] = (slab + i * 512)[ut];
#pragma unroll
        for (int i = 0; i < 16; ++i) {
            f32x4& a0 = a[i >> 3][(i >> 2) & 1][i & 3][0]; f32x4& a1 = a[i >> 3][(i >> 2) & 1][i & 3][1];
            a0 = a0 + (f32x4){bflo(t[i].x), bfhi(t[i].x), bflo(t[i].y), bfhi(t[i].y)};
            a1 = a1 + (f32x4){bflo(t[i].z), bfhi(t[i].z), bflo(t[i].w), bfhi(t[i].w)};
        }
    }
    __device__ __forceinline__ void operator()(const AccT& acc, const pg8::Unit& u, int wr, int wc, int fr, int fq, LAS unsigned char* lds, int tid, int par) const {
        const int row0 = u.pm * 256 + wr * 64 + fr, col0 = u.pn * 128 + wc * 32 + 8 * fq;
        const bool tail = u.split >= 0;
        const unsigned ut = (unsigned)tid;
        if (tail) {
            unsigned* fl = flags + (u.split >> 1);
            if (!(u.split & 1)) {
                u32x4* sw = (u32x4*)SLAB + (size_t)(u.split >> 1) * (16 * 512);
#pragma unroll
                for (int ai = 0; ai < 2; ++ai)
#pragma unroll
                    for (int bj = 0; bj < 2; ++bj)
#pragma unroll
                        for (int m = 0; m < 4; ++m) { const f32x4 p0 = acc[ai][bj][m][0], p1 = acc[ai][bj][m][1];
                            u32x4 w; w.x = cvt_pk_bf16(p0.x, p0.y); w.y = cvt_pk_bf16(p0.z, p0.w); w.z = cvt_pk_bf16(p1.x, p1.y); w.w = cvt_pk_bf16(p1.z, p1.w);
                            (sw + ((ai * 2 + bj) * 4 + m) * 512)[ut] = w; }
                __syncthreads();
                if (tid == 0) { __builtin_amdgcn_fence(__ATOMIC_RELEASE, "agent"); asm volatile("s_waitcnt vmcnt(0)" ::: "memory"); (void)xb_add(fl, 1u); }
                return;
            }
        }
        float rs8[2][4]; rs_read8(lds, wr, fr, rs8, par);
#pragma unroll
        for (int ai = 0; ai < 2; ++ai)
#pragma unroll
            for (int m = 0; m < 4; ++m) {
                const int row = row0 + ai * 128 + m * 16;
                const float r = rs8[ai][m];
                bf16_t* rowp = H + (size_t)row * FF + col0;
                float hv[8];
#pragma unroll
                for (int n = 0; n < 2; ++n)
#pragma unroll
                    for (int j = 0; j < 4; ++j) { const float gv = acc[ai][0][m][n][j] * r, uv = acc[ai][1][m][n][j] * r; hv[n * 4 + j] = fsilu(gv) * uv; }
                u32x4 w; w.x = cvt_pk_bf16(hv[0], hv[1]); w.y = cvt_pk_bf16(hv[2], hv[3]); w.z = cvt_pk_bf16(hv[4], hv[5]); w.w = cvt_pk_bf16(hv[6], hv[7]);
                *(u32x4*)rowp = w;
            }
    }
};
template <int NP, int HALF> struct EpiRes {
    float* X; bf16_t* XB; float* SS; const float* colscale; const float* RP; float* PART;
    __device__ __forceinline__ void prefetch(const pg8::Unit&, int, LAS unsigned char*, int) const {}
    __device__ __forceinline__ void combine(AccT&, const pg8::Unit&, int) const {}
    __device__ __forceinline__ void operator()(const AccT& acc, const pg8::Unit& u, int wr, int wc, int fr, int fq, LAS unsigned char* lds, int tid, int par) const {
        const int row0 = u.pm * 256 + wr * 64 + fr, col0 = u.pn * 256 + wc * 32 + 8 * fq;
        if (u.split >= 0) {
#pragma unroll
            for (int ai = 0; ai < 2; ++ai)
#pragma unroll
                for (int m = 0; m < 4; ++m) {
                    bf16_t* rowp = (bf16_t*)PART + ((size_t)u.split * MS + (size_t)(row0 + ai * 128 + m * 16 - MP)) * D + col0;
#pragma unroll
                    for (int bj = 0; bj < 2; ++bj) { const f32x4 p0 = acc[ai][bj][m][0], p1 = acc[ai][bj][m][1];
                        u32x4 w; w.x = cvt_pk_bf16(p0.x, p0.y); w.y = cvt_pk_bf16(p0.z, p0.w); w.z = cvt_pk_bf16(p1.x, p1.y); w.w = cvt_pk_bf16(p1.z, p1.w);
                        *(u32x4*)(rowp + bj * 128) = w; }
                }
            return;
        }
        f32x4 cs[2][2];
#pragma unroll
        for (int bj = 0; bj < 2; ++bj)
#pragma unroll
            for (int n = 0; n < 2; ++n) { cs[bj][n] = colscale ? *(const f32x4*)(colscale + col0 + bj * 128 + 4 * n) : (f32x4){1.f, 1.f, 1.f, 1.f}; if (HALF) cs[bj][n] = cs[bj][n] * 0.5f; }
        float rs8[2][4];
        if (NP > 0) row_scales8_direct<NP == 0 ? 16 : NP>(RP, u.pm, tid, lds, wr, fr, rs8);
        constexpr bool PIPE = (NP == 0 && HALF == 1);
        f32x4 xo[PIPE ? 2 : 1][2][2][2];
#define RES_LD(buf, q_) do { _Pragma("unroll") for (int mm = 0; mm < 2; ++mm) _Pragma("unroll") for (int bj = 0; bj < 2; ++bj) _Pragma("unroll") for (int n = 0; n < 2; ++n) \
            xo[buf][mm][bj][n] = *(const f32x4*)(X + (size_t)(row0 + ((q_) >> 1) * 128 + (2 * ((q_) & 1) + mm) * 16) * D + col0 + bj * 128 + 4 * n); } while (0)
        if (PIPE) RES_LD(0, 0);
#pragma unroll
        for (int q = 0; q < 4; ++q) {
            const int ai = q >> 1, mp = q & 1;
            if (PIPE) { if (q + 1 < 4) RES_LD((q + 1) & 1, q + 1); } else RES_LD(0, q);
            __builtin_amdgcn_sched_barrier(0);
#pragma unroll
            for (int mm = 0; mm < 2; ++mm) {
                const int m = 2 * mp + mm, row = row0 + ai * 128 + m * 16;
                const float r = NP > 0 ? rs8[ai][m] : 1.f;
                float* rowp = X + (size_t)row * D + col0; bf16_t* rowb = XB + (size_t)row * D + col0;
                float ss = 0.f;
#pragma unroll
                for (int bj = 0; bj < 2; ++bj) {
                    const f32x4 x0 = xo[PIPE ? (q & 1) : 0][mm][bj][0] + cs[bj][0] * (acc[ai][bj][m][0] * r), x1 = xo[PIPE ? (q & 1) : 0][mm][bj][1] + cs[bj][1] * (acc[ai][bj][m][1] * r);
                    *(f32x4*)(rowp + bj * 128) = x0; *(f32x4*)(rowp + bj * 128 + 4) = x1;
                    ss += ((x0.x * x0.x + x0.y * x0.y) + (x0.z * x0.z + x0.w * x0.w)) + ((x1.x * x1.x + x1.y * x1.y) + (x1.z * x1.z + x1.w * x1.w));
                    u32x4 w; w.x = cvt_pk_bf16(x0.x, x0.y); w.y = cvt_pk_bf16(x0.z, x0.w); w.z = cvt_pk_bf16(x1.x, x1.y); w.w = cvt_pk_bf16(x1.z, x1.w);
                    if (XB) *(u32x4*)(rowb + bj * 128) = w;
                }
                ss += __shfl_xor(ss, 16); ss += __shfl_xor(ss, 32);
                if (fq == 0) SS[(size_t)row * 32 + u.pn * 4 + wc] = ss;
            }
            __builtin_amdgcn_sched_barrier(0);
        }
#undef RES_LD
    }
};
struct EpiHG {
    bf16_t *Q, *KK, *V, *G; float* LF; const float* lb; const float* SS;
    __device__ __forceinline__ void prefetch(const pg8::Unit&, int, LAS unsigned char*, int) const {}
    __device__ __forceinline__ void combine(AccT&, const pg8::Unit&, int) const {}
    __device__ __forceinline__ void operator()(const AccT& acc, const pg8::Unit& u, int wr, int wc, int fr, int fq, LAS unsigned char* lds, int tid, int par) const {
        const int row0 = u.pm * 256 + wr * 64 + fr, reg = u.pn >> 3, col0 = (u.pn & 7) * 256 + wc * 32 + 8 * fq;
        float lbv[2][8];
#pragma unroll
        for (int bj = 0; bj < 2; ++bj)
#pragma unroll
            for (int j = 0; j < 8; ++j) lbv[bj][j] = (reg == 1) ? lb[col0 + bj * 128 + j] : 0.f;
        float rs8[2][4]; row_scales8_direct<32>(SS, u.pm, tid, lds, wr, fr, rs8);
#pragma unroll
        for (int ai = 0; ai < 2; ++ai)
#pragma unroll
            for (int m = 0; m < 4; ++m) {
                const size_t ro = (size_t)(row0 + ai * 128 + m * 16) * D + col0;
                const float rsc = rs8[ai][m];
#pragma unroll
                for (int bj = 0; bj < 2; ++bj) {
                    float a[8], o[8];
#pragma unroll
                    for (int n = 0; n < 2; ++n)
#pragma unroll
                        for (int j = 0; j < 4; ++j) a[n * 4 + j] = acc[ai][bj][m][n][j] * rsc;
                    bf16_t* dst;
                    if (reg == 0) { dst = Q;
#pragma unroll
                        for (int j = 0; j < 8; ++j) o[j] = fsilu(a[j]) * 0.08838834764831845f;
                    } else if (reg == 1) { dst = KK; float lf[8];
#pragma unroll
                        for (int j = 0; j < 8; ++j) { const float f = fminf(fmaxf(a[j], -80.f), 80.f), e = __expf(-f), sig = __builtin_amdgcn_rcpf(1.f + e), l = lbv[bj][j];
                            lf[j] = __logf(l + (1.f - l) * sig); o[j] = (1.f - l) * e * sig; }
                        u32x4 lw; lw.x = pkh2(lf[0], lf[1]); lw.y = pkh2(lf[2], lf[3]); lw.z = pkh2(lf[4], lf[5]); lw.w = pkh2(lf[6], lf[7]);
                        *(u32x4*)((unsigned short*)LF + ro + bj * 128) = lw;
                    } else if (reg == 2) { dst = V;
#pragma unroll
                        for (int j = 0; j < 8; ++j) o[j] = a[j];
                    } else { dst = G;
#pragma unroll
                        for (int j = 0; j < 8; ++j) o[j] = fsilu(a[j]);
                    }
                    u32x4 w; w.x = cvt_pk_bf16(o[0], o[1]); w.y = cvt_pk_bf16(o[2], o[3]); w.z = cvt_pk_bf16(o[4], o[5]); w.w = cvt_pk_bf16(o[6], o[7]);
                    *(u32x4*)(dst + ro + bj * 128) = w;
                }
            }
    }
};
struct EpiGLA {
    bf16_t *Q, *KK, *V, *G; float* LF; const float* bgate; const float* SS;
    __device__ __forceinline__ void prefetch(const pg8::Unit&, int, LAS unsigned char*, int) const {}
    __device__ __forceinline__ void combine(AccT&, const pg8::Unit&, int) const {}
    __device__ __forceinline__ void operator()(const AccT& acc, const pg8::Unit& u, int wr, int wc, int fr, int fq, LAS unsigned char* lds, int tid, int par) const {
        const int pn = u.pn; int reg, cbase;
        if (pn < 4) { reg = 0; cbase = pn * 256; } else if (pn < 8) { reg = 1; cbase = (pn - 4) * 256; } else if (pn < 16) { reg = 2; cbase = (pn - 8) * 256; }
        else if (pn < 24) { reg = 3; cbase = (pn - 16) * 256; } else { reg = 4; cbase = (pn - 24) * 256; }
        const int row0 = u.pm * 256 + wr * 64 + fr, col0 = cbase + wc * 32 + 8 * fq;
        float bg[2][8];
#pragma unroll
        for (int bj = 0; bj < 2; ++bj)
#pragma unroll
            for (int j = 0; j < 8; ++j) bg[bj][j] = (reg == 4) ? bgate[col0 + bj * 128 + j] : 0.f;
        float rs8[2][4]; row_scales8_direct<32>(SS, u.pm, tid, lds, wr, fr, rs8);
#pragma unroll
        for (int ai = 0; ai < 2; ++ai)
#pragma unroll
            for (int m = 0; m < 4; ++m) {
                const size_t ro = (size_t)(row0 + ai * 128 + m * 16) * D + col0;
                const float rsc = rs8[ai][m];
#pragma unroll
                for (int bj = 0; bj < 2; ++bj) {
                    float a[8], o[8];
#pragma unroll
                    for (int n = 0; n < 2; ++n)
#pragma unroll
                        for (int j = 0; j < 4; ++j) a[n * 4 + j] = acc[ai][bj][m][n][j] * rsc;
                    if (reg == 4) {
                        float lf[8];
#pragma unroll
                        for (int j = 0; j < 8; ++j) { const float z = a[j] + bg[bj][j]; lf[j] = (fminf(z, 0.f) - __logf(1.f + __expf(-fabsf(z)))) * 0.0625f; }
                        u32x4 lw; lw.x = pkh2(lf[0], lf[1]); lw.y = pkh2(lf[2], lf[3]); lw.z = pkh2(lf[4], lf[5]); lw.w = pkh2(lf[6], lf[7]);
                        *(u32x4*)((unsigned short*)LF + ro + bj * 128) = lw;
                    } else {
                        bf16_t* dst;
                        if (reg == 0) { dst = Q;
#pragma unroll
                            for (int j = 0; j < 8; ++j) o[j] = a[j] * 0.0625f;
                        } else if (reg == 1) { dst = KK;
#pragma unroll
                            for (int j = 0; j < 8; ++j) o[j] = a[j];
                        } else if (reg == 2) { dst = V;
#pragma unroll
                            for (int j = 0; j < 8; ++j) o[j] = a[j];
                        } else { dst = G;
#pragma unroll
                            for (int j = 0; j < 8; ++j) o[j] = fsilu(a[j]);
                        }
                        u32x4 w; w.x = cvt_pk_bf16(o[0], o[1]); w.y = cvt_pk_bf16(o[2], o[3]); w.z = cvt_pk_bf16(o[4], o[5]); w.w = cvt_pk_bf16(o[6], o[7]);
                        *(u32x4*)(dst + ro + bj * 128) = w;
                    }
                }
            }
    }
};

struct Params { const float* in[26]; float* out; unsigned char* ws; int ph_lo, ph_hi; };
typedef const Params __attribute__((address_space(4))) CParams;
enum { I_XP = 0, I_XS, I_SHG, I_SGLA, I_SPOOL, I_NF1, I_F1G, I_F1U, I_F1D, I_NMIX, I_NF2, I_F2G, I_F2U, I_F2D, I_LBL, I_HWIN, I_HON, I_HWOUT, I_GWIN, I_GWGU, I_GBG, I_GON, I_GWOUT, I_PWG, I_PSC, I_FN };

template <class Src>
__device__ __forceinline__ void transpose_item(const Src& src, int K, bf16_t* WT, int dst_row0, int k0, int n0, LAS float* scr, int lane, const float* gain) {
    const int c = lane & 7;
    f32x4 g0 = (f32x4){1.f, 1.f, 1.f, 1.f}, g1 = g0;
    if (gain) { g0 = *(const f32x4*)(gain + k0 + 8 * c); g1 = *(const f32x4*)(gain + k0 + 8 * c + 4); }
    float wv[32];
#pragma unroll
    for (int i = 0; i < 32; ++i) wv[i] = src(k0 + 2 * i + (lane >> 5), n0 + (lane & 31));
#pragma unroll
    for (int i = 0; i < 32; ++i) scr[(2 * i + (lane >> 5)) * 33 + (lane & 31)] = wv[i];
    LDS_WAIT(); asm volatile("" ::: "memory");
#pragma unroll
    for (int j = 0; j < 4; ++j) { const int n = (lane >> 3) + 8 * j; const LAS float* s = scr + (8 * c) * 33 + n;
        u32x4 o; o.x = pk2(s[0 * 33] * g0.x, s[1 * 33] * g0.y); o.y = pk2(s[2 * 33] * g0.z, s[3 * 33] * g0.w); o.z = pk2(s[4 * 33] * g1.x, s[5 * 33] * g1.y); o.w = pk2(s[6 * 33] * g1.z, s[7 * 33] * g1.w);
        *(u32x4*)(WT + (size_t)(dst_row0 + n) * K + k0 + 8 * c) = o; }
    LDS_WAIT(); asm volatile("" ::: "memory");
}
struct SrcPlain { const float* W; int ld; __device__ __forceinline__ float operator()(int k, int n) const { return __builtin_nontemporal_load(W + (size_t)k * ld + n); } };
struct SrcGlaGate { const float* win; const float* wgu;
    __device__ __forceinline__ float operator()(int k, int n) const { float s = 0.f;
#pragma unroll
        for (int r = 0; r < 16; ++r) s += win[(size_t)k * GL_WIN_LD + 6144 + r] * wgu[r * GL_DK + n];
        return s; } };

__device__ __forceinline__ void prologue_phase(CParams* P, LAS unsigned char* lds, int gw, int NGW, int wave, int lane) {
    unsigned char* ws = P->ws;
    LAS float* scr = (LAS float*)(lds + wave * 16384);
    constexpr int IT_FFN = (D / 64) * (FF / 32);
    constexpr int IT_HIN = (D / 64) * (8192 / 32), IT_DD = (D / 64) * (D / 32), IT_GIN = (D / 64) * (6144 / 32), IT_GG = (D / 64) * (GL_DK / 32), IT_PL = (512 / 64) * (512 / 32);
    constexpr int N_FFN = 24 * IT_FFN, N_H = 2 * IT_HIN + 2 * IT_DD, N_G = IT_GIN + IT_GG + IT_DD, N_P = 4 * IT_PL;
    constexpr int NITEMS = N_FFN + N_H + N_G + N_P;
    for (int it = gw; it < NITEMS; it += NGW) {
        int r = it;
        if (r < N_FFN) {
            const int mat = r / IT_FFN, item = r % IT_FFN, s = mat / 3, kind = mat % 3, li = s >> 1, which = s & 1;
            if (kind < 2) {
                const float* W = P->in[(which ? I_F2G : I_F1G) + kind] + (size_t)li * D * FF;
                const int nblk = FF / 32, kb = item / nblk, nb = item % nblk, n0 = nb * 32;
                SrcPlain src{W, FF};
                transpose_item(src, D, (bf16_t*)(ws + WS_WGU + (size_t)s * SZ_WGU1), (n0 >> 7) * 256 + (n0 & 127) + kind * 128, kb * 64, n0, scr, lane, P->in[which ? I_NF2 : I_NF1] + (size_t)li * D);
            } else {
                const float* W = P->in[which ? I_F2D : I_F1D] + (size_t)li * FF * D;
                const int nblk = D / 32, kb = item / nblk, nb = item % nblk;
                SrcPlain src{W, D};
                transpose_item(src, FF, (bf16_t*)(ws + WS_WDN + (size_t)s * SZ_WDN1), nb * 32, kb * 64, nb * 32, scr, lane, nullptr);
            }
            continue;
        }
        r -= N_FFN;
        if (r < N_H) {
            if (r < 2 * IT_HIN) { const int j = r / IT_HIN, item = r % IT_HIN, nblk = 8192 / 32, kb = item / nblk, nb = item % nblk;
                SrcPlain src{P->in[I_HWIN] + (size_t)j * D * 8192, 8192};
                transpose_item(src, D, (bf16_t*)(ws + WS_WHIN) + (size_t)j * 8192 * D, nb * 32, kb * 64, nb * 32, scr, lane, P->in[I_NMIX] + (size_t)(3 * j) * D);
            } else { r -= 2 * IT_HIN; const int j = r / IT_DD, item = r % IT_DD, nblk = D / 32, kb = item / nblk, nb = item % nblk;
                SrcPlain src{P->in[I_HWOUT] + (size_t)j * D * D, D};
                transpose_item(src, D, (bf16_t*)(ws + WS_WHOUT) + (size_t)j * D * D, nb * 32, kb * 64, nb * 32, scr, lane, P->in[I_HON] + (size_t)j * D);
            }
            continue;
        }
        r -= N_H;
        if (r < N_G) {
            if (r < IT_GIN) { const int nblk = 6144 / 32, kb = r / nblk, nb = r % nblk;
                SrcPlain src{P->in[I_GWIN], GL_WIN_LD};
                transpose_item(src, D, (bf16_t*)(ws + WS_WGIN), nb * 32, kb * 64, nb * 32, scr, lane, P->in[I_NMIX] + (size_t)1 * D);
            } else if (r < IT_GIN + IT_GG) { r -= IT_GIN; const int nblk = GL_DK / 32, kb = r / nblk, nb = r % nblk;
                SrcGlaGate src{P->in[I_GWIN], P->in[I_GWGU]};
                transpose_item(src, D, (bf16_t*)(ws + WS_WGIN), 6144 + nb * 32, kb * 64, nb * 32, scr, lane, P->in[I_NMIX] + (size_t)1 * D);
            } else { r -= IT_GIN + IT_GG; const int nblk = D / 32, kb = r / nblk, nb = r % nblk;
                SrcPlain src{P->in[I_GWOUT], D};
                transpose_item(src, D, (bf16_t*)(ws + WS_WGOUT), nb * 32, kb * 64, nb * 32, scr, lane, nullptr);
            }
            continue;
        }
        r -= N_G;
        { const int gi = r / IT_PL, item = r % IT_PL, nblk = 512 / 32, kb = item / nblk, nb = item % nblk;
          SrcPlain src{P->in[I_PWG] + (size_t)gi * 512 * 512, 512};
          transpose_item(src, 512, (bf16_t*)(ws + WS_WPOOL), gi * 512 + nb * 32, kb * 64, nb * 32, scr, lane, nullptr); }
    }
    {
        float* X = (float*)(ws + WS_X); bf16_t* XB = (bf16_t*)(ws + WS_XN); float* SS = (float*)(ws + WS_SS);
        for (int m = gw; m < M; m += NGW) {
            const f32x4* xr = (m < MP ? (const f32x4*)(P->in[I_XP] + (size_t)m * D) : (const f32x4*)(P->in[I_XS] + (size_t)(m - MP) * D)) + lane;
            f32x4* xo = (f32x4*)(X + (size_t)m * D) + lane; u32x2* xb = (u32x2*)(XB + (size_t)m * D) + lane;
            float sq = 0.f;
#pragma unroll
            for (int j = 0; j < 8; ++j) { const f32x4 v = xr[64 * j]; xo[64 * j] = v; u32x2 w; w.x = pk2(v.x, v.y); w.y = pk2(v.z, v.w); xb[64 * j] = w; sq += (v.x * v.x + v.y * v.y) + (v.z * v.z + v.w * v.w); }
            sq = wave_sum(sq);
            if (lane < 32) SS[(size_t)m * 32 + lane] = lane == 0 ? sq : 0.f;
            if (lane == 0) ((float*)(ws + WS_R))[m] = __builtin_amdgcn_rsqf(sq * (1.f / D) + EPS);
        }
    }
    {
        float* TAB = (float*)(ws + WS_TAB);
        for (int c = gw * 64 + lane; c < D; c += NGW * 64) {
            float l[4], mx = -1e30f;
#pragma unroll
            for (int i = 0; i < 4; ++i) { l[i] = P->in[I_LBL][i * D + c]; mx = fmaxf(mx, l[i]); }
            float e[4], s = 0.f;
#pragma unroll
            for (int i = 0; i < 4; ++i) { e[i] = __expf(l[i] - mx); s += e[i]; }
            TAB[c] = 0.f;
            TAB[D + c] = (e[1] + e[2] + e[3]) / s;
        }
    }
}

__device__ __forceinline__ void norm_phase(float* X, const float* gain, bf16_t* XN, int gw, int NGW, int lane) {
    for (int m = gw; m < M; m += NGW) {
        const f32x4* xr = (const f32x4*)(X + (size_t)m * D) + lane;
        f32x4 v[8]; float s = 0.f;
#pragma unroll
        for (int j = 0; j < 8; ++j) v[j] = xr[64 * j];
#pragma unroll
        for (int j = 0; j < 8; ++j) s += (v[j].x * v[j].x + v[j].y * v[j].y) + (v[j].z * v[j].z + v[j].w * v[j].w);
        const float r = __builtin_amdgcn_rsqf(wave_sum(s) * (1.f / D) + EPS);
        const f32x4* gr = (const f32x4*)gain + lane;
        u32x2* o = (u32x2*)(XN + (size_t)m * D) + lane;
#pragma unroll
        for (int j = 0; j < 8; ++j) { const f32x4 g = gr[64 * j]; u32x2 w; w.x = pk2(v[j].x * r * g.x, v[j].y * r * g.y); w.y = pk2(v[j].z * r * g.z, v[j].w * r * g.w); o[64 * j] = w; }
    }
}
__device__ __forceinline__ void final_phase(const float* X, const float* gain, float* Y, const float* PART, int gw, int NGW, int lane) {
    f32x4 gv[8];
#pragma unroll
    for (int j = 0; j < 8; ++j) gv[j] = *((const f32x4*)gain + lane + 64 * j);
    for (int m = gw; m < M; m += NGW) {
        const f32x4* xr = (const f32x4*)(X + (size_t)m * D) + lane;
        f32x4 v[8]; float s = 0.f;
#pragma unroll
        for (int j = 0; j < 8; ++j) v[j] = xr[64 * j];
        if (m >= MP) {
#pragma unroll
            for (int hh = 0; hh < 2; ++hh) {
                u32x2 pw[4][8];
#pragma unroll
                for (int j = 0; j < 4; ++j)
#pragma unroll
                    for (int sp = 0; sp < 8; ++sp) pw[j][sp] = *((const u32x2*)((const bf16_t*)PART + ((size_t)sp * MS + (m - MP)) * D) + lane + 64 * (4 * hh + j));
#pragma unroll
                for (int j = 0; j < 4; ++j) {
                    f32x4 a = (f32x4){0.f, 0.f, 0.f, 0.f};
#pragma unroll
                    for (int sp = 0; sp < 8; ++sp) a = a + (f32x4){bflo(pw[j][sp].x), bfhi(pw[j][sp].x), bflo(pw[j][sp].y), bfhi(pw[j][sp].y)};
                    v[4 * hh + j] = v[4 * hh + j] + a * 0.5f;
                }
            }
        }
#pragma unroll
        for (int j = 0; j < 8; ++j) s += (v[j].x * v[j].x + v[j].y * v[j].y) + (v[j].z * v[j].z + v[j].w * v[j].w);
        const float r = __builtin_amdgcn_rsqf(wave_sum(s) * (1.f / D) + EPS);
        f32x4* o = (f32x4*)(Y + (size_t)m * D) + lane;
#pragma unroll
        for (int j = 0; j < 8; ++j) { const f32x4 y = v[j] * r * gv[j]; __builtin_nontemporal_store(y, o + 64 * j); }
    }
}
template <int NG>
__device__ __forceinline__ void post_phase(const bf16_t* O  , const float* gain, const bf16_t* G, bf16_t* OG, int gw, int NGW, int lane) {
    f32x4 gv[8];
#pragma unroll
    for (int j = 0; j < 8; ++j) gv[j] = *((const f32x4*)gain + lane + 64 * j);
    for (int m = gw; m < M; m += NGW) {
        const u32x2* xr = (const u32x2*)(O + (size_t)m * D) + lane;
        const u32x2* gg = (const u32x2*)(G + (size_t)m * D) + lane;
        f32x4 v[8]; u32x2 vq[8], gq[8]; float s[NG];
#pragma unroll
        for (int j = 0; j < 8; ++j) { vq[j] = xr[64 * j]; gq[j] = gg[64 * j]; }
#pragma unroll
        for (int j = 0; j < 8; ++j) v[j] = (f32x4){bflo(vq[j].x), bfhi(vq[j].x), bflo(vq[j].y), bfhi(vq[j].y)};
#pragma unroll
        for (int g = 0; g < NG; ++g) s[g] = 0.f;
#pragma unroll
        for (int j = 0; j < 8; ++j) s[j * NG / 8] += (v[j].x * v[j].x + v[j].y * v[j].y) + (v[j].z * v[j].z + v[j].w * v[j].w);
        float r[NG];
#pragma unroll
        for (int g = 0; g < NG; ++g) r[g] = __builtin_amdgcn_rsqf(wave_sum(s[g]) * ((float)NG / D) + EPS);
        u32x2* o = (u32x2*)(OG + (size_t)m * D) + lane;
#pragma unroll
        for (int j = 0; j < 8; ++j) { const f32x4 g = gv[j]; const u32x2 gw2 = gq[j]; const float rr = r[j * NG / 8];
            u32x2 w; w.x = pk2(v[j].x * rr * g.x * bflo(gw2.x), v[j].y * rr * g.y * bfhi(gw2.x)); w.y = pk2(v[j].z * rr * g.z * bflo(gw2.y), v[j].w * rr * g.w * bfhi(gw2.y)); o[64 * j] = w; }
    }
}

template <int NP  , int HALF>
__device__ __forceinline__ void fix_phase(float* X, bf16_t* XB, float* SS, float* R, const float* PART, int nsplit, const float* colscale, const float* RP, LAS unsigned char* lds, int bx, int wave, int gw, int NGW, int lane) {
    {
        const int m = MP + 4 * bx + (wave & 3), hf = wave >> 2;
        f32x4* xr = (f32x4*)(X + (size_t)m * D) + lane + 256 * hf; u32x2* xb = (u32x2*)(XB + (size_t)m * D) + lane + 256 * hf;
        u32x2 pw[4][8]; f32x4 xv[4];
#pragma unroll
        for (int j = 0; j < 4; ++j) { xv[j] = xr[64 * j];
#pragma unroll
            for (int sp = 0; sp < 8; ++sp) pw[j][sp] = (sp < nsplit) ? *((const u32x2*)((const bf16_t*)PART + ((size_t)sp * MS + (m - MP)) * D) + lane + 256 * hf + 64 * j) : (u32x2){0u, 0u}; }
        float rpv = 0.f; if (NP > 0) rpv = lane < NP ? RP[(size_t)m * NP + lane] : 0.f;
        f32x4 csv[4];
#pragma unroll
        for (int j = 0; j < 4; ++j) csv[j] = colscale ? *((const f32x4*)colscale + lane + 256 * hf + 64 * j) : (f32x4){1.f, 1.f, 1.f, 1.f};
        { float sv[2];
#pragma unroll
          for (int i = 0; i < 2; ++i) { const int mm = 2 * (gw + i * NGW) + (lane >> 5); sv[i] = mm < MP ? SS[(size_t)mm * 32 + (lane & 31)] : 0.f; }
#pragma unroll
          for (int i = 0; i < 2; ++i) { const int mm = 2 * (gw + i * NGW) + (lane >> 5); float s2 = sv[i];
#pragma unroll
              for (int o = 1; o < 32; o <<= 1) s2 += __shfl_xor(s2, o);
              if ((lane & 31) == 0 && mm < MP) R[mm] = __builtin_amdgcn_rsqf(s2 * (1.f / D) + EPS); } }
        float r = HALF ? 0.5f : 1.0f;
        if (NP > 0) { const float s3 = wave_sum(rpv); r *= __builtin_amdgcn_rsqf(s3 * (1.f / D) + EPS); }
        float sq = 0.f;
#pragma unroll
        for (int j = 0; j < 4; ++j) {
            f32x4 a = (f32x4){0.f, 0.f, 0.f, 0.f};
#pragma unroll
            for (int sp = 0; sp < 8; ++sp) a = a + (f32x4){bflo(pw[j][sp].x), bfhi(pw[j][sp].x), bflo(pw[j][sp].y), bfhi(pw[j][sp].y)};
            const f32x4 v = xv[j] + a * csv[j] * r;
            xr[64 * j] = v; u32x2 w; w.x = pk2(v.x, v.y); w.y = pk2(v.z, v.w); xb[64 * j] = w;
            sq += (v.x * v.x + v.y * v.y) + (v.z * v.z + v.w * v.w);
        }
        sq = wave_sum(sq);
        LAS float* red = (LAS float*)lds;
        lds_barrier();
        if (lane == 0) red[wave] = sq;
        lds_barrier();
        if (hf == 0) { const float tot = red[wave] + red[wave + 4];
            if (lane < 32) SS[(size_t)m * 32 + lane] = lane == 0 ? tot : 0.f;
            if (lane == 0) R[m] = __builtin_amdgcn_rsqf(tot * (1.f / D) + EPS); }
    }
}

template <int KT> struct LdBf;
template <> struct LdBf<4> { static __device__ __forceinline__ void ld(const bf16_t* p, float* o) { const u32x2 w = *(const u32x2*)p; o[0] = bflo(w.x); o[1] = bfhi(w.x); o[2] = bflo(w.y); o[3] = bfhi(w.y); } };
template <> struct LdBf<8> { static __device__ __forceinline__ void ld(const bf16_t* p, float* o) { const u32x4 w = *(const u32x4*)p; o[0] = bflo(w.x); o[1] = bfhi(w.x); o[2] = bflo(w.y); o[3] = bfhi(w.y); o[4] = bflo(w.z); o[5] = bfhi(w.z); o[6] = bflo(w.w); o[7] = bfhi(w.w); } };
template <int K, int VH, int NH>
__device__ __forceinline__ void scan_simple(const bf16_t* Q, const bf16_t* KK, const float* LF, const bf16_t* V, float* O,
                                            const float* S0, float* SPo, float* SSo, int tid, int G) {
    constexpr int KT = K / 32, NVB = VH / 16;
    const int vi = tid >> 5, kg = tid & 31;
    const int nunits = (PB + SB) * NH * NVB;
    for (int u = blockIdx.x; u < nunits; u += G) {
        const int seq = u / (NH * NVB), rem = u % (NH * NVB), h = rem / NVB, vb = rem % NVB;
        int row0, T; if (seq < PB) { row0 = seq * PT; T = PT; } else { row0 = MP + (seq - PB) * ST; T = ST; }
        float S[KT];
        const size_t sidx = ((size_t)h * K + kg * KT) * VH + vb * 16 + vi;
        if (seq >= PB) { const float* s0 = S0 + (size_t)(seq - PB) * NH * K * VH + sidx;
#pragma unroll
            for (int j = 0; j < KT; ++j) S[j] = s0[(size_t)j * VH]; }
        else {
#pragma unroll
            for (int j = 0; j < KT; ++j) S[j] = 0.f; }
        const int ccol = h * K + kg * KT, vcol = h * VH + vb * 16 + vi;
#pragma unroll 4
        for (int t = 0; t < T; ++t) {
            const size_t r = (size_t)(row0 + t) * D;
            float qf[KT], kf[KT], lf[KT];
            LdBf<KT>::ld(Q + r + ccol, qf); LdBf<KT>::ld(KK + r + ccol, kf);
#pragma unroll
            for (int j = 0; j < KT; j += 4) { const f32x4 l4 = *(const f32x4*)(LF + r + ccol + j); lf[j] = l4.x; lf[j + 1] = l4.y; lf[j + 2] = l4.z; lf[j + 3] = l4.w; }
            const float vv = bf2f(V[r + vcol]);
            float po = 0.f;
#pragma unroll
            for (int j = 0; j < KT; ++j) { S[j] = __expf(lf[j]) * S[j] + kf[j] * vv; po += qf[j] * S[j]; }
#pragma unroll
            for (int o = 1; o < 32; o <<= 1) po += __shfl_xor(po, o);
            if (kg == 0) O[r + vcol] = po;
        }
        float* so = (seq < PB ? SPo + (size_t)seq * NH * K * VH : SSo + (size_t)(seq - PB) * NH * K * VH) + sidx;
#pragma unroll
        for (int j = 0; j < KT; ++j) so[(size_t)j * VH] = S[j];
    }
}


__device__ __forceinline__ int permK(int c) { const int kk = c & 31; return (c & ~31) + 8 * ((kk & 15) >> 2) + 4 * (kk >> 4) + (kk & 3); }
template <int K, int VH, int NH>
__device__ __forceinline__ void scan_s1(const bf16_t* Q, const bf16_t* KK, const float* LF, const bf16_t* V, bf16_t* QI, bf16_t* KDT, bf16_t* AM, bf16_t* VT, float* DL,
                                        LAS unsigned char* lds, int tid, int G, int bx) {
    constexpr int KH = K / 2, RG = 512 / KH, RPT = 64 / RG, KS = K * 2 + 16, NHK = NH * K;
    constexpr int L_TOT = 0, L_QT = 4096, L_KT = L_QT + 64 * KS;
    static_assert(RG * K * 4 <= L_QT && L_KT + 64 * KS <= RING_BYTES && RPT % 8 == 0, "S1 LDS / shape");
    const int c = 2 * (tid % KH), rg = tid / KH, lane = tid & 63, wave = tid >> 6, l15 = lane & 15, g4 = lane >> 4;
    LAS float* TOT = (LAS float*)(lds + L_TOT);
    for (int u = bx; u < 144 * NH; u += G) {
        const int blk = u / NH, h = u % NH, r0 = blk * 64; const bool is_prompt = blk < 128;
        lds_barrier();
        f32x2 b[RPT]; unsigned lw[RPT], qw[RPT], kw[RPT];
        { const size_t ro = (size_t)(r0 + rg * RPT) * D + h * K + c;
#pragma unroll
          for (int i = 0; i < RPT; ++i) { lw[i] = *(const unsigned*)((const unsigned short*)LF + ro + (size_t)i * D); qw[i] = *(const unsigned*)(Q + ro + (size_t)i * D); kw[i] = *(const unsigned*)(KK + ro + (size_t)i * D); } }
#pragma unroll
        for (int i = 0; i < RPT; ++i) b[i] = (f32x2){hlo(lw[i]), hhi(lw[i])};
        f32x2 bref = (f32x2){0.f, 0.f}, blast = (f32x2){0.f, 0.f};
        if (is_prompt) {
#pragma unroll
            for (int i = 1; i < RPT; ++i) b[i] = b[i] + b[i - 1];
            *(LAS f32x2*)(TOT + rg * K + c) = b[RPT - 1];
            lds_barrier();
            f32x2 pre = (f32x2){0.f, 0.f}, tot = (f32x2){0.f, 0.f};
#pragma unroll
            for (int r = 0; r < RG; ++r) { const f32x2 t = *(const LAS f32x2*)(TOT + r * K + c); if (r < rg) pre = pre + t; if (r * RPT < 32) bref = bref + t; tot = tot + t; }
            blast = tot;
#pragma unroll
            for (int i = 0; i < RPT; ++i) b[i] = b[i] + pre;
        } else {
#pragma unroll
            for (int i = 0; i < RPT; ++i) if (i & 7) b[i] = b[i] + b[i - 1];
        }
        unsigned kd0[RPT / 2], kd1[RPT / 2];
#pragma unroll
        for (int i = 0; i < RPT; i += 2) {
            float k0v[2], k1v[2];
#pragma unroll
            for (int e = 0; e < 2; ++e) {
                const int t = rg * RPT + i + e;
                const f32x2 bb = b[i + e], bl = is_prompt ? blast : b[(i + e) | 7];
                const float q0 = bflo(qw[i + e]), q1 = bfhi(qw[i + e]), k0 = bflo(kw[i + e]), k1 = bfhi(kw[i + e]);
                const float qi0 = q0 * __expf(bb.x), qi1 = q1 * __expf(bb.y);
                k0v[e] = k0 * __expf(bl.x - bb.x); k1v[e] = k1 * __expf(bl.y - bb.y);
                const float qt0 = is_prompt ? q0 * __expf(fminf(bb.x - bref.x, 80.f)) : qi0, qt1 = is_prompt ? q1 * __expf(fminf(bb.y - bref.y, 80.f)) : qi1;
                const float kt0 = k0 * __expf(fminf(bref.x - bb.x, 80.f)), kt1 = k1 * __expf(fminf(bref.y - bb.y, 80.f));
                *(unsigned*)(QI + (size_t)(r0 + t) * NHK + h * K + permK(c)) = pk2(qi0, qi1);
                *(LAS unsigned*)(lds + L_QT + t * KS + c * 2) = pk2(qt0, qt1);
                *(LAS unsigned*)(lds + L_KT + t * KS + c * 2) = pk2(kt0, kt1);
                if (!is_prompt && ((i + e) & 7) == 7) *(f32x2*)(DL + (size_t)(128 + (blk - 128) * 8 + (t >> 3)) * NHK + h * K + c) = (f32x2){__expf(bb.x), __expf(bb.y)};
            }
            kd0[i / 2] = pk2(k0v[0], k0v[1]); kd1[i / 2] = pk2(k1v[0], k1v[1]);
        }
        if (is_prompt && rg == 0) *(f32x2*)(DL + (size_t)blk * NHK + h * K + c) = (f32x2){__expf(blast.x), __expf(blast.y)};
        { bf16_t* kp = KDT + ((size_t)(blk * NH + h) * K + c) * 64 + rg * RPT;
#pragma unroll
          for (int n = 0; n < RPT / 8; ++n) { u32x4 w; w.x = kd0[4 * n]; w.y = kd0[4 * n + 1]; w.z = kd0[4 * n + 2]; w.w = kd0[4 * n + 3]; *(u32x4*)(kp + 8 * n) = w;
              u32x4 w2; w2.x = kd1[4 * n]; w2.y = kd1[4 * n + 1]; w2.z = kd1[4 * n + 2]; w2.w = kd1[4 * n + 3]; *(u32x4*)(kp + 64 + 8 * n) = w2; } }
        lds_barrier();
        { const int tt = wave >> 1;
          bf16x8 bfr[K / 32];
#pragma unroll
          for (int ks = 0; ks < K / 32; ++ks) bfr[ks] = *(const LAS bf16x8*)(lds + L_QT + (16 * tt + l15) * KS + ks * 64 + g4 * 16);
#pragma unroll
          for (int e = 0; e < 2; ++e) {
              const int st = (wave & 1) * 2 + e;
              f32x4 acc = (f32x4){0.f, 0.f, 0.f, 0.f};
              if (st <= tt) {
                  bf16x8 af[K / 32];
#pragma unroll
                  for (int ks = 0; ks < K / 32; ++ks) af[ks] = *(const LAS bf16x8*)(lds + L_KT + (16 * st + l15) * KS + ks * 64 + g4 * 16);
                  __builtin_amdgcn_sched_barrier(0);
#pragma unroll
                  for (int ks = 0; ks < K / 32; ++ks) acc = __builtin_amdgcn_mfma_f32_16x16x32_bf16(af[ks], bfr[ks], acc, 0, 0, 0);
                  __builtin_amdgcn_sched_barrier(0);
              }
              const int t = 16 * tt + l15; float o[4];
#pragma unroll
              for (int r = 0; r < 4; ++r) { const int sidx = 16 * st + 4 * g4 + r; const bool keep = (sidx <= t) && (is_prompt || (sidx >> 3) == (t >> 3)); o[r] = keep ? acc[r] : 0.f; }
              u32x2 w; w.x = pk2(o[0], o[1]); w.y = pk2(o[2], o[3]);
              *(u32x2*)(AM + ((size_t)(blk * NH + h) * 64 + t) * 64 + 16 * st + 4 * g4) = w;
          } }
    }
}

template <int VS> __device__ __forceinline__ void v_frag_tr2(unsigned a, bf16x8& f0, bf16x8& f1) {
    u32x2 r0, r1, r2, r3;
    asm volatile("ds_read_b64_tr_b16 %0, %4\n\tds_read_b64_tr_b16 %1, %5\n\tds_read_b64_tr_b16 %2, %6\n\tds_read_b64_tr_b16 %3, %7\n\ts_waitcnt lgkmcnt(0)"
                 : "=&v"(r0), "=&v"(r1), "=&v"(r2), "=&v"(r3) : "v"(a), "v"(a + 4 * VS), "v"(a + 32 * VS), "v"(a + 36 * VS) : "memory");
    union { u32x4 u; bf16x8 v; } x, y; x.u = (u32x4){r0.x, r0.y, r1.x, r1.y}; y.u = (u32x4){r2.x, r2.y, r3.x, r3.y}; f0 = x.v; f1 = y.v;
}
template <int VS> __device__ __forceinline__ bf16x8 v_frag_tr1(unsigned a) {
    u32x2 r0, r1;
    asm volatile("ds_read_b64_tr_b16 %0, %2\n\tds_read_b64_tr_b16 %1, %3\n\ts_waitcnt lgkmcnt(0)" : "=&v"(r0), "=&v"(r1) : "v"(a), "v"(a + 4 * VS) : "memory");
    union { u32x4 u; bf16x8 v; } x; x.u = (u32x4){r0.x, r0.y, r1.x, r1.y}; return x.v;
}

template <int K, int VH, int NH, bool FUSE>
__device__ __forceinline__ void scan_s2_old(const bf16_t* QI, const bf16_t* KDT, const bf16_t* AM, const bf16_t* VT, const float* DL, const float* S0, float* SPo, float* SSo, float* O,
                                        const bf16_t* Gin, bf16_t* OG, float* SSO, LAS unsigned char* lds, unsigned* qhead, int tid, int G, int bx) {
    constexpr int NVQ = VH / 128, NKT = K / 16, NKS = K / 32, QS = K * 2 + 16, RS = 144, NHK = NH * K;
    constexpr int L_QI = 0, L_KDT = L_QI + 64 * QS, L_A = L_KDT + K * RS, L_VT = L_A + 64 * RS, L_DL = L_VT + 128 * RS, L_END = L_DL + 8 * K * 4;
    constexpr int L_O = L_END, OTS = 132;
    static_assert((FUSE ? L_O + 64 * OTS * 4 : L_END) <= RING_BYTES && (!FUSE || VH == 128), "S2 LDS");
    LAS float* OT = (LAS float*)(lds + L_O);
    u32x4 gpre0 = (u32x4){0u, 0u, 0u, 0u}, gpre1 = gpre0;
#define S2_G_LOAD(blk_, h_, rb, nr) do { if (FUSE && tid < (nr) * 8) { const size_t _go = (size_t)((blk_) * 64 + (rb) + (tid >> 3)) * D + (h_) * VH + (tid & 7) * 16; gpre0 = *(const u32x4*)(Gin + _go); gpre1 = *(const u32x4*)(Gin + _go + 8); } } while (0)
#define S2_OG_EPI(blk_, h_, rb, nr) do { if (tid < (nr) * 8) { const int _t = (rb) + (tid >> 3), _seg = tid & 7; const LAS float* _op = OT + _t * OTS + _seg * 16; \
        const f32x4 _o0 = *(const LAS f32x4*)_op, _o1 = *(const LAS f32x4*)(_op + 4), _o2 = *(const LAS f32x4*)(_op + 8), _o3 = *(const LAS f32x4*)(_op + 12); \
        const size_t _go = (size_t)((blk_) * 64 + _t) * D + (h_) * VH + _seg * 16; const u32x4 _g0 = gpre0, _g1 = gpre1; \
        float _ss = ((_o0.x * _o0.x + _o0.y * _o0.y) + (_o0.z * _o0.z + _o0.w * _o0.w)) + ((_o1.x * _o1.x + _o1.y * _o1.y) + (_o1.z * _o1.z + _o1.w * _o1.w)) \
                  + ((_o2.x * _o2.x + _o2.y * _o2.y) + (_o2.z * _o2.z + _o2.w * _o2.w)) + ((_o3.x * _o3.x + _o3.y * _o3.y) + (_o3.z * _o3.z + _o3.w * _o3.w)); \
        u32x4 _w0, _w1; _w0.x = cvt_pk_bf16(_o0.x * bflo(_g0.x), _o0.y * bfhi(_g0.x)); _w0.y = cvt_pk_bf16(_o0.z * bflo(_g0.y), _o0.w * bfhi(_g0.y)); \
        _w0.z = cvt_pk_bf16(_o1.x * bflo(_g0.z), _o1.y * bfhi(_g0.z)); _w0.w = cvt_pk_bf16(_o1.z * bflo(_g0.w), _o1.w * bfhi(_g0.w)); \
        _w1.x = cvt_pk_bf16(_o2.x * bflo(_g1.x), _o2.y * bfhi(_g1.x)); _w1.y = cvt_pk_bf16(_o2.z * bflo(_g1.y), _o2.w * bfhi(_g1.y)); \
        _w1.z = cvt_pk_bf16(_o3.x * bflo(_g1.z), _o3.y * bfhi(_g1.z)); _w1.w = cvt_pk_bf16(_o3.z * bflo(_g1.w), _o3.w * bfhi(_g1.w)); \
        *(u32x4*)(OG + _go) = _w0; *(u32x4*)(OG + _go + 8) = _w1; \
        _ss += __shfl_xor(_ss, 1); _ss += __shfl_xor(_ss, 2); _ss += __shfl_xor(_ss, 4); \
        if (_seg == 0) SSO[(size_t)((blk_) * 64 + _t) * 16 + (h_)] = _ss; } } while (0)
    constexpr int P_QI = 64 * (K / 8) / 512, P_KD = K * 8 / 512;
    const int lane = tid & 63, wave = tid >> 6, l15 = lane & 15, g4 = lane >> 4;
    volatile LAS unsigned* qslot = (volatile LAS unsigned*)(lds + MISC_OFF + 64);
    const unsigned vtr_a = (unsigned)(size_t)(lds + L_VT) + (8 * g4 + (l15 >> 2)) * 272 + (16 * wave + 4 * (lane & 3)) * 2, vtr_a128 = vtr_a;

    u32x4 rq[P_QI], rk[P_KD], ra, rv[2], rd;
#define S2_LOAD(blk_, h_, vq_, ndl_) do { const int _blk = (blk_), _h = (h_), _vq = (vq_); \
        _Pragma("unroll") for (int n = 0; n < P_QI; ++n) { const int p = tid + n * 512, row = p / (K / 8), pc = p % (K / 8); rq[n] = *(const u32x4*)(QI + (size_t)(_blk * 64 + row) * NHK + _h * K + pc * 8); } \
        _Pragma("unroll") for (int n = 0; n < P_KD; ++n) { const int p = tid + n * 512; rk[n] = *(const u32x4*)(KDT + (size_t)(_blk * NH + _h) * K * 64 + (size_t)p * 8); } \
        ra = *(const u32x4*)(AM + (size_t)(_blk * NH + _h) * 4096 + (size_t)tid * 8); \
        _Pragma("unroll") for (int n = 0; n < 2; ++n) { const int p = tid + n * 512; rv[n] = *(const u32x4*)(VT + (size_t)(_blk * 64 + (p >> 4)) * D + _h * VH + _vq * 128 + (p & 15) * 8); } \
        if ((ndl_) == 1) { if (tid < K / 4) rd = *(const u32x4*)(DL + (size_t)_blk * NHK + _h * K + tid * 4); } \
        else { if (tid < 2 * K) { const int sg = tid / (K / 4), pc = tid % (K / 4); rd = *(const u32x4*)(DL + (size_t)(128 + (_blk - 128) * 8 + sg) * NHK + _h * K + pc * 4); } } } while (0)
#define S2_STORE(ndl_) do { \
        _Pragma("unroll") for (int n = 0; n < P_QI; ++n) { const int p = tid + n * 512, row = p / (K / 8), pc = p % (K / 8); *(LAS u32x4*)(lds + L_QI + row * QS + pc * 16) = rq[n]; } \
        _Pragma("unroll") for (int n = 0; n < P_KD; ++n) { const int p = tid + n * 512; *(LAS u32x4*)(lds + L_KDT + (p >> 3) * RS + (p & 7) * 16) = rk[n]; } \
        *(LAS u32x4*)(lds + L_A + (tid >> 3) * RS + (tid & 7) * 16) = ra; \
        _Pragma("unroll") for (int n = 0; n < 2; ++n) { const int p = tid + n * 512; *(LAS u32x4*)(lds + L_VT + (p >> 4) * 272 + (p & 15) * 16) = rv[n]; } \
        if ((ndl_) == 1) { if (tid < K / 4) *(LAS u32x4*)(lds + L_DL + tid * 16) = rd; } \
        else { if (tid < 2 * K) *(LAS u32x4*)(lds + L_DL + tid * 16) = rd; } } while (0)

    f32x4 S[NKT];
    if (bx < PB * NH * NVQ) {
        const int b = bx / (NH * NVQ), h = (bx / NVQ) % NH, vq = bx % NVQ;
        const int col = h * VH + vq * 128 + wave * 16 + l15;
#pragma unroll
        for (int kt = 0; kt < NKT; ++kt) S[kt] = (f32x4){0.f, 0.f, 0.f, 0.f};
        lds_barrier();
        S2_LOAD(b * 32, h, vq, 1); S2_STORE(1);
        lds_barrier();
#pragma unroll 1
        for (int ch = 0; ch < 32; ++ch) {
            const int blk = b * 32 + ch;
            if (ch + 1 < 32) S2_LOAD(blk + 1, h, vq, 1);
            S2_G_LOAD(blk, h, 0, 64);
            bf16x8 vfr[2];
            v_frag_tr2<272>(vtr_a, vfr[0], vfr[1]);
            f32x4 oacc[4];
#pragma unroll
            for (int tt = 0; tt < 4; ++tt) oacc[tt] = (f32x4){0.f, 0.f, 0.f, 0.f};
#pragma unroll
            for (int ks = 0; ks < NKS; ++ks) {
                bf16x8 aq[4];
#pragma unroll
                for (int tt = 0; tt < 4; ++tt) aq[tt] = *(const LAS bf16x8*)(lds + L_QI + (16 * tt + l15) * QS + ks * 64 + g4 * 16);
                __builtin_amdgcn_sched_barrier(0);
                union { u32x4 u; bf16x8 v; } sb;
                sb.u.x = cvt_pk_bf16(S[2 * ks][0], S[2 * ks][1]); sb.u.y = cvt_pk_bf16(S[2 * ks][2], S[2 * ks][3]);
                sb.u.z = cvt_pk_bf16(S[2 * ks + 1][0], S[2 * ks + 1][1]); sb.u.w = cvt_pk_bf16(S[2 * ks + 1][2], S[2 * ks + 1][3]);
#pragma unroll
                for (int tt = 0; tt < 4; ++tt) oacc[tt] = __builtin_amdgcn_mfma_f32_16x16x32_bf16(aq[tt], sb.v, oacc[tt], 0, 0, 0);
                __builtin_amdgcn_sched_barrier(0);
            }
#pragma unroll
            for (int tp = 0; tp < 2; ++tp) { bf16x8 aa[2][2];
#pragma unroll
              for (int i = 0; i < 2; ++i)
#pragma unroll
                  for (int ss = 0; ss < 2; ++ss) aa[i][ss] = *(const LAS bf16x8*)(lds + L_A + (16 * (2 * tp + i) + l15) * RS + ss * 64 + g4 * 16);
              __builtin_amdgcn_sched_barrier(0);
#pragma unroll
              for (int i = 0; i < 2; ++i)
#pragma unroll
                  for (int ss = 0; ss < 2; ++ss) oacc[2 * tp + i] = __builtin_amdgcn_mfma_f32_16x16x32_bf16(aa[i][ss], vfr[ss], oacc[2 * tp + i], 0, 0, 0);
              __builtin_amdgcn_sched_barrier(0); }
#pragma unroll
            for (int kh = 0; kh < NKT / 2; ++kh) {
                bf16x8 ak[2][2]; f32x4 dlv[2];
#pragma unroll
                for (int k2 = 0; k2 < 2; ++k2) { dlv[k2] = *(const LAS f32x4*)(lds + L_DL + (16 * (kh * 2 + k2) + 4 * g4) * 4);
#pragma unroll
                    for (int ss = 0; ss < 2; ++ss) ak[k2][ss] = *(const LAS bf16x8*)(lds + L_KDT + (16 * (kh * 2 + k2) + l15) * RS + ss * 64 + g4 * 16); }
                __builtin_amdgcn_sched_barrier(0);
#pragma unroll
                for (int k2 = 0; k2 < 2; ++k2) { const int kt = kh * 2 + k2; S[kt] = S[kt] * dlv[k2];
#pragma unroll
                    for (int ss = 0; ss < 2; ++ss) S[kt] = __builtin_amdgcn_mfma_f32_16x16x32_bf16(ak[k2][ss], vfr[ss], S[kt], 0, 0, 0); }
                __builtin_amdgcn_sched_barrier(0);
            }
#pragma unroll
            for (int tt = 0; tt < 4; ++tt)
#pragma unroll
                for (int r = 0; r < 4; ++r) { if (FUSE) OT[(16 * tt + 4 * g4 + r) * OTS + wave * 16 + l15] = oacc[tt][r]; else ((bf16_t*)O)[(size_t)(blk * 64 + 16 * tt + 4 * g4 + r) * D + col] = (bf16_t)pk2(oacc[tt][r], 0.f); }
            lds_barrier();
            if (ch + 1 < 32) S2_STORE(1);
            if (FUSE) S2_OG_EPI(blk, h, 0, 64);
            lds_barrier();
        }
        float* so = SPo + ((size_t)(b * NH + h) * K) * VH + vq * 128 + wave * 16 + l15;
#pragma unroll
        for (int kt = 0; kt < NKT; ++kt)
#pragma unroll
            for (int r = 0; r < 4; ++r) __builtin_nontemporal_store(S[kt][r], so + (size_t)(16 * kt + 4 * g4 + r) * VH);
    }
    constexpr int NTASK = 16 * NH * NVQ * 2;
    for (;;) {
        lds_barrier();
        if (tid == 0) qslot[0] = __hip_atomic_fetch_add(qhead, 1u, __ATOMIC_RELAXED, __HIP_MEMORY_SCOPE_AGENT);
        lds_barrier();
        const int task = (int)qslot[0];
        if (task >= NTASK) break;
        const int half = task & 1, vq = (task >> 1) % NVQ, h = (task / (2 * NVQ)) % NH, sblk = task / (2 * NVQ * NH), blk = 128 + sblk;
        const int col = h * VH + vq * 128 + wave * 16 + l15;
        S2_LOAD(blk, h, vq, 8); S2_STORE(8);
        S2_G_LOAD(blk, h, 32 * half, 32);
        lds_barrier();
        const bf16x8 vfr0 = v_frag_tr1<272>(vtr_a128 + half * 32 * 272);
#pragma unroll 1
        for (int jj = 0; jj < 4; ++jj) {
            const int j = half * 4 + jj, bseq = sblk * 8 + j;
            const float* s0 = S0 + ((size_t)(bseq * NH + h) * K) * VH + vq * 128 + wave * 16 + l15;
#pragma unroll
            for (int kt = 0; kt < NKT; ++kt)
#pragma unroll
                for (int r = 0; r < 4; ++r) S[kt][r] = __builtin_nontemporal_load(s0 + (size_t)(16 * kt + 4 * g4 + r) * VH);
            const int arow = 8 * j + (l15 & 7);
            constexpr int BQ = 4, BK = (NKT > 8) ? 4 : 8;
            const bf16x8 aAs = *(const LAS bf16x8*)(lds + L_A + arow * RS + half * 64 + g4 * 16);
            f32x4 oacc = (f32x4){0.f, 0.f, 0.f, 0.f};
#pragma unroll
            for (int qb = 0; qb < NKS / BQ; ++qb) {
                bf16x8 aqs[BQ];
#pragma unroll
                for (int i = 0; i < BQ; ++i) aqs[i] = *(const LAS bf16x8*)(lds + L_QI + arow * QS + (qb * BQ + i) * 64 + g4 * 16);
                __builtin_amdgcn_sched_barrier(0);
#pragma unroll
                for (int i = 0; i < BQ; ++i) { const int ks = qb * BQ + i;
                    union { u32x4 u; bf16x8 v; } sb;
                    sb.u.x = cvt_pk_bf16(S[2 * ks][0], S[2 * ks][1]); sb.u.y = cvt_pk_bf16(S[2 * ks][2], S[2 * ks][3]);
                    sb.u.z = cvt_pk_bf16(S[2 * ks + 1][0], S[2 * ks + 1][1]); sb.u.w = cvt_pk_bf16(S[2 * ks + 1][2], S[2 * ks + 1][3]);
                    oacc = __builtin_amdgcn_mfma_f32_16x16x32_bf16(aqs[i], sb.v, oacc, 0, 0, 0); }
                __builtin_amdgcn_sched_barrier(0);
            }
            oacc = __builtin_amdgcn_mfma_f32_16x16x32_bf16(aAs, vfr0, oacc, 0, 0, 0);
#pragma unroll
            for (int kh = 0; kh < NKT / BK; ++kh) {
                u32x4 akd[BK]; f32x4 dls[BK];
#pragma unroll
                for (int k8 = 0; k8 < BK; ++k8) { akd[k8] = *(const LAS u32x4*)(lds + L_KDT + (16 * (kh * BK + k8) + l15) * RS + half * 64 + g4 * 16);
                    dls[k8] = *(const LAS f32x4*)(lds + L_DL + j * K * 4 + (16 * (kh * BK + k8) + 4 * g4) * 4); }
                __builtin_amdgcn_sched_barrier(0);
#pragma unroll
                for (int k8 = 0; k8 < BK; ++k8) { const int kt = kh * BK + k8;
                    S[kt] = S[kt] * dls[k8];
                    union { u32x4 u; bf16x8 v; } af; af.u = akd[k8];
                    if (g4 != jj) af.u = (u32x4){0u, 0u, 0u, 0u};
                    S[kt] = __builtin_amdgcn_mfma_f32_16x16x32_bf16(af.v, vfr0, S[kt], 0, 0, 0); }
                __builtin_amdgcn_sched_barrier(0);
            }
            if (g4 < 2) {
#pragma unroll
                for (int r = 0; r < 4; ++r) { if (FUSE) OT[(8 * j + 4 * g4 + r) * OTS + wave * 16 + l15] = oacc[r]; else ((bf16_t*)O)[(size_t)(blk * 64 + 8 * j + 4 * g4 + r) * D + col] = (bf16_t)pk2(oacc[r], 0.f); }
            }
            float* so = SSo + ((size_t)(bseq * NH + h) * K) * VH + vq * 128 + wave * 16 + l15;
#pragma unroll
            for (int kt = 0; kt < NKT; ++kt)
#pragma unroll
                for (int r = 0; r < 4; ++r) __builtin_nontemporal_store(S[kt][r], so + (size_t)(16 * kt + 4 * g4 + r) * VH);
        }
        if (FUSE) { lds_barrier(); S2_OG_EPI(blk, h, 32 * half, 32); }
    }
#undef S2_OG_EPI
#undef S2_G_LOAD
#undef S2_LOAD
#undef S2_STORE
}

template <int K, int VH, int NH, bool FUSE>
__device__ __forceinline__ void scan_s2(const bf16_t* QI, const bf16_t* KDT, const bf16_t* AM, const bf16_t* VT, const float* DL, const float* S0, float* SPo, float* SSo, float* O,
                                        const bf16_t* Gin, bf16_t* OG, float* SSO, LAS unsigned char* lds, unsigned* qhead, int tid, int G, int bx) {
    constexpr int NVQ = VH / 128, NVQ2 = VH / 64, NKT = K / 16, NKS = K / 32, QS = K * 2 + 16, RS = 144, NHK = NH * K;
    constexpr int L_QI = 0, L_KDT = L_QI + 64 * QS, L_A = L_KDT + K * RS, L_VT = L_A + 64 * RS, L_DL = L_VT + 128 * RS, L_END = L_DL + 8 * K * 4;
    constexpr int L_O = L_END, OTS = 132;
    static_assert((FUSE ? L_O + 64 * OTS * 4 : L_END) <= RING_BYTES && (!FUSE || VH == 128), "S2 LDS");
    LAS float* OT = (LAS float*)(lds + L_O);
    u32x4 gpre0 = (u32x4){0u, 0u, 0u, 0u}, gpre1 = gpre0;
#define S2_G_LOAD(blk_, h_, rb, nr) do { if (FUSE && tid < (nr) * 8) { const size_t _go = (size_t)((blk_) * 64 + (rb) + (tid >> 3)) * D + (h_) * VH + (tid & 7) * 16; gpre0 = *(const u32x4*)(Gin + _go); gpre1 = *(const u32x4*)(Gin + _go + 8); } } while (0)
#define S2_OG_EPI(blk_, h_, rb, nr) do { if (tid < (nr) * 8) { const int _t = (rb) + (tid >> 3), _seg = tid & 7; const LAS float* _op = OT + _t * OTS + _seg * 16; \
        const f32x4 _o0 = *(const LAS f32x4*)_op, _o1 = *(const LAS f32x4*)(_op + 4), _o2 = *(const LAS f32x4*)(_op + 8), _o3 = *(const LAS f32x4*)(_op + 12); \
        const size_t _go = (size_t)((blk_) * 64 + _t) * D + (h_) * VH + _seg * 16; const u32x4 _g0 = gpre0, _g1 = gpre1; \
        float _ss = ((_o0.x * _o0.x + _o0.y * _o0.y) + (_o0.z * _o0.z + _o0.w * _o0.w)) + ((_o1.x * _o1.x + _o1.y * _o1.y) + (_o1.z * _o1.z + _o1.w * _o1.w)) \
                  + ((_o2.x * _o2.x + _o2.y * _o2.y) + (_o2.z * _o2.z + _o2.w * _o2.w)) + ((_o3.x * _o3.x + _o3.y * _o3.y) + (_o3.z * _o3.z + _o3.w * _o3.w)); \
        u32x4 _w0, _w1; _w0.x = cvt_pk_bf16(_o0.x * bflo(_g0.x), _o0.y * bfhi(_g0.x)); _w0.y = cvt_pk_bf16(_o0.z * bflo(_g0.y), _o0.w * bfhi(_g0.y)); \
        _w0.z = cvt_pk_bf16(_o1.x * bflo(_g0.z), _o1.y * bfhi(_g0.z)); _w0.w = cvt_pk_bf16(_o1.z * bflo(_g0.w), _o1.w * bfhi(_g0.w)); \
        _w1.x = cvt_pk_bf16(_o2.x * bflo(_g1.x), _o2.y * bfhi(_g1.x)); _w1.y = cvt_pk_bf16(_o2.z * bflo(_g1.y), _o2.w * bfhi(_g1.y)); \
        _w1.z = cvt_pk_bf16(_o3.x * bflo(_g1.z), _o3.y * bfhi(_g1.z)); _w1.w = cvt_pk_bf16(_o3.z * bflo(_g1.w), _o3.w * bfhi(_g1.w)); \
        *(u32x4*)(OG + _go) = _w0; *(u32x4*)(OG + _go + 8) = _w1; \
        _ss += __shfl_xor(_ss, 1); _ss += __shfl_xor(_ss, 2); _ss += __shfl_xor(_ss, 4); \
        if (_seg == 0) { SSO[(size_t)((blk_) * 64 + _t) * 32 + 2 * (h_)] = _ss; SSO[(size_t)((blk_) * 64 + _t) * 32 + 2 * (h_) + 1] = 0.f; } } } while (0)
#define S2_G_LOADP(blk_, h_, vq2_) do { if (FUSE && tid < 256) { const size_t _go = (size_t)((blk_) * 64 + (tid >> 2)) * D + (h_) * VH + (vq2_) * 64 + (tid & 3) * 16; gpre0 = *(const u32x4*)(Gin + _go); gpre1 = *(const u32x4*)(Gin + _go + 8); } } while (0)
#define S2_OG_EPIP(blk_, h_, vq2_) do { if (tid < 256) { const int _t = tid >> 2, _seg = tid & 3; const LAS float* _op = OT + _t * OTS + _seg * 16; \
        const f32x4 _o0 = *(const LAS f32x4*)_op, _o1 = *(const LAS f32x4*)(_op + 4), _o2 = *(const LAS f32x4*)(_op + 8), _o3 = *(const LAS f32x4*)(_op + 12); \
        const size_t _go = (size_t)((blk_) * 64 + _t) * D + (h_) * VH + (vq2_) * 64 + _seg * 16; const u32x4 _g0 = gpre0, _g1 = gpre1; \
        float _ss = ((_o0.x * _o0.x + _o0.y * _o0.y) + (_o0.z * _o0.z + _o0.w * _o0.w)) + ((_o1.x * _o1.x + _o1.y * _o1.y) + (_o1.z * _o1.z + _o1.w * _o1.w)) \
                  + ((_o2.x * _o2.x + _o2.y * _o2.y) + (_o2.z * _o2.z + _o2.w * _o2.w)) + ((_o3.x * _o3.x + _o3.y * _o3.y) + (_o3.z * _o3.z + _o3.w * _o3.w)); \
        u32x4 _w0, _w1; _w0.x = cvt_pk_bf16(_o0.x * bflo(_g0.x), _o0.y * bfhi(_g0.x)); _w0.y = cvt_pk_bf16(_o0.z * bflo(_g0.y), _o0.w * bfhi(_g0.y)); \
        _w0.z = cvt_pk_bf16(_o1.x * bflo(_g0.z), _o1.y * bfhi(_g0.z)); _w0.w = cvt_pk_bf16(_o1.z * bflo(_g0.w), _o1.w * bfhi(_g0.w)); \
        _w1.x = cvt_pk_bf16(_o2.x * bflo(_g1.x), _o2.y * bfhi(_g1.x)); _w1.y = cvt_pk_bf16(_o2.z * bflo(_g1.y), _o2.w * bfhi(_g1.y)); \
        _w1.z = cvt_pk_bf16(_o3.x * bflo(_g1.z), _o3.y * bfhi(_g1.z)); _w1.w = cvt_pk_bf16(_o3.z * bflo(_g1.w), _o3.w * bfhi(_g1.w)); \
        *(u32x4*)(OG + _go) = _w0; *(u32x4*)(OG + _go + 8) = _w1; \
        _ss += __shfl_xor(_ss, 1); _ss += __shfl_xor(_ss, 2); \
        if (_seg == 0) SSO[(size_t)((blk_) * 64 + _t) * 32 + 2 * (h_) + (vq2_)] = _ss; } } while (0)
    constexpr int P_QI = 64 * (K / 8) / 512, P_KD = K * 8 / 512;
    const int lane = tid & 63, wave = tid >> 6, l15 = lane & 15, g4 = lane >> 4;
    volatile LAS unsigned* qslot = (volatile LAS unsigned*)(lds + MISC_OFF + 64);
    const unsigned vtr_a128 = (unsigned)(size_t)(lds + L_VT) + (8 * g4 + (l15 >> 2)) * 272 + (16 * wave + 4 * (lane & 3)) * 2;
    const unsigned vtr_a64 = (unsigned)(size_t)(lds + L_VT) + (8 * g4 + (l15 >> 2)) * 144 + (16 * (wave & 3) + 4 * (lane & 3)) * 2;

    u32x4 rq[P_QI], rk[P_KD], ra, rv[2], rd;
#define S2_LOAD(blk_, h_, vcol0_, nvrows_, ndl_) do { const int _blk = (blk_), _h = (h_), _vc0 = (vcol0_); \
        _Pragma("unroll") for (int n = 0; n < P_QI; ++n) { const int p = tid + n * 512, row = p / (K / 8), pc = p % (K / 8); rq[n] = *(const u32x4*)(QI + (size_t)(_blk * 64 + row) * NHK + _h * K + pc * 8); } \
        _Pragma("unroll") for (int n = 0; n < P_KD; ++n) { const int p = tid + n * 512; rk[n] = *(const u32x4*)(KDT + (size_t)(_blk * NH + _h) * K * 64 + (size_t)p * 8); } \
        ra = *(const u32x4*)(AM + (size_t)(_blk * NH + _h) * 4096 + (size_t)tid * 8); \
        _Pragma("unroll") for (int n = 0; n < 2; ++n) { const int p = tid + n * 512; constexpr int _pr = (nvrows_) / 8; if (p < (nvrows_) * 8) rv[n] = *(const u32x4*)(VT + (size_t)(_blk * 64 + p / _pr) * D + _h * VH + _vc0 + (p % _pr) * 8); } \
        if ((ndl_) == 1) { if (tid < K / 4) rd = *(const u32x4*)(DL + (size_t)_blk * NHK + _h * K + tid * 4); } \
        else { if (tid < 2 * K) { const int sg = tid / (K / 4), pc = tid % (K / 4); rd = *(const u32x4*)(DL + (size_t)(128 + (_blk - 128) * 8 + sg) * NHK + _h * K + pc * 4); } } } while (0)
#define S2_STORE(nvrows_, ndl_) do { \
        _Pragma("unroll") for (int n = 0; n < P_QI; ++n) { const int p = tid + n * 512, row = p / (K / 8), pc = p % (K / 8); *(LAS u32x4*)(lds + L_QI + row * QS + pc * 16) = rq[n]; } \
        _Pragma("unroll") for (int n = 0; n < P_KD; ++n) { const int p = tid + n * 512; *(LAS u32x4*)(lds + L_KDT + (p >> 3) * RS + (p & 7) * 16) = rk[n]; } \
        *(LAS u32x4*)(lds + L_A + (tid >> 3) * RS + (tid & 7) * 16) = ra; \
        _Pragma("unroll") for (int n = 0; n < 2; ++n) { const int p = tid + n * 512; constexpr int _pr = (nvrows_) / 8, _vs = (nvrows_) == 64 ? 144 : 272; if (p < (nvrows_) * 8) *(LAS u32x4*)(lds + L_VT + (p / _pr) * _vs + (p % _pr) * 16) = rv[n]; } \
        if ((ndl_) == 1) { if (tid < K / 4) *(LAS u32x4*)(lds + L_DL + tid * 16) = rd; } \
        else { if (tid < 2 * K) *(LAS u32x4*)(lds + L_DL + tid * 16) = rd; } } while (0)

    f32x4 S[NKT];
    if (FUSE && bx < PB * NH * NVQ2) {
        const int b = bx / (NH * NVQ2), h = (bx / NVQ2) % NH, vq2 = bx % NVQ2;
        const int col = h * VH + vq2 * 64 + (wave & 3) * 16 + l15;
        const bool act = wave < 4;
#pragma unroll
        for (int kt = 0; kt < NKT; ++kt) S[kt] = (f32x4){0.f, 0.f, 0.f, 0.f};
        lds_barrier();
        S2_LOAD(b * 32, h, vq2 * 64, 64, 1); S2_STORE(64, 1);
        lds_barrier();
#pragma unroll 1
        for (int ch = 0; ch < 32; ++ch) {
            const int blk = b * 32 + ch;
            if (ch + 1 < 32) S2_LOAD(blk + 1, h, vq2 * 64, 64, 1);
            S2_G_LOADP(blk, h, vq2);
            if (act) {
            bf16x8 vfr[2], aq[NKS][4];
#pragma unroll
            for (int ks = 0; ks < NKS; ++ks)
#pragma unroll
                for (int tt = 0; tt < 4; ++tt) aq[ks][tt] = *(const LAS bf16x8*)(lds + L_QI + (16 * tt + l15) * QS + ks * 64 + g4 * 16);
            v_frag_tr2<144>(vtr_a64, vfr[0], vfr[1]);
            __builtin_amdgcn_sched_barrier(0);
            f32x4 oacc[4];
#pragma unroll
            for (int tt = 0; tt < 4; ++tt) oacc[tt] = (f32x4){0.f, 0.f, 0.f, 0.f};
#pragma unroll
            for (int ks = 0; ks < NKS; ++ks) {
                union { u32x4 u; bf16x8 v; } sb;
                sb.u.x = cvt_pk_bf16(S[2 * ks][0], S[2 * ks][1]); sb.u.y = cvt_pk_bf16(S[2 * ks][2], S[2 * ks][3]);
                sb.u.z = cvt_pk_bf16(S[2 * ks + 1][0], S[2 * ks + 1][1]); sb.u.w = cvt_pk_bf16(S[2 * ks + 1][2], S[2 * ks + 1][3]);
#pragma unroll
                for (int tt = 0; tt < 4; ++tt) oacc[tt] = __builtin_amdgcn_mfma_f32_16x16x32_bf16(aq[ks][tt], sb.v, oacc[tt], 0, 0, 0);
            }
            __builtin_amdgcn_sched_barrier(0);
            { bf16x8 aa[4][2]; f32x4 dlv[NKT];
#pragma unroll
              for (int tt = 0; tt < 4; ++tt)
#pragma unroll
                  for (int ss = 0; ss < 2; ++ss) aa[tt][ss] = *(const LAS bf16x8*)(lds + L_A + (16 * tt + l15) * RS + ss * 64 + g4 * 16);
#pragma unroll
              for (int kt = 0; kt < NKT; ++kt) dlv[kt] = *(const LAS f32x4*)(lds + L_DL + (16 * kt + 4 * g4) * 4);
              __builtin_amdgcn_sched_barrier(0);
#pragma unroll
              for (int tt = 0; tt < 4; ++tt)
#pragma unroll
                  for (int ss = 0; ss < 2; ++ss) oacc[tt] = __builtin_amdgcn_mfma_f32_16x16x32_bf16(aa[tt][ss], vfr[ss], oacc[tt], 0, 0, 0);
#pragma unroll
              for (int kt = 0; kt < NKT; ++kt) S[kt] = S[kt] * dlv[kt];
            }
            __builtin_amdgcn_sched_barrier(0);
#pragma unroll
            for (int kh = 0; kh < NKT / 8; ++kh) {
                bf16x8 ak[8][2];
#pragma unroll
                for (int k8 = 0; k8 < 8; ++k8)
#pragma unroll
                    for (int ss = 0; ss < 2; ++ss) ak[k8][ss] = *(const LAS bf16x8*)(lds + L_KDT + (16 * (kh * 8 + k8) + l15) * RS + ss * 64 + g4 * 16);
                __builtin_amdgcn_sched_barrier(0);
#pragma unroll
                for (int k8 = 0; k8 < 8; ++k8)
#pragma unroll
                    for (int ss = 0; ss < 2; ++ss) S[kh * 8 + k8] = __builtin_amdgcn_mfma_f32_16x16x32_bf16(ak[k8][ss], vfr[ss], S[kh * 8 + k8], 0, 0, 0);
                __builtin_amdgcn_sched_barrier(0);
            }
#pragma unroll
            for (int tt = 0; tt < 4; ++tt)
#pragma unroll
                for (int r = 0; r < 4; ++r) { if (FUSE) OT[(16 * tt + 4 * g4 + r) * OTS + wave * 16 + l15] = oacc[tt][r]; else O[(size_t)(blk * 64 + 16 * tt + 4 * g4 + r) * D + col] = oacc[tt][r]; }
            }
            lds_barrier();
            if (ch + 1 < 32) S2_STORE(64, 1);
            if (FUSE) S2_OG_EPIP(blk, h, vq2);
            lds_barrier();
        }
        if (act) {
        float* so = SPo + ((size_t)(b * NH + h) * K) * VH + vq2 * 64 + wave * 16 + l15;
#pragma unroll
        for (int kt = 0; kt < NKT; ++kt)
#pragma unroll
            for (int r = 0; r < 4; ++r) __builtin_nontemporal_store(S[kt][r], so + (size_t)(16 * kt + 4 * g4 + r) * VH);
        }
    }
    constexpr int NTASK = 16 * NH * NVQ * 2;
    for (;;) {
        lds_barrier();
        if (tid == 0) qslot[0] = __hip_atomic_fetch_add(qhead, 1u, __ATOMIC_RELAXED, __HIP_MEMORY_SCOPE_AGENT);
        lds_barrier();
        const int task = (int)qslot[0];
        if (task >= NTASK) break;
        const int half = task & 1, vq = (task >> 1) % NVQ, h = (task / (2 * NVQ)) % NH, sblk = task / (2 * NVQ * NH), blk = 128 + sblk;
        const int col = h * VH + vq * 128 + wave * 16 + l15;
        S2_LOAD(blk, h, vq * 128, 128, 8); S2_STORE(128, 8);
        S2_G_LOAD(blk, h, 32 * half, 32);
        lds_barrier();
        const bf16x8 vfr0 = v_frag_tr1<272>(vtr_a128 + half * 32 * 272);
#pragma unroll 1
        for (int jj = 0; jj < 4; ++jj) {
            const int j = half * 4 + jj, bseq = sblk * 8 + j;
            const float* s0 = S0 + ((size_t)(bseq * NH + h) * K) * VH + vq * 128 + wave * 16 + l15;
#pragma unroll
            for (int kt = 0; kt < NKT; ++kt)
#pragma unroll
                for (int r = 0; r < 4; ++r) S[kt][r] = __builtin_nontemporal_load(s0 + (size_t)(16 * kt + 4 * g4 + r) * VH);
            const int arow = 8 * j + (l15 & 7);
            constexpr int BQ = 4, BK = (NKT > 8) ? 4 : 8;
            const bf16x8 aAs = *(const LAS bf16x8*)(lds + L_A + arow * RS + half * 64 + g4 * 16);
            f32x4 oacc = (f32x4){0.f, 0.f, 0.f, 0.f};
#pragma unroll
            for (int qb = 0; qb < NKS / BQ; ++qb) {
                bf16x8 aqs[BQ];
#pragma unroll
                for (int i = 0; i < BQ; ++i) aqs[i] = *(const LAS bf16x8*)(lds + L_QI + arow * QS + (qb * BQ + i) * 64 + g4 * 16);
                __builtin_amdgcn_sched_barrier(0);
#pragma unroll
                for (int i = 0; i < BQ; ++i) { const int ks = qb * BQ + i;
                    union { u32x4 u; bf16x8 v; } sb;
                    sb.u.x = cvt_pk_bf16(S[2 * ks][0], S[2 * ks][1]); sb.u.y = cvt_pk_bf16(S[2 * ks][2], S[2 * ks][3]);
                    sb.u.z = cvt_pk_bf16(S[2 * ks + 1][0], S[2 * ks + 1][1]); sb.u.w = cvt_pk_bf16(S[2 * ks + 1][2], S[2 * ks + 1][3]);
                    oacc = __builtin_amdgcn_mfma_f32_16x16x32_bf16(aqs[i], sb.v, oacc, 0, 0, 0); }
                __builtin_amdgcn_sched_barrier(0);
            }
            oacc = __builtin_amdgcn_mfma_f32_16x16x32_bf16(aAs, vfr0, oacc, 0, 0, 0);
#pragma unroll
            for (int kh = 0; kh < NKT / BK; ++kh) {
                u32x4 akd[BK]; f32x4 dls[BK];
#pragma unroll
                for (int k8 = 0; k8 < BK; ++k8) { akd[k8] = *(const LAS u32x4*)(lds + L_KDT + (16 * (kh * BK + k8) + l15) * RS + half * 64 + g4 * 16);
                    dls[k8] = *(const LAS f32x4*)(lds + L_DL + j * K * 4 + (16 * (kh * BK + k8) + 4 * g4) * 4); }
                __builtin_amdgcn_sched_barrier(0);
#pragma unroll
                for (int k8 = 0; k8 < BK; ++k8) { const int kt = kh * BK + k8;
                    S[kt] = S[kt] * dls[k8];
                    union { u32x4 u; bf16x8 v; } af; af.u = akd[k8];
                    if (g4 != jj) af.u = (u32x4){0u, 0u, 0u, 0u};
                    S[kt] = __builtin_amdgcn_mfma_f32_16x16x32_bf16(af.v, vfr0, S[kt], 0, 0, 0); }
                __builtin_amdgcn_sched_barrier(0);
            }
            if (g4 < 2) {
#pragma unroll
                for (int r = 0; r < 4; ++r) { if (FUSE) OT[(8 * j + 4 * g4 + r) * OTS + wave * 16 + l15] = oacc[r]; else O[(size_t)(blk * 64 + 8 * j + 4 * g4 + r) * D + col] = oacc[r]; }
            }
            float* so = SSo + ((size_t)(bseq * NH + h) * K) * VH + vq * 128 + wave * 16 + l15;
#pragma unroll
            for (int kt = 0; kt < NKT; ++kt)
#pragma unroll
                for (int r = 0; r < 4; ++r) __builtin_nontemporal_store(S[kt][r], so + (size_t)(16 * kt + 4 * g4 + r) * VH);
        }
        if (FUSE) { lds_barrier(); S2_OG_EPI(blk, h, 32 * half, 32); }
    }
#undef S2_OG_EPI
#undef S2_OG_EPIP
#undef S2_G_LOADP
#undef S2_G_LOAD
#undef S2_LOAD
#undef S2_STORE
}

template <int NR>
__device__ __forceinline__ void pool_segment(const float* X, int row0, int tabs0  , const float* hsrc, const LAS float* rs  ,
                                             const f32x4 gain, int w, bool is_prompt, bf16_t* Y, float* pstate  , float* sstate  , int c0) {
    f32x4 ring[16]; f32x4 wsum = (f32x4){0.f, 0.f, 0.f, 0.f};
#pragma unroll
    for (int i = 0; i < 16; ++i) ring[i] = (f32x4){0.f, 0.f, 0.f, 0.f};
#pragma unroll
    for (int i = 0; i < 15 + NR; ++i) {
        f32x4 val;
        if (i < 15) {
            if (hsrc) val = *(const f32x4*)(hsrc + (size_t)i * D + c0);
            else { const int t = tabs0 - 15 + i; val = (t >= 0) ? *(const f32x4*)(X + (size_t)(row0 - 15 + i) * D + c0) * rs[i] * gain : (f32x4){0.f, 0.f, 0.f, 0.f}; }
        } else val = *(const f32x4*)(X + (size_t)(row0 + i - 15) * D + c0) * rs[i] * gain;
        const f32x4 old = (w == 2) ? ring[(i - 2) & 15] : (w == 4) ? ring[(i - 4) & 15] : (w == 8) ? ring[(i - 8) & 15] : ring[i & 15];
        wsum = wsum + val - old;
        ring[i & 15] = val;
        if (i >= 15) {
            const int t = i - 15;
            float cnt = (float)w; if (is_prompt) { const int have = tabs0 + t + 1; cnt = (float)(have < w ? have : w); }
            const float ic = 1.f / cnt;
            const f32x4 y = wsum * ic - val;
            u32x2 o; o.x = pk2(y.x, y.y); o.y = pk2(y.z, y.w);
            *(u32x2*)(Y + (size_t)(row0 + t) * D + c0) = o;
            if (is_prompt) { if (pstate) { const int tt = tabs0 + t - (PT - POOLBUF); if (tt >= 0) *(f32x4*)(pstate + (size_t)tt * D + c0) = val; } }
            else *(f32x4*)(sstate + (size_t)(7 + t) * D + c0) = val;
        }
    }
    if (!is_prompt) {
#pragma unroll
        for (int i = 0; i < 7; ++i) *(f32x4*)(sstate + (size_t)i * D + c0) = *(const f32x4*)(hsrc + (size_t)(8 + i) * D + c0);
    }
}
__device__ __forceinline__ void pool_pre_phase(CParams* P, LAS unsigned char* lds, float* X, const float* gain, bf16_t* Y, int tid, int wave, int lane, int G) {
    LAS float* rs = (LAS float*)lds;
    const int c0 = tid * 4, w = 2 << (c0 >> 9);
    const f32x4 g4 = *(const f32x4*)(gain + c0);
    for (int u = blockIdx.x; u < M / 32; u += G) {
        const int r0 = u * 32; const bool is_prompt = r0 < MP;
        __syncthreads();
        for (int i = wave; i < 47; i += NWAVES) {
            const int row = r0 - 15 + i;
            const bool need = is_prompt ? ((r0 % PT) - 15 + i >= 0) : (i >= 15);
            float r = 0.f;
            if (need) { const f32x4* xr = (const f32x4*)(X + (size_t)row * D) + lane; float s = 0.f; f32x4 v[8];
#pragma unroll
                for (int j = 0; j < 8; ++j) v[j] = xr[64 * j];
#pragma unroll
                for (int j = 0; j < 8; ++j) s += (v[j].x * v[j].x + v[j].y * v[j].y) + (v[j].z * v[j].z + v[j].w * v[j].w);
                r = __builtin_amdgcn_rsqf(wave_sum(s) * (1.f / D) + EPS); }
            if (lane == 0) rs[i] = r;
        }
        __syncthreads();
        if (is_prompt) {
            const int b = r0 / PT, t0 = r0 % PT;
            float* pst = (t0 + 32 == PT) ? P->out + OUT_POOL_P + (size_t)b * POOLBUF * D : nullptr;
            pool_segment<32>(X, r0, t0, nullptr, rs, g4, w, true, Y, pst, nullptr, c0);
        } else {
            for (int sgi = 0; sgi < 4; ++sgi) {
                const int b = (r0 - MP) / ST + sgi;
                pool_segment<8>(X, r0 + sgi * 8, 0, P->in[I_SPOOL] + (size_t)b * POOLBUF * D, rs + sgi * 8, g4, w, false, Y, nullptr, P->out + OUT_POOL_S + (size_t)b * POOLBUF * D, c0);
            }
        }
    }
}

constexpr int NPHASE = 51;
__host__ __device__ inline bool phase_exists(int ph) { if (ph == 0 || ph == NPHASE - 1) return true; const int li = (ph - 1) / 12, k = (ph - 1) % 12, kind = li % 3;
    if (k == 0) return li > 0;
    if (li >= NLAYER) return false;
    if (k == 5 || k == 6) return kind != 2;
    if (k == 7) return kind == 1;
    return true; }

__device__ __forceinline__ CParams* fresh_params() { CParams* p = (CParams*)__builtin_amdgcn_kernarg_segment_ptr(); asm volatile("" : "+s"(p)); return p; }
__device__ __forceinline__ int fresh_tid(int wave0) { int l = __builtin_amdgcn_mbcnt_hi(~0u, __builtin_amdgcn_mbcnt_lo(~0u, 0u)); asm volatile("" : "+v"(l)); return wave0 * 64 + l; }
#define SITE_BEGIN CParams* pp = fresh_params(); unsigned char* ws = pp->ws; const int tid = fresh_tid(wave0), lane = tid & 63, wave = __builtin_amdgcn_readfirstlane(tid >> 6), G = gridDim.x, bx = blockIdx.x, gw = bx * NWAVES + wave, NGW = G * NWAVES, vbx = __builtin_amdgcn_readfirstlane((int)((volatile LAS unsigned*)(lds + MISC_OFF))[20]); \
    (void)vbx; (void)ws; (void)lane; (void)wave; (void)gw; (void)NGW; (void)tid; (void)G; (void)bx;
#define WSP(T, off) ((T*)(ws + (off)))

__global__ void __launch_bounds__(NTHREADS, 2) mega_fwd(Params P) {
    extern __shared__ __attribute__((aligned(16))) unsigned char lds_raw[];
    LAS unsigned char* lds = (LAS unsigned char*)lds_raw;
    volatile LAS unsigned* MISC = (volatile LAS unsigned*)(lds + MISC_OFF);
    const int wave0 = __builtin_amdgcn_readfirstlane(threadIdx.x >> 6);
    for (int u = threadIdx.x; u < (LDS_BYTES - LDSCTL_OFF) / 4; u += NTHREADS) ((LAS unsigned*)(lds + LDSCTL_OFF))[u] = 0u;
    __syncthreads();
    if (threadIdx.x == 0) { const unsigned x = xb_xcc_id() & 7u; const unsigned rk = __hip_atomic_fetch_add((unsigned*)(P.ws + WS_CTL) + CW_XRANK + 64 * x, 1u, __ATOMIC_RELAXED, __HIP_MEMORY_SCOPE_AGENT);
        ((volatile LAS unsigned*)(lds + MISC_OFF))[20] = rk < 32u ? rk * 8u + x : blockIdx.x; }
    __syncthreads();
    const int lo = P.ph_lo, hi = P.ph_hi;
    XcdBarrier bar; bar.bar = (unsigned*)(P.ws + WS_CTL) + CW_BAR; bar.x = 0; bar.st = nullptr;
    if (hi - lo > 1) bar = xcd_barrier_post((unsigned*)(P.ws + WS_CTL) + CW_BAR, MISC + 8);
    unsigned long long probe_acc = 0ull, probe_t0 = 0ull; (void)probe_acc; (void)probe_t0;
#define IN(k) ((probe_t0 = (PROBE_MASK != 0 && (((k) > 0 && (k) < NPHASE - 1 && ((PROBE_MASK >> (((k) - 1) % 12)) & 1)) || ((k) == 0 && ((PROBE_MASK >> 12) & 1)))) ? __builtin_amdgcn_s_memrealtime() : 0ull), (lo <= (k) && (k) < hi))
#define SEAM(k) do { if ((k) + 1 < hi) xcd_barrier(bar, fresh_tid(wave0) == 0); if (PROBE_MASK != 0 && probe_t0 != 0ull) { probe_acc += __builtin_amdgcn_s_memrealtime() - probe_t0; probe_t0 = 0ull; } } while (0)

    if (IN(0)) { for (int rep = 0; rep < REP_PRO; ++rep) { { SITE_BEGIN prologue_phase(pp, lds, gw, NGW, wave, lane); } SEAM(0); } }

#pragma unroll 1
    for (int li = 0; li < NLAYER; ++li) {
        const int pb = 1 + li * 12, kind = li % 3, j = li / 3;
#pragma unroll 1
        for (int which = 0; which < 2; ++which) {
            const int p0 = pb + (which ? 9 : 0), s = li * 2 + which;
            if (IN(p0 + 1)) {
#pragma unroll 1
                for (int rep = 0; rep < REP_GU; ++rep) {
                { SITE_BEGIN
                pg8::Gemm g{WSP(bf16_t, WS_XN), (const bf16_t*)(ws + WS_WGU + (size_t)s * SZ_WGU1), D, D, D, M / 256, 2 * FF / 256, 0};
                pg8::TailSplitOrder<M / 256, 2 * FF / 256, D / 64, 256> S; S.init(vbx);
                EpiGU E{WSP(bf16_t, WS_H), WSP(const float, WS_R), WSP(float, WS_PART), WSP(unsigned, WS_CTL) + CW_GUFLAG + 64 * s};
                pg8::gemm_phase(lds, g, S, E, tid); }
                SEAM(p0 + 1); }
            }
            if (IN(p0 + 2)) {
                { SITE_BEGIN
                pg8::Gemm g{WSP(bf16_t, WS_H), (const bf16_t*)(ws + WS_WDN + (size_t)s * SZ_WDN1), FF, FF, FF, M / 256, D / 256, 0};
                pg8::ResOrder S; S.init(vbx, g.K / 64);
                EpiRes<0, 1> E{WSP(float, WS_X), (li == NLAYER - 1 && which == 1) ? (bf16_t*)nullptr : WSP(bf16_t, WS_XN), WSP(float, WS_SS), nullptr, nullptr, WSP(float, WS_PART)};
                pg8::gemm_phase(lds, g, S, E, tid); }
                SEAM(p0 + 2);
            }
            if (!(li == NLAYER - 1 && which == 1)   && IN(p0 + 3)) { { SITE_BEGIN fix_phase<0, 1>(WSP(float, WS_X), WSP(bf16_t, WS_XN), WSP(float, WS_SS), WSP(float, WS_R), WSP(const float, WS_PART), 8, nullptr, nullptr, lds, bx, wave, gw, NGW, lane); } SEAM(p0 + 3); }
            if (which == 1) continue;
            if (kind == 0) {
                if (IN(pb + 4)) {
                    { SITE_BEGIN
                    pg8::Gemm g{WSP(bf16_t, WS_XN), WSP(const bf16_t, WS_WHIN) + (size_t)j * 8192 * D, D, D, D, M / 256, 8192 / 256, 0};
                    pg8::StaticOrder S; S.init(g.nM, g.nN, G, vbx, g.K / 64);
                    EpiHG E{WSP(bf16_t, WS_Q), WSP(bf16_t, WS_KK), WSP(bf16_t, WS_V), WSP(bf16_t, WS_G), WSP(float, WS_LF), WSP(const float, WS_TAB) + (size_t)j * D, WSP(const float, WS_SS)};
                    pg8::gemm_phase(lds, g, S, E, tid); }
                    SEAM(pb + 4);
                }
#pragma unroll 1
                for (int rep = 0; rep < REP_SCAN; ++rep) {
                if (IN(pb + 5)) {
                    { SITE_BEGIN
                    scan_s1<HG_K, HG_V, HG_H>(WSP(bf16_t, WS_Q), WSP(bf16_t, WS_KK), WSP(float, WS_LF), WSP(bf16_t, WS_V), WSP(bf16_t, WS_QI), WSP(bf16_t, WS_KDT), WSP(bf16_t, WS_AM), WSP(bf16_t, WS_VT), WSP(float, WS_DL), lds, tid, G, bx); }
                    SEAM(pb + 5);
                }
                if (IN(pb + 6)) {
                    { SITE_BEGIN
                    scan_s2<HG_K, HG_V, HG_H, true>(WSP(bf16_t, WS_QI), WSP(bf16_t, WS_KDT), WSP(bf16_t, WS_AM), WSP(bf16_t, WS_V), WSP(float, WS_DL), pp->in[I_SHG] + (size_t)j * SB * HG_H * HG_K * HG_V,
                        pp->out + OUT_HG_P + (size_t)j * PB * HG_H * HG_K * HG_V, pp->out + OUT_HG_S + (size_t)j * SB * HG_H * HG_K * HG_V, nullptr,
                        WSP(const bf16_t, WS_G), WSP(bf16_t, WS_OG), WSP(float, WS_SSO), lds, WSP(unsigned, WS_CTL) + CW_QUEUE + 64 * li + 16 * rep, tid, G, bx); }
                    SEAM(pb + 6);
                }
                }
                if (IN(pb + 8)) {
                    { SITE_BEGIN
                    pg8::Gemm g{WSP(bf16_t, WS_OG), WSP(const bf16_t, WS_WHOUT) + (size_t)j * D * D, D, D, D, M / 256, D / 256, 0};
                    pg8::ResOrder S; S.init(vbx, g.K / 64);
                    EpiRes<32, 0> E{WSP(float, WS_X), WSP(bf16_t, WS_XN), WSP(float, WS_SS), nullptr, WSP(const float, WS_SSO), WSP(float, WS_PART)};
                    pg8::gemm_phase(lds, g, S, E, tid); }
                    SEAM(pb + 8);
                }
                if (IN(pb + 9)) { { SITE_BEGIN fix_phase<32, 0>(WSP(float, WS_X), WSP(bf16_t, WS_XN), WSP(float, WS_SS), WSP(float, WS_R), WSP(const float, WS_PART), 8, nullptr, WSP(const float, WS_SSO), lds, bx, wave, gw, NGW, lane); } SEAM(pb + 9); }
            } else if (kind == 1) {
                if (IN(pb + 4)) {
                    { SITE_BEGIN
                    pg8::Gemm g{WSP(bf16_t, WS_XN), WSP(const bf16_t, WS_WGIN), D, D, D, M / 256, GL_NIN / 256, 0};
                    pg8::StaticOrder S; S.init(g.nM, g.nN, G, vbx, g.K / 64);
                    EpiGLA E{WSP(bf16_t, WS_Q), WSP(bf16_t, WS_KK), WSP(bf16_t, WS_V), WSP(bf16_t, WS_G), WSP(float, WS_LF), pp->in[I_GBG] + (size_t)j * GL_DK, WSP(const float, WS_SS)};
                    pg8::gemm_phase(lds, g, S, E, tid); }
                    SEAM(pb + 4);
                }
#pragma unroll 1
                for (int rep = 0; rep < REP_SCAN; ++rep) {
                if (IN(pb + 5)) {
                    { SITE_BEGIN
                    scan_s1<GL_K, GL_V, GL_H>(WSP(bf16_t, WS_Q), WSP(bf16_t, WS_KK), WSP(float, WS_LF), WSP(bf16_t, WS_V), WSP(bf16_t, WS_QI), WSP(bf16_t, WS_KDT), WSP(bf16_t, WS_AM), WSP(bf16_t, WS_VT), WSP(float, WS_DL), lds, tid, G, bx); }
                    SEAM(pb + 5);
                }
                if (IN(pb + 6)) {
                    { SITE_BEGIN
                    scan_s2_old<GL_K, GL_V, GL_H, false>(WSP(bf16_t, WS_QI), WSP(bf16_t, WS_KDT), WSP(bf16_t, WS_AM), WSP(bf16_t, WS_V), WSP(float, WS_DL), pp->in[I_SGLA] + (size_t)j * SB * GL_H * GL_K * GL_V,
                        pp->out + OUT_GLA_P + (size_t)j * PB * GL_H * GL_K * GL_V, pp->out + OUT_GLA_S + (size_t)j * SB * GL_H * GL_K * GL_V, WSP(float, WS_O),
                        nullptr, nullptr, nullptr, lds, WSP(unsigned, WS_CTL) + CW_QUEUE + 64 * li + 16 * rep, tid, G, bx); }
                    SEAM(pb + 6);
                }
                if (IN(pb + 7)) { { SITE_BEGIN post_phase<4>(WSP(const bf16_t, WS_O), pp->in[I_GON] + (size_t)j * D, WSP(bf16_t, WS_G), WSP(bf16_t, WS_OG), gw, NGW, lane); } SEAM(pb + 7); }
                }
                if (IN(pb + 8)) {
                    { SITE_BEGIN
                    pg8::Gemm g{WSP(bf16_t, WS_OG), WSP(const bf16_t, WS_WGOUT), D, D, D, M / 256, D / 256, 0};
                    pg8::ResOrder S; S.init(vbx, g.K / 64);
                    EpiRes<0, 0> E{WSP(float, WS_X), WSP(bf16_t, WS_XN), WSP(float, WS_SS), nullptr, nullptr, WSP(float, WS_PART)};
                    pg8::gemm_phase(lds, g, S, E, tid); }
                    SEAM(pb + 8);
                }
                if (IN(pb + 9)) { { SITE_BEGIN fix_phase<0, 0>(WSP(float, WS_X), WSP(bf16_t, WS_XN), WSP(float, WS_SS), WSP(float, WS_R), WSP(const float, WS_PART), 8, nullptr, nullptr, lds, bx, wave, gw, NGW, lane); } SEAM(pb + 9); }
            } else {
                if (IN(pb + 4)) { { SITE_BEGIN pool_pre_phase(pp, lds, WSP(float, WS_X), pp->in[I_NMIX] + (size_t)li * D, WSP(bf16_t, WS_OG), tid, wave, lane, G); } SEAM(pb + 7); }
                if (IN(pb + 8)) {
                    { SITE_BEGIN
                    pg8::Gemm g{WSP(bf16_t, WS_OG), WSP(const bf16_t, WS_WPOOL), D, 512, 512, M / 256, D / 256, 1};
                    pg8::ResOrder S; S.init(vbx, g.K / 64);
                    EpiRes<0, 0> E{WSP(float, WS_X), WSP(bf16_t, WS_XN), WSP(float, WS_SS), pp->in[I_PSC] + (size_t)j * D, nullptr, WSP(float, WS_PART)};
                    pg8::gemm_phase(lds, g, S, E, tid); }
                    SEAM(pb + 8);
                }
                if (IN(pb + 9)) { { SITE_BEGIN fix_phase<0, 0>(WSP(float, WS_X), WSP(bf16_t, WS_XN), WSP(float, WS_SS), WSP(float, WS_R), WSP(const float, WS_PART), 4, pp->in[I_PSC] + (size_t)j * D, nullptr, lds, bx, wave, gw, NGW, lane); } SEAM(pb + 9); }
            }
        }
    }
    if (IN(NPHASE - 1)) { SITE_BEGIN final_phase(WSP(const float, WS_X), pp->in[I_FN], pp->out + OUT_Y, WSP(const float, WS_PART), gw, NGW, lane); }
    if (PROBE_MASK != 0 && blockIdx.x == 0) { const unsigned long long t1 = __builtin_amdgcn_s_memrealtime(); while (__builtin_amdgcn_s_memrealtime() - t1 < (unsigned long long)PROBE_MUL * probe_acc) __builtin_amdgcn_s_sleep(16); }
#undef IN
#undef SEAM
}

extern "C" void kernel_launch(void* const* d_in, const int* in_sizes, int n_in, void* d_out, int out_size, void* d_ws, size_t ws_size, hipStream_t stream) {
    static int grid = 0;
    if (grid == 0) {
        if (n_in != 26 || (size_t)out_size != OUT_TOTAL || ws_size < WS_END) { fprintf(stderr, "kernel_launch: unexpected sizes n_in %d out %d ws %zu (need %zu)\n", n_in, out_size, ws_size, (size_t)WS_END); grid = -1; return; }
        int dev = 0, cus = 0, per_cu = 0;
        if (hipGetDevice(&dev) != hipSuccess || hipDeviceGetAttribute(&cus, hipDeviceAttributeMultiprocessorCount, dev) != hipSuccess) { grid = -1; return; }
        if (hipFuncSetAttribute((const void*)mega_fwd, hipFuncAttributeMaxDynamicSharedMemorySize, LDS_BYTES) != hipSuccess) { fprintf(stderr, "kernel_launch: hipFuncSetAttribute failed\n"); grid = -1; return; }
        if (hipOccupancyMaxActiveBlocksPerMultiprocessor(&per_cu, (const void*)mega_fwd, NTHREADS, LDS_BYTES) != hipSuccess || per_cu < 1) fprintf(stderr, "kernel_launch: occupancy query reports %d\n", per_cu);
        (void)hipGetLastError();
        grid = cus;
        if (grid != 256) { fprintf(stderr, "kernel_launch: built for 256 CUs (got %d)\n", cus); grid = -1; return; }
    }
    if (grid < 0) return;
    if (hipMemsetAsync((char*)d_ws + WS_CTL, 0, CTL_ZERO_BYTES, stream) != hipSuccess) return;
    Params p{};
    for (int i = 0; i < 26; ++i) p.in[i] = (const float*)d_in[i];
    p.out = (float*)d_out; p.ws = (unsigned char*)d_ws;
#if MK_PER_PHASE_LAUNCH
    for (int ph = 0; ph < NPHASE; ++ph) {
        if (!phase_exists(ph)) continue;
        p.ph_lo = ph; p.ph_hi = ph + 1;
        hipLaunchKernelGGL(mega_fwd, dim3(grid), dim3(NTHREADS), LDS_BYTES, stream, p);
    }
#else
    p.ph_lo = 0; p.ph_hi = NPHASE;
    hipLaunchKernelGGL(mega_fwd, dim3(grid), dim3(NTHREADS), LDS_BYTES, stream, p);
#endif
    (void)in_sizes;
}
```
